# Optimizing an MI355X kernel written in HIP

```python
import jax, jax.numpy as jnp
from jax import lax
import numpy as np

D_MODEL = 2048
BATCH = 2
SEQ = 4096
DEPTH = 2

N_MEM = 256
RWKV_HEADS = 16
RWKV_HEAD_DIM = 64
RWKV_WIDTH = RWKV_HEADS * RWKV_HEAD_DIM
DECAY_RANK = 64
ICLR_RANK = 64
GATE_RANK = 128
DECAY_SCALE = 0.606531
GN_EPS = 64e-5
CONV_WIDTH = 1024
CONV_K = 3
XATTN_HEADS = 4
XATTN_HEAD_DIM = 256
XATTN_WIDTH = XATTN_HEADS * XATTN_HEAD_DIM
N_BRANCH = 3
BRANCH_WIDTH = 1024
D_FF = 5504
RWKV_PROJ = 3 * RWKV_WIDTH + 2 * DECAY_RANK + 2 * ICLR_RANK + GATE_RANK
CONV_PROJ = 3 * CONV_WIDTH
GATE_PROJ = N_BRANCH * D_MODEL
D_IN = RWKV_PROJ + CONV_PROJ + XATTN_WIDTH + GATE_PROJ
ALPHA = (2 * DEPTH) ** 0.25
BETA = (8 * DEPTH) ** -0.25
LN_EPS = 1e-5

kernel_name = "hybrid_rwkv7_shortconv_memxattn_macaron_deepnorm"


def layer_norm(x, g, b):
    xf = x.astype(jnp.float32)
    mu = jnp.mean(xf, axis=-1, keepdims=True)
    var = jnp.mean(jnp.square(xf - mu), axis=-1, keepdims=True)
    y = (xf - mu) * lax.rsqrt(var + LN_EPS)
    return (y * g.astype(jnp.float32) + b.astype(jnp.float32)).astype(x.dtype)


def swiglu(x, w_gate, w_up, w_down):
    return (jax.nn.silu(x @ w_gate) * (x @ w_up)) @ w_down


def _wkv7_scan(r, w, k, v, kk, a, reverse):
    b, t, h, n = r.shape

    def step(S, inp):
        r_t, w_t, k_t, v_t, kk_t, a_t = inp
        s_kk = jnp.einsum('bhvk,bhk->bhv', S, kk_t)
        S = (S * w_t[:, :, None, :]
             - s_kk[..., None] * (kk_t * a_t)[:, :, None, :]
             + v_t[..., None] * k_t[:, :, None, :])
        y_t = jnp.einsum('bhvk,bhk->bhv', S, r_t)
        return S, y_t

    xs = tuple(jnp.moveaxis(u, 1, 0) for u in (r, w, k, v, kk, a))
    s0 = jnp.zeros((b, h, n, n), jnp.float32)
    _, ys = lax.scan(step, s0, xs, reverse=reverse)
    return jnp.moveaxis(ys, 0, 1)


def rwkv7_branch(p, mu, w0, w_up, a0, a_up, g_up, k_k, k_a, r_k, gn_g, gn_b):
    b, t, _ = p.shape
    h, n = RWKV_HEADS, RWKV_HEAD_DIM
    prev = jnp.pad(p[:, :-1], ((0, 0), (1, 0), (0, 0)))
    nxt = jnp.pad(p[:, 1:], ((0, 0), (0, 1), (0, 0)))
    p = p + mu * (0.5 * (prev + nxt) - p)
    cuts = [RWKV_WIDTH, 2 * RWKV_WIDTH, 3 * RWKV_WIDTH,
            3 * RWKV_WIDTH + 2 * DECAY_RANK, 3 * RWKV_WIDTH + 2 * DECAY_RANK + 2 * ICLR_RANK]
    r, k, v, hw, ha, hg = jnp.split(p, cuts, axis=-1)
    hw = hw.reshape(b, t, 2, DECAY_RANK)
    ha = ha.reshape(b, t, 2, ICLR_RANK)
    w_logit = w0 + jnp.einsum('btdr,drc->btdc', jnp.tanh(hw), w_up)
    decay = jnp.exp(-DECAY_SCALE * jax.nn.sigmoid(w_logit.astype(jnp.float32)))
    a = jax.nn.sigmoid((a0 + jnp.einsum('btdr,drc->btdc', ha, a_up)).astype(jnp.float32))
    g = jax.nn.sigmoid(hg) @ g_up
    rf = r.astype(jnp.float32)
    kf = k.astype(jnp.float32)
    vf = v.astype(jnp.float32)
    r_h = rf.reshape(b, t, h, n)
    v_h = vf.reshape(b, t, h, n)
    kk = (kf * k_k.astype(jnp.float32)).reshape(b, t, h, n)
    kk = kk * lax.rsqrt(jnp.sum(kk * kk, axis=-1, keepdims=True) + 1e-12)
    k_dir = kf[:, :, None, :] * (1.0 + (a - 1.0) * k_a.astype(jnp.float32))
    k_dir_h = k_dir.reshape(b, t, 2, h, n)
    a_h = a.reshape(b, t, 2, h, n)
    decay_h = decay.reshape(b, t, 2, h, n)
    y_fwd = _wkv7_scan(r_h, decay_h[:, :, 0], k_dir_h[:, :, 0], v_h, kk, a_h[:, :, 0], reverse=False)
    y_bwd = _wkv7_scan(r_h, decay_h[:, :, 1], k_dir_h[:, :, 1], v_h, kk, a_h[:, :, 1], reverse=True)
    y = y_fwd + y_bwd
    m = jnp.mean(y, axis=-1, keepdims=True)
    var = jnp.mean(jnp.square(y - m), axis=-1, keepdims=True)
    y = ((y - m) * lax.rsqrt(var + GN_EPS)).reshape(b, t, RWKV_WIDTH)
    y = y * gn_g.astype(jnp.float32) + gn_b.astype(jnp.float32)
    k_bonus = jnp.mean(k_dir_h, axis=2)
    bonus = jnp.sum(r_h * k_bonus * r_k.astype(jnp.float32), axis=-1, keepdims=True) * v_h
    y = y + bonus.reshape(b, t, RWKV_WIDTH)
    return (y * g.astype(jnp.float32)).astype(p.dtype)


def shortconv_branch(p, conv_w):
    gate_b, gate_c, h = jnp.split(p, 3, axis=-1)
    hc = lax.conv_general_dilated(
        gate_c * h, conv_w[:, None, :].astype(p.dtype),
        window_strides=(1,), padding='SAME',
        dimension_numbers=('NWC', 'WIO', 'NWC'),
        feature_group_count=CONV_WIDTH)
    return gate_b * hc


def memory_xattn_branch(q, mem, ln_g, ln_b, w_kv):
    b, t, _ = q.shape
    mem_n = layer_norm(mem, ln_g, ln_b)
    k, v = jnp.split(mem_n @ w_kv, 2, axis=-1)
    qh = q.reshape(b, t, XATTN_HEADS, XATTN_HEAD_DIM)
    kh = k.reshape(b, -1, XATTN_HEADS, XATTN_HEAD_DIM)
    vh = v.reshape(b, -1, XATTN_HEADS, XATTN_HEAD_DIM)
    s = jnp.einsum('bthd,bmhd->bhtm', qh, kh).astype(jnp.float32) * (XATTN_HEAD_DIM ** -0.5)
    attn = jax.nn.softmax(s, axis=-1).astype(vh.dtype)
    o = jnp.einsum('bhtm,bmhd->bthd', attn, vh)
    return o.reshape(b, t, XATTN_WIDTH)


def setup_inputs(seed: int = 0) -> dict:
    key = jax.random.key(seed)
    ks = iter(jax.random.split(key, 40))
    L, D, F = DEPTH, D_MODEL, D_FF

    def nrm(shape, scale):
        return jax.random.normal(next(ks), shape, jnp.float32) * scale

    def gain(shape):
        return 1.0 + nrm(shape, 0.02)

    return {
        "x": nrm((BATCH, SEQ, D), 1.0),
        "mem": nrm((BATCH, N_MEM, D), 1.0),
        "ffn1_w_gate": nrm((L, D, F), D ** -0.5),
        "ffn1_w_up": nrm((L, D, F), D ** -0.5),
        "ffn1_w_down": nrm((L, F, D), BETA * F ** -0.5),
        "ln1_g": gain((L, D)),
        "ln1_b": nrm((L, D), 0.02),
        "w_in": nrm((L, D, D_IN), D ** -0.5),
        "rwkv_mu": jax.random.uniform(next(ks), (L, RWKV_PROJ), jnp.float32),
        "rwkv_w0": nrm((L, 2, RWKV_WIDTH), 1.5),
        "rwkv_w_up": nrm((L, 2, DECAY_RANK, RWKV_WIDTH), 0.5 * DECAY_RANK ** -0.5),
        "rwkv_a0": nrm((L, 2, RWKV_WIDTH), 0.5),
        "rwkv_a_up": nrm((L, 2, ICLR_RANK, RWKV_WIDTH), 0.5 * ICLR_RANK ** -0.5),
        "rwkv_g_up": nrm((L, GATE_RANK, RWKV_WIDTH), GATE_RANK ** -0.5),
        "rwkv_k_k": 0.85 + nrm((L, RWKV_WIDTH), 0.02),
        "rwkv_k_a": gain((L, RWKV_WIDTH)),
        "rwkv_r_k": nrm((L, RWKV_HEADS, RWKV_HEAD_DIM), 0.1),
        "rwkv_gn_g": gain((L, RWKV_WIDTH)),
        "rwkv_gn_b": nrm((L, RWKV_WIDTH), 0.02),
        "conv_w": nrm((L, CONV_K, CONV_WIDTH), CONV_K ** -0.5),
        "mem_ln_g": gain((L, D)),
        "mem_ln_b": nrm((L, D), 0.02),
        "w_mem_kv": nrm((L, D, 2 * XATTN_WIDTH), D ** -0.5),
        "w_branch": nrm((L, N_BRANCH, BRANCH_WIDTH, D), BETA * BRANCH_WIDTH ** -0.5),
        "gate_b": nrm((L, N_BRANCH, D), 0.1),
        "w_out": nrm((L, D, D), BETA * D ** -0.5),
        "ln2_g": gain((L, D)),
        "ln2_b": nrm((L, D), 0.02),
        "ffn2_w_gate": nrm((L, D, F), D ** -0.5),
        "ffn2_w_up": nrm((L, D, F), D ** -0.5),
        "ffn2_w_down": nrm((L, F, D), BETA * F ** -0.5),
        "ln3_g": gain((L, D)),
        "ln3_b": nrm((L, D), 0.02),
    }


def reference(x, mem, ffn1_w_gate, ffn1_w_up, ffn1_w_down, ln1_g, ln1_b, w_in,
              rwkv_mu, rwkv_w0, rwkv_w_up, rwkv_a0, rwkv_a_up, rwkv_g_up, rwkv_k_k,
              rwkv_k_a, rwkv_r_k, rwkv_gn_g, rwkv_gn_b, conv_w, mem_ln_g, mem_ln_b,
              w_mem_kv, w_branch, gate_b, w_out, ln2_g, ln2_b, ffn2_w_gate, ffn2_w_up,
              ffn2_w_down, ln3_g, ln3_b):
    b, t, d = x.shape
    cuts = [RWKV_PROJ, RWKV_PROJ + CONV_PROJ, RWKV_PROJ + CONV_PROJ + XATTN_WIDTH]
    for l in range(DEPTH):
        x = layer_norm(ALPHA * x + 0.5 * swiglu(x, ffn1_w_gate[l], ffn1_w_up[l], ffn1_w_down[l]),
                       ln1_g[l], ln1_b[l])
        p = x @ w_in[l]
        p_rwkv, p_conv, q_mem, gate_logits = jnp.split(p, cuts, axis=-1)
        y_rwkv = rwkv7_branch(p_rwkv, rwkv_mu[l], rwkv_w0[l], rwkv_w_up[l], rwkv_a0[l],
                              rwkv_a_up[l], rwkv_g_up[l], rwkv_k_k[l], rwkv_k_a[l],
                              rwkv_r_k[l], rwkv_gn_g[l], rwkv_gn_b[l])
        y_conv = shortconv_branch(p_conv, conv_w[l])
        y_mem = memory_xattn_branch(q_mem, mem, mem_ln_g[l], mem_ln_b[l], w_mem_kv[l])
        ys = jnp.stack([y_rwkv, y_conv, y_mem], axis=2)
        proj = jnp.einsum('btnc,ncd->btnd', ys, w_branch[l])
        gates = jax.nn.sigmoid(gate_logits.reshape(b, t, N_BRANCH, d) + gate_b[l])
        mixed = jnp.sum(gates * proj, axis=2) @ w_out[l]
        x = layer_norm(ALPHA * x + mixed, ln2_g[l], ln2_b[l])
        x = layer_norm(ALPHA * x + 0.5 * swiglu(x, ffn2_w_gate[l], ffn2_w_up[l], ffn2_w_down[l]),
                       ln3_g[l], ln3_b[l])
    return x
```

```cpp
#include <hip/hip_runtime.h>
#include <cstdio>

#ifndef PHMASK
#define PHMASK 0x7fff
#endif
#define PH_EN(k) (((PHMASK) >> (k)) & 1)
#ifndef MK_ONE_LAUNCH
#define MK_ONE_LAUNCH 1
#endif

#define LAS __attribute__((address_space(3)))
#define GAS __attribute__((address_space(1)))
typedef unsigned short bf16_t;
typedef short bf16x8 __attribute__((ext_vector_type(8)));
typedef float f32x4 __attribute__((ext_vector_type(4)));
typedef float f32x2 __attribute__((ext_vector_type(2)));
typedef unsigned u32x4 __attribute__((ext_vector_type(4)));
typedef unsigned u32x2 __attribute__((ext_vector_type(2)));

constexpr int DM = 2048, BATCH = 2, SEQ = 4096, M = BATCH * SEQ, DEPTH = 2, NMEM = 256, FF = 5504;
constexpr int RW = 1024, DIN = 13696, DINP = 13824;
constexpr int PC_R = 0, PC_K = 1024, PC_V = 2048, PC_LR = 3072, PC_CB = 3456, PC_CC = 4480, PC_CH = 5504, PC_Q = 6528, PC_G = 7552;
constexpr int LRK = 384, LRN = 5120;
constexpr float ALPHA = 1.41421356237309515f;
constexpr float LN_EPS = 1e-5f, GN_EPS = 64e-5f, DECAY_SCALE = 0.606531f;
constexpr int NPH = 15;

enum { I_X = 0, I_MEM, I_F1G, I_F1U, I_F1D, I_LN1G, I_LN1B, I_WIN, I_MU, I_W0, I_WUP, I_A0, I_AUP, I_GUP, I_KK, I_KA, I_RK, I_GNG, I_GNB, I_CONVW,
       I_MLNG, I_MLNB, I_WKV, I_WBR, I_GATEB, I_WOUT, I_LN2G, I_LN2B, I_F2G, I_F2U, I_F2D, I_LN3G, I_LN3B, N_IN };

constexpr size_t MiB = 1u << 20;
constexpr size_t WS_CTL = 0, CTL_BYTES = 1 * MiB;
constexpr size_t WS_WGU1 = 1 * MiB;
constexpr size_t WS_WD1 = WS_WGU1 + 43 * MiB;
constexpr size_t WS_WIN = WS_WD1 + 22 * MiB;
constexpr size_t WS_WKV = WS_WIN + 54 * MiB;
constexpr size_t WS_WBR = WS_WKV + 8 * MiB;
constexpr size_t WS_WOUT = WS_WBR + 12 * MiB;
constexpr size_t WS_WGU2 = WS_WOUT + 8 * MiB;
constexpr size_t WS_WD2 = WS_WGU2 + 43 * MiB;
constexpr size_t WS_WLR = WS_WD2 + 22 * MiB;
constexpr size_t WS_X = WS_WLR + 4 * MiB;
constexpr size_t WS_XB = WS_X + 64 * MiB;
constexpr size_t WS_H = WS_XB + 32 * MiB;
constexpr size_t WS_P = WS_H + 86 * MiB;
constexpr size_t WS_W2 = WS_P + 216 * MiB;
constexpr size_t WS_A2 = WS_W2 + 64 * MiB;
constexpr size_t WS_R = WS_A2 + 64 * MiB;
constexpr size_t WS_K = WS_R + 16 * MiB;
constexpr size_t WS_V = WS_K + 16 * MiB;
constexpr size_t WS_KK = WS_V + 16 * MiB;
constexpr size_t WS_G = WS_KK + 16 * MiB;
constexpr size_t WS_ACAT = WS_G + 16 * MiB;
constexpr size_t WS_YS = WS_ACAT + 6 * MiB;
constexpr size_t WS_MEMN = WS_YS + 48 * MiB;
constexpr size_t WS_KMEM = WS_MEMN + 2 * MiB;
constexpr size_t WS_VT = WS_KMEM + 1 * MiB;
constexpr size_t WS_END = WS_VT + 1 * MiB;
constexpr size_t WS_YF = WS_H, WS_YB = WS_H + 32 * MiB, WS_MIXF = WS_H, WS_MIXB = WS_XB;
constexpr int CW_BAR = 4096;

constexpr int LDS_MISC = 140 * 1024;
constexpr int LDS_BYTES = 147456;

__device__ __forceinline__ unsigned cvt_pk_bf16(float lo, float hi) { unsigned r; asm volatile("v_cvt_pk_bf16_f32 %0, %1, %2" : "=v"(r) : "v"(lo), "v"(hi)); return r; }
__device__ __forceinline__ float bflo(unsigned w) { return __uint_as_float(w << 16); }
__device__ __forceinline__ float bfhi(unsigned w) { return __uint_as_float(w & 0xffff0000u); }
__device__ __forceinline__ void unpack8(const u32x4 w, float (&f)[8]) { f[0] = bflo(w.x); f[1] = bfhi(w.x); f[2] = bflo(w.y); f[3] = bfhi(w.y); f[4] = bflo(w.z); f[5] = bfhi(w.z); f[6] = bflo(w.w); f[7] = bfhi(w.w); }
__device__ __forceinline__ u32x4 pack8(const float (&f)[8]) { u32x4 w; w.x = cvt_pk_bf16(f[0], f[1]); w.y = cvt_pk_bf16(f[2], f[3]); w.z = cvt_pk_bf16(f[4], f[5]); w.w = cvt_pk_bf16(f[6], f[7]); return w; }
__device__ __forceinline__ float sigmoidf_(float x) { return __builtin_amdgcn_rcpf(1.0f + __expf(-x)); }
__device__ __forceinline__ float wave_sum(float v) {
#pragma unroll
    for (int o = 1; o < 64; o <<= 1) v += __shfl_xor(v, o);
    return v;
}
__device__ __forceinline__ float sum8(float v) { v += __shfl_xor(v, 1); v += __shfl_xor(v, 2); v += __shfl_xor(v, 4); return v; }

namespace pg8 {
constexpr int BM = 256, BK = 64, HALF = 128, HTB = HALF * BK * 2, STAGE_BYTES = 8 * HTB, NXCD = 8, WGM = 8;
__host__ __device__ __forceinline__ int lds_byte(int r, int c) { const int st = (r >> 4) * 2 + (c >> 5), rr = r & 15, cc = c & 31, ob = rr * 64 + cc * 2; return st * 1024 + (ob ^ (((ob >> 9) & 1) << 5)); }
__host__ __device__ __forceinline__ void stage_rc(int b, int& R, int& C) { const int st = b / 1024, sb = b % 1024, swz = sb ^ (((sb >> 9) & 1) << 5); R = (st >> 1) * 16 + swz / 64; C = (st & 1) * 32 + (swz % 64) / 2; }
__host__ __device__ __forceinline__ int perm32(int rho) { const int n = rho >> 4, i = rho & 15; return 8 * (i >> 2) + 4 * n + (i & 3); }
struct Unit { int pm, pn; };
struct Gemm { const bf16_t* A; const bf16_t* Bt; int M, N, K, lda, ldb; };
struct StaticOrder {
    int nM, nN, nwg, G, c;
    __host__ __device__ void init(int M_, int N_, int G_, int c_) { nM = M_ / BM; nN = N_ / BM; nwg = nM * nN; G = G_; c = c_; }
    __host__ __device__ bool next(int i, Unit& u) const {
        const long L = (long)i * G + c; if (L >= nwg) return false;
        int wgid = (int)L; { const int q = nwg / NXCD, r = nwg % NXCD, xcd = wgid % NXCD, off = wgid / NXCD; wgid = (xcd < r ? xcd * (q + 1) : r * (q + 1) + (xcd - r) * q) + off; }
        const int nig = WGM * nN, gid = wgid / nig, fm = gid * WGM, gsz = (nM - fm) < WGM ? (nM - fm) : WGM;
        u.pm = fm + ((wgid % nig) % gsz); u.pn = (wgid % nig) / gsz; return true;
    }
    __device__ __forceinline__ void a_ready(const Unit&) const {}
    __device__ __forceinline__ void done(const Unit&) const {}
};
template <class Epi, class Sched, bool ALIGN_EPI = false, bool SP2 = false>
__device__ __forceinline__ void gemm_phase(LAS unsigned char* lds, const Gemm g, const Sched& S, const Epi& E) {
    int tid_ = threadIdx.x; asm volatile("" : "+v"(tid_));
    const int tid = tid_, wid = __builtin_amdgcn_readfirstlane(tid >> 6), lane = tid & 63, wr = wid >> 2, wc = wid & 3, fr = lane & 15, fq = lane >> 4;
    const int K = g.K, nt = K / BK;
    unsigned voffA[2], voffB[2];
#pragma unroll
    for (int i = 0; i < 2; ++i) { int R, C; stage_rc(tid * 16 + i * 8192, R, C); const int Rb = Epi::PERM ? ((R & ~31) + perm32(R & 31)) : R;
        voffA[i] = (unsigned)(R * g.lda + C) * 2u; voffB[i] = (unsigned)(Rb * g.ldb + C) * 2u; }
    const size_t kstep = (size_t)(BK * 2);
    const size_t hsA = (size_t)HALF * g.lda * 2, hsB = (size_t)HALF * g.ldb * 2;
    const size_t tsA = 2 * hsA, tsB = 2 * hsB;
    const unsigned ldsw = (unsigned)wid * 1024u;
    const int aoff = lds_byte(wr * 64 + fr, fq * 8), boff = lds_byte(wc * 32 + fr, fq * 8);
#define PG8_SA(b, h) (((b) * 2 + (h)) * HTB)
#define PG8_SB(b, h) ((4 + (b) * 2 + (h)) * HTB)
#define PG8_STAGE(bufoff, gbase, voff) do { _Pragma("unroll") for (int _i = 0; _i < 2; ++_i) \
        __builtin_amdgcn_global_load_lds((const unsigned*)((const char*)(gbase) + (voff)[_i]), (LAS unsigned*)(lds + (bufoff) + ldsw + _i * 8192), 16, 0, 0); } while (0)
#define PG8_LDA(dst, b, h) do { _Pragma("unroll") for (int m = 0; m < 4; ++m) _Pragma("unroll") for (int k = 0; k < 2; ++k) dst[m][k] = *(const LAS bf16x8*)(lds + PG8_SA(b, h) + aoff + m * 2048 + k * 1024); } while (0)
#define PG8_LDB(dst, b, h) do { _Pragma("unroll") for (int n = 0; n < 2; ++n) _Pragma("unroll") for (int k = 0; k < 2; ++k) dst[n][k] = *(const LAS bf16x8*)(lds + PG8_SB(b, h) + boff + n * 2048 + k * 1024); } while (0)
#define PG8_MMA(ai, bj, At, Bt) do { __builtin_amdgcn_s_setprio(1); _Pragma("unroll") for (int m = 0; m < 4; ++m) _Pragma("unroll") for (int n = 0; n < 2; ++n) _Pragma("unroll") for (int k = 0; k < 2; ++k) \
        acc[ai][bj][m][n] = __builtin_amdgcn_mfma_f32_16x16x32_bf16(Bt[n][k], At[m][k], acc[ai][bj][m][n], 0, 0, 0); __builtin_amdgcn_s_setprio(0); } while (0)
#define PG8_WAIT_V(n) asm volatile("s_waitcnt vmcnt(" #n ")" ::: "memory")
#define PG8_WAIT_L(n) asm volatile("s_waitcnt lgkmcnt(" #n ")" ::: "memory")
#define PG8_BAR __builtin_amdgcn_s_barrier()
#define PG8_SCHED __builtin_amdgcn_sched_barrier(0)
    Unit cur, nxt; int ui = 0;
    if (!S.next(0, cur)) return;
    f32x4 acc[2][2][4][2];
#pragma unroll
    for (int a = 0; a < 2; ++a)
#pragma unroll
        for (int b = 0; b < 2; ++b)
#pragma unroll
            for (int m = 0; m < 4; ++m)
#pragma unroll
                for (int n = 0; n < 2; ++n) acc[a][b][m][n] = (f32x4){0.f, 0.f, 0.f, 0.f};
    bf16x8 At[4][2], B0[2][2], B1[2][2];
    const char* cA = (const char*)g.A + (size_t)cur.pm * tsA; const char* cB = (const char*)g.Bt + (size_t)cur.pn * tsB;
    S.a_ready(cur);
    if constexpr (SP2) {
        PG8_STAGE(PG8_SB(0, 0), cB, voffB); PG8_STAGE(PG8_SB(0, 1), cB + hsB, voffB); PG8_STAGE(PG8_SA(0, 0), cA, voffA); PG8_STAGE(PG8_SA(0, 1), cA + hsA, voffA);
        if (wr == 1) PG8_BAR;
        PG8_WAIT_V(2); PG8_BAR;
        PG8_STAGE(PG8_SB(1, 0), cB + kstep, voffB); PG8_STAGE(PG8_SA(1, 0), cA + kstep, voffA); PG8_STAGE(PG8_SB(1, 1), cB + hsB + kstep, voffB);
        PG8_WAIT_V(6); PG8_BAR;
    } else {
        PG8_STAGE(PG8_SB(0, 0), cB, voffB); PG8_STAGE(PG8_SA(0, 0), cA, voffA); PG8_STAGE(PG8_SB(0, 1), cB + hsB, voffB); PG8_STAGE(PG8_SA(0, 1), cA + hsA, voffA);
        if (wr == 1) PG8_BAR;
        PG8_WAIT_V(4); PG8_BAR;
        PG8_STAGE(PG8_SB(1, 0), cB + kstep, voffB); PG8_STAGE(PG8_SA(1, 0), cA + kstep, voffA); PG8_STAGE(PG8_SB(1, 1), cB + hsB + kstep, voffB);
        PG8_WAIT_V(6); PG8_BAR;
    }
    for (;;) {
        const bool has_next = S.next(ui + 1, nxt);
        const char* nA = has_next ? (const char*)g.A + (size_t)nxt.pm * tsA : cA; const char* nB = has_next ? (const char*)g.Bt + (size_t)nxt.pn * tsB : cB;
#pragma nounroll
        for (int t = 0; t < nt; t += 2) {
            const bool last = (t == nt - 2);
            const char* a1 = cA + (size_t)(t + 1) * kstep;
            const char* a2 = last ? nA : cA + (size_t)(t + 2) * kstep; const char* b2 = last ? nB : cB + (size_t)(t + 2) * kstep;
            const char* a3 = a2 + kstep; const char* b3 = b2 + kstep;
            if (last && has_next) S.a_ready(nxt);
            if constexpr (SP2) {
            PG8_LDB(B0, 0, 0); PG8_LDB(B1, 0, 1); PG8_SCHED; PG8_LDA(At, 0, 0); PG8_STAGE(PG8_SA(1, 1), a1 + hsA, voffA);
            PG8_WAIT_V(8); PG8_WAIT_L(0); PG8_BAR; PG8_MMA(0, 0, At, B0); PG8_MMA(0, 1, At, B1); PG8_BAR; PG8_SCHED;
            PG8_LDA(At, 0, 1); PG8_STAGE(PG8_SB(0, 0), b2, voffB); PG8_STAGE(PG8_SB(0, 1), b2 + hsB, voffB); PG8_STAGE(PG8_SA(0, 0), a2, voffA);
            PG8_WAIT_V(8); PG8_WAIT_L(0); PG8_BAR; PG8_MMA(1, 0, At, B0); PG8_MMA(1, 1, At, B1); PG8_BAR; PG8_SCHED;
            PG8_LDB(B0, 1, 0); PG8_LDB(B1, 1, 1); PG8_SCHED; PG8_LDA(At, 1, 0); PG8_STAGE(PG8_SA(0, 1), a2 + hsA, voffA);
            PG8_WAIT_V(8); PG8_WAIT_L(0); PG8_BAR; PG8_MMA(0, 0, At, B0); PG8_MMA(0, 1, At, B1); PG8_BAR; PG8_SCHED;
            PG8_LDA(At, 1, 1); PG8_STAGE(PG8_SB(1, 0), b3, voffB); PG8_STAGE(PG8_SB(1, 1), b3 + hsB, voffB); PG8_STAGE(PG8_SA(1, 0), a3, voffA);
            PG8_WAIT_V(8); PG8_WAIT_L(0); PG8_BAR; PG8_MMA(1, 0, At, B0); PG8_MMA(1, 1, At, B1); PG8_BAR; PG8_SCHED;
            } else {
            PG8_LDB(B0, 0, 0); PG8_SCHED; PG8_LDA(At, 0, 0); PG8_STAGE(PG8_SA(1, 1), a1 + hsA, voffA);
            PG8_WAIT_L(8); PG8_BAR; PG8_WAIT_L(0); PG8_MMA(0, 0, At, B0); PG8_BAR; PG8_SCHED;
            PG8_LDB(B1, 0, 1); PG8_STAGE(PG8_SB(0, 0), b2, voffB);
            PG8_BAR; PG8_WAIT_L(0); PG8_MMA(0, 1, At, B1); PG8_BAR;
            PG8_LDA(At, 0, 1); PG8_STAGE(PG8_SA(0, 0), a2, voffA);
            PG8_BAR; PG8_WAIT_L(0); PG8_MMA(1, 0, At, B0); PG8_BAR; PG8_SCHED;
            PG8_STAGE(PG8_SB(0, 1), b2 + hsB, voffB);
            PG8_WAIT_V(6); PG8_BAR; PG8_MMA(1, 1, At, B1); PG8_BAR;
            PG8_LDB(B0, 1, 0); PG8_SCHED; PG8_LDA(At, 1, 0); PG8_STAGE(PG8_SA(0, 1), a2 + hsA, voffA);
            PG8_WAIT_L(8); PG8_BAR; PG8_WAIT_L(0); PG8_MMA(0, 0, At, B0); PG8_BAR; PG8_SCHED;
            PG8_LDB(B1, 1, 1); PG8_STAGE(PG8_SB(1, 0), b3, voffB);
            PG8_BAR; PG8_WAIT_L(0); PG8_MMA(0, 1, At, B1); PG8_BAR;
            PG8_LDA(At, 1, 1); PG8_STAGE(PG8_SA(1, 0), a3, voffA);
            PG8_BAR; PG8_WAIT_L(0); PG8_MMA(1, 0, At, B0); PG8_BAR; PG8_SCHED;
            PG8_STAGE(PG8_SB(1, 1), b3 + hsB, voffB);
            PG8_WAIT_V(6); PG8_BAR; PG8_MMA(1, 1, At, B1); PG8_BAR;
            }
        }
        if constexpr (ALIGN_EPI) { if (wr == 0) PG8_BAR; }
        E(acc, cur, wr, wc, fr, fq); S.done(cur);
        if (!has_next) break;
#pragma unroll
        for (int a = 0; a < 2; ++a)
#pragma unroll
            for (int b = 0; b < 2; ++b)
#pragma unroll
                for (int m = 0; m < 4; ++m)
#pragma unroll
                    for (int n = 0; n < 2; ++n) acc[a][b][m][n] = (f32x4){0.f, 0.f, 0.f, 0.f};
        cur = nxt; cA = nA; cB = nB; ++ui;
        if constexpr (ALIGN_EPI) { if (wr == 1) PG8_BAR; }
    }
    PG8_WAIT_V(0);
    if constexpr (!ALIGN_EPI) { if (wr == 0) PG8_BAR; }
    PG8_BAR;
#undef PG8_SA
#undef PG8_SB
#undef PG8_STAGE
#undef PG8_LDA
#undef PG8_LDB
#undef PG8_MMA
#undef PG8_WAIT_V
#undef PG8_WAIT_L
#undef PG8_BAR
#undef PG8_SCHED
}

struct EpiBf16 {
    static constexpr bool PERM = true;
    bf16_t* O; int ldc;
    __device__ __forceinline__ void operator()(const f32x4 (&acc)[2][2][4][2], const Unit& u, int wr, int wc, int fr, int fq) const {
        const int row0 = u.pm * BM + wr * 64 + fr, col0 = u.pn * BM + wc * 32 + 8 * fq;
#pragma unroll
        for (int ai = 0; ai < 2; ++ai)
#pragma unroll
            for (int m = 0; m < 4; ++m) { bf16_t* rowp = O + (size_t)(row0 + ai * HALF + m * 16) * ldc + col0;
#pragma unroll
                for (int bj = 0; bj < 2; ++bj) { const f32x4 v0 = acc[ai][bj][m][0], v1 = acc[ai][bj][m][1];
                    u32x4 w; w.x = cvt_pk_bf16(v0[0], v0[1]); w.y = cvt_pk_bf16(v0[2], v0[3]); w.z = cvt_pk_bf16(v1[0], v1[1]); w.w = cvt_pk_bf16(v1[2], v1[3]);
                    *(u32x4*)(rowp + bj * HALF) = w; } }
    }
};
struct EpiSwiglu {
    static constexpr bool PERM = true;
    bf16_t* H; int ldh;
    __device__ __forceinline__ void operator()(const f32x4 (&acc)[2][2][4][2], const Unit& u, int wr, int wc, int fr, int fq) const {
        const int row0 = u.pm * BM + wr * 64 + fr, col0 = u.pn * HALF + wc * 32 + 8 * fq;
#pragma unroll
        for (int ai = 0; ai < 2; ++ai)
#pragma unroll
            for (int m = 0; m < 4; ++m) { bf16_t* rowp = H + (size_t)(row0 + ai * HALF + m * 16) * ldh + col0;
                float h[8];
#pragma unroll
                for (int n = 0; n < 2; ++n)
#pragma unroll
                    for (int j = 0; j < 4; ++j) { const float gt = acc[ai][0][m][n][j], up = acc[ai][1][m][n][j]; h[n * 4 + j] = gt * __builtin_amdgcn_rcpf(1.0f + __expf(-gt)) * up; }
                *(u32x4*)rowp = pack8(h); }
    }
};
struct EpiRes {
    static constexpr bool PERM = false;
    const float* base; float* out; int ldc; float alpha, beta;
    __device__ __forceinline__ void operator()(const f32x4 (&acc)[2][2][4][2], const Unit& u, int wr, int wc, int fr, int fq) const {
        const int row0 = u.pm * BM + wr * 64 + fr, col0 = u.pn * BM + wc * 32 + 4 * fq;
#pragma unroll
        for (int ai = 0; ai < 2; ++ai)
#pragma unroll
            for (int m = 0; m < 4; ++m) { const size_t off = (size_t)(row0 + ai * HALF + m * 16) * ldc + col0;
#pragma unroll
                for (int bj = 0; bj < 2; ++bj)
#pragma unroll
                    for (int n = 0; n < 2; ++n) { const f32x4 b = *(const f32x4*)(base + off + bj * HALF + n * 16); *(f32x4*)(out + off + bj * HALF + n * 16) = b * alpha + acc[ai][bj][m][n] * beta; } }
    }
};
template <int KIND> struct EpiLR {
    static constexpr bool PERM = false;
    float* O32; bf16_t* G; const float* bias;
    __device__ __forceinline__ void operator()(const f32x4 (&acc)[2][2][4][2], const Unit& u, int wr, int wc, int fr, int fq) const {
        const int row0 = u.pm * BM + wr * 64 + fr, col0 = u.pn * BM + wc * 32 + 4 * fq;
#pragma unroll
        for (int bj = 0; bj < 2; ++bj)
#pragma unroll
            for (int n = 0; n < 2; ++n) { const int col = col0 + bj * HALF + n * 16;
                if (KIND < 2) { const f32x4 bb = *(const f32x4*)(bias + col); float* dst = O32 + (size_t)(col >> 10) * M * RW + (col & 1023);
#pragma unroll
                    for (int ai = 0; ai < 2; ++ai)
#pragma unroll
                        for (int m = 0; m < 4; ++m) { f32x4 o;
#pragma unroll
                            for (int j = 0; j < 4; ++j) { const float sg = sigmoidf_(acc[ai][bj][m][n][j] + bb[j]); o[j] = KIND == 0 ? __expf(-DECAY_SCALE * sg) : sg; }
                            *(f32x4*)(dst + (size_t)(row0 + ai * HALF + m * 16) * RW) = o; }
                } else { bf16_t* dst = G + col;
#pragma unroll
                    for (int ai = 0; ai < 2; ++ai)
#pragma unroll
                        for (int m = 0; m < 4; ++m) { const f32x4 v = acc[ai][bj][m][n]; u32x2 w; w.x = cvt_pk_bf16(v[0], v[1]); w.y = cvt_pk_bf16(v[2], v[3]);
                            *(u32x2*)(dst + (size_t)(row0 + ai * HALF + m * 16) * RW) = w; }
                } }
    }
};
template <int BR> struct EpiGate {
    static constexpr bool PERM = false;
    const bf16_t* P; const float* gb; float* MIXF; bf16_t* MIXB;
    __device__ __forceinline__ void operator()(const f32x4 (&acc)[2][2][4][2], const Unit& u, int wr, int wc, int fr, int fq) const {
        const int row0 = u.pm * BM + wr * 64 + fr, col0 = u.pn * BM + wc * 32 + 4 * fq;
#pragma unroll
        for (int bj = 0; bj < 2; ++bj)
#pragma unroll
            for (int n = 0; n < 2; ++n) { const int col = col0 + bj * HALF + n * 16; const f32x4 bb = *(const f32x4*)(gb + BR * DM + col);
#pragma unroll
                for (int ai = 0; ai < 2; ++ai)
#pragma unroll
                    for (int m = 0; m < 4; ++m) { const int row = row0 + ai * HALF + m * 16;
                        const u32x2 gl = *(const u32x2*)(P + (size_t)row * DINP + PC_G + BR * DM + col);
                        f32x4 v;
                        v[0] = sigmoidf_(bflo(gl.x) + bb[0]) * acc[ai][bj][m][n][0]; v[1] = sigmoidf_(bfhi(gl.x) + bb[1]) * acc[ai][bj][m][n][1];
                        v[2] = sigmoidf_(bflo(gl.y) + bb[2]) * acc[ai][bj][m][n][2]; v[3] = sigmoidf_(bfhi(gl.y) + bb[3]) * acc[ai][bj][m][n][3];
                        float* mp = MIXF + (size_t)row * DM + col;
                        if (BR == 0) *(f32x4*)mp = v;
                        else if (BR == 1) *(f32x4*)mp = *(const f32x4*)mp + v;
                        else { const f32x4 t = *(const f32x4*)mp + v; u32x2 w; w.x = cvt_pk_bf16(t[0], t[1]); w.y = cvt_pk_bf16(t[2], t[3]); *(u32x2*)(MIXB + (size_t)row * DM + col) = w; } } }
    }
};
}

#define XB_TMO      128
#define XB_XCNT(j)  (256  + 64 * (j))
#define XB_XSUB(j)  (1280 + 64 * (j))
#define XB_XGEN(j)  (2304 + 64 * (j))
#define XB_TOP      3328
#define XB_TOPGEN   3392
#define XCD_BAR_WORDS 3456
#define XB_SPIN_CAP (1u << 18)
__device__ __forceinline__ unsigned xb_ld(unsigned* p)              { return __hip_atomic_load(p, __ATOMIC_RELAXED, __HIP_MEMORY_SCOPE_AGENT); }
__device__ __forceinline__ unsigned xb_add(unsigned* p, unsigned v) { return __hip_atomic_fetch_add(p, v, __ATOMIC_RELAXED, __HIP_MEMORY_SCOPE_AGENT); }
__device__ __forceinline__ unsigned xb_xcc_id() { return (unsigned)__builtin_amdgcn_s_getreg((3 << 11) | 20) & 0xFu; }
#define XB_SPIN(cond, bar) do { unsigned _sp = 0; while (cond) { __builtin_amdgcn_s_sleep(1); \
    if ((++_sp & 255u) == 0u) { if (xb_ld(&(bar)[XB_TMO])) break; if (_sp > XB_SPIN_CAP) { atomicAdd(&(bar)[XB_TMO], 1u); break; } } } } while (0)
struct XcdBarrier { unsigned* bar; unsigned x; volatile LAS unsigned* st; };
__device__ __forceinline__ XcdBarrier xcd_barrier_post(unsigned* bar, volatile LAS unsigned* st) {
    XcdBarrier b; b.bar = bar; b.x = xb_xcc_id(); b.st = st;
    if (threadIdx.x == 0) (void)xb_add(&bar[XB_XCNT(b.x)], 1u);
    return b;
}
__device__ __forceinline__ void xcd_barrier_complete(unsigned* bar, unsigned x, unsigned& nloc, unsigned& nx) {
    const unsigned G = gridDim.x * gridDim.y * gridDim.z;
    unsigned sum, cnt, mine, sp = 0u;
    for (;;) {
        sum = 0u; cnt = 0u; mine = 0u;
#pragma unroll
        for (unsigned j = 0; j < 16; ++j) { const unsigned c = xb_ld(&bar[XB_XCNT(j)]); sum += c; cnt += (c > 0u) ? 1u : 0u; mine = (j == x) ? c : mine; }
        if (sum == G) break;
        __builtin_amdgcn_s_sleep(1);
        if ((++sp & 255u) == 0u) { if (xb_ld(&bar[XB_TMO])) break; if (sp > XB_SPIN_CAP) { atomicAdd(&bar[XB_TMO], 1u); break; } }
    }
    nloc = mine > 0u ? mine : 1u; nx = cnt > 0u ? cnt : 1u;
}
__device__ __forceinline__ void xcd_barrier(const XcdBarrier& b) {
    asm volatile("s_waitcnt vmcnt(0)" ::: "memory");
    __syncthreads();
    if (threadIdx.x == 0) {
        unsigned* bar = b.bar;
        __builtin_amdgcn_s_waitcnt(0);
        unsigned nloc = b.st[0], nx = b.st[1];
        if (nloc == 0u) { xcd_barrier_complete(bar, b.x, nloc, nx); b.st[0] = nloc; b.st[1] = nx; }
        const unsigned old = xb_add(&bar[XB_XSUB(b.x)], 1u);
        const unsigned gen = old / nloc;
        if (old + 1u == (gen + 1u) * nloc) {
            __builtin_amdgcn_fence(__ATOMIC_RELEASE, "agent");
            asm volatile("s_waitcnt vmcnt(0)" ::: "memory");
            const unsigned og = xb_add(&bar[XB_TOP], 1u);
            const unsigned tg = og / nx;
            if (og + 1u == (tg + 1u) * nx) xb_add(&bar[XB_TOPGEN], 1u);
            else XB_SPIN(xb_ld(&bar[XB_TOPGEN]) == tg, bar);
            __builtin_amdgcn_fence(__ATOMIC_ACQUIRE, "agent");
            xb_add(&bar[XB_XGEN(b.x)], 1u);
            asm volatile("s_waitcnt vmcnt(0)" ::: "memory");
        } else {
            XB_SPIN(xb_ld(&bar[XB_XGEN(b.x)]) == gen, bar);
            __builtin_amdgcn_fence(__ATOMIC_ACQUIRE, "agent");
            asm volatile("s_waitcnt vmcnt(0)" ::: "memory");
        }
    }
    __syncthreads();
}

struct Args { const float* in[N_IN]; float* out; unsigned char* ws; int ph_lo, ph_hi; };
typedef const __attribute__((address_space(4))) Args* KArgs;
__device__ __forceinline__ KArgs kargs() { KArgs p = (KArgs)__builtin_amdgcn_kernarg_segment_ptr(); asm volatile("" : "+s"(p)); return p; }

template <int MODE>
__device__ __forceinline__ void cvt_tile(const float* W, int K, int N, bf16_t* WT, int item, int lane) {
    const int nblk = N / 32, kb = item / nblk, nb = item - kb * nblk, k0 = kb * 64, n0 = nb * 32;
    const int n4 = lane & 7, kg = lane >> 3;
    const float* src = W + (size_t)(k0 + kg * 8) * N + n0 + n4 * 4;
    f32x4 v[8];
#pragma unroll
    for (int kk = 0; kk < 8; ++kk) v[kk] = *(const f32x4*)(src + (size_t)kk * N);
    int drow = n0 + n4 * 4;
    if (MODE == 1) drow = (drow >> 7) * 256 + (drow & 127);
    if (MODE == 2) drow = (drow >> 7) * 256 + 128 + (drow & 127);
    bf16_t* dst = WT + (size_t)drow * K + k0 + kg * 8;
#pragma unroll
    for (int j = 0; j < 4; ++j) { u32x4 w; w.x = cvt_pk_bf16(v[0][j], v[1][j]); w.y = cvt_pk_bf16(v[2][j], v[3][j]); w.z = cvt_pk_bf16(v[4][j], v[5][j]); w.w = cvt_pk_bf16(v[6][j], v[7][j]);
        *(u32x4*)(dst + (size_t)j * K) = w; }
}

__device__ __forceinline__ void phase_cvt(KArgs a, int l, int gw, int NGW, int lane) {
    unsigned char* ws = a->ws;
    const float* f1g = a->in[I_F1G] + (size_t)l * DM * FF; const float* f1u = a->in[I_F1U] + (size_t)l * DM * FF; const float* f1d = a->in[I_F1D] + (size_t)l * FF * DM;
    const float* f2g = a->in[I_F2G] + (size_t)l * DM * FF; const float* f2u = a->in[I_F2U] + (size_t)l * DM * FF; const float* f2d = a->in[I_F2D] + (size_t)l * FF * DM;
    const float* win = a->in[I_WIN] + (size_t)l * DM * DIN; const float* wkv = a->in[I_WKV] + (size_t)l * DM * DM; const float* wbr = a->in[I_WBR] + (size_t)l * 3 * RW * DM;
    const float* wout = a->in[I_WOUT] + (size_t)l * DM * DM;
    constexpr int T_GU = (DM / 64) * (FF / 32), T_D = (FF / 64) * (DM / 32), T_IN = (DM / 64) * (DIN / 32), T_SQ = (DM / 64) * (DM / 32), T_BR = (RW / 64) * (DM / 32);
    constexpr int NIT = 4 * T_GU + 2 * T_D + T_IN + 2 * T_SQ + 3 * T_BR;
    for (int it = gw; it < NIT; it += NGW) {
        int r = it;
        if (r < T_GU) { cvt_tile<1>(f1g, DM, FF, (bf16_t*)(ws + WS_WGU1), r, lane); continue; } r -= T_GU;
        if (r < T_GU) { cvt_tile<2>(f1u, DM, FF, (bf16_t*)(ws + WS_WGU1), r, lane); continue; } r -= T_GU;
        if (r < T_D) { cvt_tile<0>(f1d, FF, DM, (bf16_t*)(ws + WS_WD1), r, lane); continue; } r -= T_D;
        if (r < T_IN) { cvt_tile<0>(win, DM, DIN, (bf16_t*)(ws + WS_WIN), r, lane); continue; } r -= T_IN;
        if (r < T_SQ) { cvt_tile<0>(wkv, DM, DM, (bf16_t*)(ws + WS_WKV), r, lane); continue; } r -= T_SQ;
        if (r < T_BR) { cvt_tile<0>(wbr, RW, DM, (bf16_t*)(ws + WS_WBR), r, lane); continue; } r -= T_BR;
        if (r < T_BR) { cvt_tile<0>(wbr + (size_t)RW * DM, RW, DM, (bf16_t*)(ws + WS_WBR) + (size_t)DM * RW, r, lane); continue; } r -= T_BR;
        if (r < T_BR) { cvt_tile<0>(wbr + (size_t)2 * RW * DM, RW, DM, (bf16_t*)(ws + WS_WBR) + (size_t)2 * DM * RW, r, lane); continue; } r -= T_BR;
        if (r < T_SQ) { cvt_tile<0>(wout, DM, DM, (bf16_t*)(ws + WS_WOUT), r, lane); continue; } r -= T_SQ;
        if (r < T_GU) { cvt_tile<1>(f2g, DM, FF, (bf16_t*)(ws + WS_WGU2), r, lane); continue; } r -= T_GU;
        if (r < T_GU) { cvt_tile<2>(f2u, DM, FF, (bf16_t*)(ws + WS_WGU2), r, lane); continue; } r -= T_GU;
        cvt_tile<0>(f2d, FF, DM, (bf16_t*)(ws + WS_WD2), r, lane);
    }
    { u32x4* z = (u32x4*)((bf16_t*)(ws + WS_WIN) + (size_t)DIN * DM); const int nz = (DINP - DIN) * DM / 8;
      for (int i = gw * 64 + lane; i < nz; i += NGW * 64) z[i] = (u32x4){0u, 0u, 0u, 0u}; }
    { const float* wup = a->in[I_WUP] + (size_t)l * 2 * 64 * RW; const float* aup = a->in[I_AUP] + (size_t)l * 2 * 64 * RW; const float* gup = a->in[I_GUP] + (size_t)l * 128 * RW;
      bf16_t* wlr = (bf16_t*)(ws + WS_WLR);
      for (int i = gw * 64 + lane; i < LRN * (LRK / 8); i += NGW * 64) { const int n = i / (LRK / 8), kc = (i - n * (LRK / 8)) * 8; const int blk = n >> 10, nn = n & 1023;
          const int kb0 = blk < 4 ? 64 * blk : 256, kb1 = blk < 4 ? kb0 + 64 : 384;
          const float* src = blk < 2 ? wup + (size_t)blk * 64 * RW : (blk < 4 ? aup + (size_t)(blk - 2) * 64 * RW : gup);
          float f[8];
#pragma unroll
          for (int e = 0; e < 8; ++e) { const int k = kc + e; f[e] = (k >= kb0 && k < kb1) ? src[(size_t)(k - kb0) * RW + nn] : 0.f; }
          *(u32x4*)(wlr + (size_t)n * LRK + kc) = pack8(f); } }
    if (l == 0) { const f32x4* xs = (const f32x4*)a->in[I_X]; u32x2* xb = (u32x2*)(ws + WS_XB);
        for (size_t i = (size_t)gw * 64 + lane; i < (size_t)M * DM / 4; i += (size_t)NGW * 64) { const f32x4 v = xs[i]; u32x2 w; w.x = cvt_pk_bf16(v[0], v[1]); w.y = cvt_pk_bf16(v[2], v[3]); xb[i] = w; } }
    { const float* mg = a->in[I_MLNG] + (size_t)l * DM; const float* mb = a->in[I_MLNB] + (size_t)l * DM; bf16_t* memn = (bf16_t*)(ws + WS_MEMN);
      for (int m = gw; m < BATCH * NMEM; m += NGW) {
          const f32x4* xr = (const f32x4*)(a->in[I_MEM] + (size_t)m * DM) + lane; f32x4 v[8]; float s = 0.f;
#pragma unroll
          for (int j = 0; j < 8; ++j) { v[j] = xr[64 * j]; s += (v[j][0] + v[j][1]) + (v[j][2] + v[j][3]); }
          const float mean = wave_sum(s) * (1.f / DM); float s2 = 0.f;
#pragma unroll
          for (int j = 0; j < 8; ++j) { v[j] = v[j] - mean; s2 += (v[j][0] * v[j][0] + v[j][1] * v[j][1]) + (v[j][2] * v[j][2] + v[j][3] * v[j][3]); }
          const float rstd = rsqrtf(wave_sum(s2) * (1.f / DM) + LN_EPS);
#pragma unroll
          for (int j = 0; j < 8; ++j) { const f32x4 gg = *((const f32x4*)mg + lane + 64 * j), bb = *((const f32x4*)mb + lane + 64 * j); const f32x4 y = v[j] * rstd * gg + bb;
              u32x2 w; w.x = cvt_pk_bf16(y[0], y[1]); w.y = cvt_pk_bf16(y[2], y[3]); *((u32x2*)(memn + (size_t)m * DM) + lane + 64 * j) = w; } } }
}

__device__ __forceinline__ void phase_ln(const float* src, float* dst, bf16_t* dstb, const float* g, const float* b, int gw, int NGW, int lane) {
    for (int m = gw; m < M; m += NGW) {
        const f32x4* xr = (const f32x4*)(src + (size_t)m * DM) + lane; f32x4 v[8]; float s = 0.f;
#pragma unroll
        for (int j = 0; j < 8; ++j) { v[j] = xr[64 * j]; s += (v[j][0] + v[j][1]) + (v[j][2] + v[j][3]); }
        const float mean = wave_sum(s) * (1.f / DM); float s2 = 0.f;
#pragma unroll
        for (int j = 0; j < 8; ++j) { v[j] = v[j] - mean; s2 += (v[j][0] * v[j][0] + v[j][1] * v[j][1]) + (v[j][2] * v[j][2] + v[j][3] * v[j][3]); }
        const float rstd = rsqrtf(wave_sum(s2) * (1.f / DM) + LN_EPS);
#pragma unroll
        for (int j = 0; j < 8; ++j) { const f32x4 gg = *((const f32x4*)g + lane + 64 * j), bb = *((const f32x4*)b + lane + 64 * j); const f32x4 y = v[j] * rstd * gg + bb;
            *((f32x4*)(dst + (size_t)m * DM) + lane + 64 * j) = y;
            if (dstb) { u32x2 w; w.x = cvt_pk_bf16(y[0], y[1]); w.y = cvt_pk_bf16(y[2], y[3]); *((u32x2*)(dstb + (size_t)m * DM) + lane + 64 * j) = w; } }
    }
}

__device__ __forceinline__ void phase_elt(KArgs a, int l, int gw, int NGW, int lane) {
    unsigned char* ws = a->ws;
    const bf16_t* P = (const bf16_t*)(ws + WS_P);
    bf16_t* Rb = (bf16_t*)(ws + WS_R); bf16_t* Kb = (bf16_t*)(ws + WS_K); bf16_t* Vb = (bf16_t*)(ws + WS_V); bf16_t* KKb = (bf16_t*)(ws + WS_KK);
    bf16_t* AC = (bf16_t*)(ws + WS_ACAT); bf16_t* YS = (bf16_t*)(ws + WS_YS);
    const float* mu = a->in[I_MU] + (size_t)l * 3456; const float* k_k = a->in[I_KK] + (size_t)l * RW; const float* cw = a->in[I_CONVW] + (size_t)l * 3 * RW;
    for (int m = gw; m < M; m += NGW) {
        const int t = m & (SEQ - 1); const bool hp = t > 0, hn = t < SEQ - 1;
        const bf16_t* pc = P + (size_t)m * DINP;
#pragma unroll
        for (int j = 0; j < 7; ++j) {
            const int c0 = 8 * (lane + 64 * j);
            if (j == 6 && lane >= 48) continue;
            const u32x4 zc = (u32x4){0u, 0u, 0u, 0u};
            const u32x4 wc_ = *(const u32x4*)(pc + c0); const u32x4 wp = hp ? *(const u32x4*)(pc - DINP + c0) : zc; const u32x4 wn = hn ? *(const u32x4*)(pc + DINP + c0) : zc;
            float cu[8], pv[8], nx[8], s[8]; unpack8(wc_, cu); unpack8(wp, pv); unpack8(wn, nx);
            const f32x4 m0 = *(const f32x4*)(mu + c0), m1 = *(const f32x4*)(mu + c0 + 4);
#pragma unroll
            for (int e = 0; e < 8; ++e) { const float mm = e < 4 ? m0[e] : m1[e - 4]; s[e] = cu[e] + mm * (0.5f * (pv[e] + nx[e]) - cu[e]); }
            if (j < 2) { *(u32x4*)(Rb + (size_t)m * RW + c0) = pack8(s); }
            else if (j < 4) { const int c = c0 - 1024; *(u32x4*)(Kb + (size_t)m * RW + c) = pack8(s);
                const f32x4 k0 = *(const f32x4*)(k_k + c), k1 = *(const f32x4*)(k_k + c + 4); float kx[8]; float ss = 0.f;
#pragma unroll
                for (int e = 0; e < 8; ++e) { kx[e] = s[e] * (e < 4 ? k0[e] : k1[e - 4]); ss += kx[e] * kx[e]; }
                ss = sum8(ss); const float inv = rsqrtf(ss + 1e-12f);
#pragma unroll
                for (int e = 0; e < 8; ++e) kx[e] *= inv;
                *(u32x4*)(KKb + (size_t)m * RW + c) = pack8(kx); }
            else if (j < 6) { *(u32x4*)(Vb + (size_t)m * RW + (c0 - 2048)) = pack8(s); }
            else { const int cc = c0 - 3072; float f[8];
#pragma unroll
                for (int e = 0; e < 8; ++e) f[e] = cc < 128 ? tanhf(s[e]) : (cc < 256 ? s[e] : sigmoidf_(s[e]));
                *(u32x4*)(AC + (size_t)m * LRK + cc) = pack8(f); }
        }
#pragma unroll
        for (int j = 0; j < 2; ++j) {
            const int c = 8 * (lane + 64 * j);
            const u32x4 zc = (u32x4){0u, 0u, 0u, 0u};
            float gbv[8], gc[8], hh[8], up[8], uc[8], un[8];
            unpack8(*(const u32x4*)(pc + PC_CB + c), gbv);
            unpack8(*(const u32x4*)(pc + PC_CC + c), gc); unpack8(*(const u32x4*)(pc + PC_CH + c), hh);
#pragma unroll
            for (int e = 0; e < 8; ++e) uc[e] = gc[e] * hh[e];
            unpack8(hp ? *(const u32x4*)(pc - DINP + PC_CC + c) : zc, gc); unpack8(hp ? *(const u32x4*)(pc - DINP + PC_CH + c) : zc, hh);
#pragma unroll
            for (int e = 0; e < 8; ++e) up[e] = gc[e] * hh[e];
            unpack8(hn ? *(const u32x4*)(pc + DINP + PC_CC + c) : zc, gc); unpack8(hn ? *(const u32x4*)(pc + DINP + PC_CH + c) : zc, hh);
#pragma unroll
            for (int e = 0; e < 8; ++e) un[e] = gc[e] * hh[e];
            float o[8];
#pragma unroll
            for (int e = 0; e < 8; ++e) o[e] = gbv[e] * (cw[c + e] * up[e] + cw[RW + c + e] * uc[e] + cw[2 * RW + c + e] * un[e]);
            *(u32x4*)(YS + (size_t)m * 3072 + 1024 + c) = pack8(o);
        }
    }
}

constexpr int XA_PITCH = 528;
__device__ __forceinline__ void xattn_unit(KArgs a, int unit, LAS unsigned char* lds, int tid, int wave, int lane) {
    unsigned char* ws = a->ws;
    const bf16_t* P = (const bf16_t*)(ws + WS_P); const bf16_t* KM = (const bf16_t*)(ws + WS_KMEM); const bf16_t* VT = (const bf16_t*)(ws + WS_VT); bf16_t* YS = (bf16_t*)(ws + WS_YS);
    const int bb = unit >> 7, h = (unit >> 5) & 3, qt = unit & 31, fr = lane & 15, fq = lane >> 4;
    const int mrow = bb * SEQ + qt * 128 + wave * 16 + fr;
    bf16x8 qf[8];
#pragma unroll
    for (int ks = 0; ks < 8; ++ks) qf[ks] = *(const bf16x8*)(P + (size_t)mrow * DINP + PC_Q + h * 256 + 32 * ks + 8 * fq);
#pragma unroll 4
    for (int it = 0; it < 16; ++it) { const int idx = tid + 512 * it, key = idx >> 5, ch = idx & 31;
        const u32x4 v = *(const u32x4*)(KM + (size_t)(bb * NMEM + key) * 1024 + h * 256 + ch * 8);
        *(LAS u32x4*)(lds + key * XA_PITCH + ch * 16) = v; }
    __syncthreads();
    f32x4 sacc[16];
#pragma unroll
    for (int kb = 0; kb < 16; ++kb) { f32x4 acc = (f32x4){0.f, 0.f, 0.f, 0.f};
#pragma unroll
        for (int ks = 0; ks < 8; ++ks) { const bf16x8 kf = *(const LAS bf16x8*)(lds + (kb * 16 + fr) * XA_PITCH + (32 * ks + 8 * fq) * 2);
            acc = __builtin_amdgcn_mfma_f32_16x16x32_bf16(kf, qf[ks], acc, 0, 0, 0); }
        sacc[kb] = acc; }
    float mx = -3.0e38f;
#pragma unroll
    for (int kb = 0; kb < 16; ++kb)
#pragma unroll
        for (int i = 0; i < 4; ++i) mx = fmaxf(mx, sacc[kb][i]);
    mx = fmaxf(mx, __shfl_xor(mx, 16)); mx = fmaxf(mx, __shfl_xor(mx, 32));
    float sum = 0.f;
#pragma unroll
    for (int kb = 0; kb < 16; ++kb)
#pragma unroll
        for (int i = 0; i < 4; ++i) { const float p = __expf((sacc[kb][i] - mx) * 0.0625f); sacc[kb][i] = p; sum += p; }
    sum += __shfl_xor(sum, 16); sum += __shfl_xor(sum, 32);
    const float rs = 1.0f / sum;
    bf16x8 pf[8];
#pragma unroll
    for (int s2 = 0; s2 < 8; ++s2) { u32x4 w; w.x = cvt_pk_bf16(sacc[2 * s2][0], sacc[2 * s2][1]); w.y = cvt_pk_bf16(sacc[2 * s2][2], sacc[2 * s2][3]);
        w.z = cvt_pk_bf16(sacc[2 * s2 + 1][0], sacc[2 * s2 + 1][1]); w.w = cvt_pk_bf16(sacc[2 * s2 + 1][2], sacc[2 * s2 + 1][3]); pf[s2] = __builtin_bit_cast(bf16x8, w); }
    __syncthreads();
#pragma unroll 4
    for (int it = 0; it < 16; ++it) { const int idx = tid + 512 * it, d = idx >> 5, ch = idx & 31;
        const u32x4 v = *(const u32x4*)(VT + (size_t)(h * 256 + d) * 512 + bb * NMEM + ch * 8);
        *(LAS u32x4*)(lds + d * XA_PITCH + ch * 16) = v; }
    __syncthreads();
#pragma unroll
    for (int db = 0; db < 16; ++db) { f32x4 acc = (f32x4){0.f, 0.f, 0.f, 0.f};
#pragma unroll
        for (int s2 = 0; s2 < 8; ++s2) { const LAS unsigned char* rp = lds + (db * 16 + fr) * XA_PITCH;
            const u32x2 lo = *(const LAS u32x2*)(rp + (32 * s2 + 4 * fq) * 2), hi = *(const LAS u32x2*)(rp + (32 * s2 + 16 + 4 * fq) * 2);
            u32x4 w; w.x = lo.x; w.y = lo.y; w.z = hi.x; w.w = hi.y;
            acc = __builtin_amdgcn_mfma_f32_16x16x32_bf16(__builtin_bit_cast(bf16x8, w), pf[s2], acc, 0, 0, 0); }
        u32x2 o; o.x = cvt_pk_bf16(acc[0] * rs, acc[1] * rs); o.y = cvt_pk_bf16(acc[2] * rs, acc[3] * rs);
        *(u32x2*)(YS + (size_t)mrow * 3072 + 2048 + h * 256 + db * 16 + 4 * fq) = o; }
    __syncthreads();
}

constexpr int SC_TC = 32;
constexpr int SC_BUF = SC_TC * 5 * 64 * 4;
constexpr int SC_VOFF = SC_BUF, SC_YOFF = SC_BUF + SC_TC * 16 * 4, SC_STRIDE = SC_YOFF + SC_TC * 16 * 4;
__device__ __forceinline__ void phase_scan(KArgs a, int l, int wgid, LAS unsigned char* lds, int tid, int wave, int lane) {
    unsigned char* ws = a->ws;
    const int seq = wgid >> 2, rq = wgid & 3, dir = seq >> 5, bb = (seq >> 4) & 1, h = seq & 15;
    const float* W2 = (const float*)(ws + WS_W2) + (size_t)dir * M * RW; const float* A2 = (const float*)(ws + WS_A2) + (size_t)dir * M * RW;
    const bf16_t* KKb = (const bf16_t*)(ws + WS_KK); const bf16_t* Kb = (const bf16_t*)(ws + WS_K); const bf16_t* Rb = (const bf16_t*)(ws + WS_R); const bf16_t* Vb = (const bf16_t*)(ws + WS_V);
    float* Y = (float*)(ws + (dir ? WS_YB : WS_YF));
    const float* k_a = a->in[I_KA] + (size_t)l * RW;
    const int ss = tid >> 4, kq = tid & 15;
    const f32x4 ka4 = *(const f32x4*)(k_a + h * 64 + 4 * kq);
    f32x4 gw_, ga_; u32x2 gkk, gk, gr; unsigned short gv;
#define SC_LOAD(ci) do { const int tk = (ci) * SC_TC + ss; const int tok = dir ? (SEQ - 1 - tk) : tk; const size_t mo = (size_t)(bb * SEQ + tok) * RW + h * 64; \
        gw_ = *(const f32x4*)(W2 + mo + 4 * kq); ga_ = *(const f32x4*)(A2 + mo + 4 * kq); gkk = *(const u32x2*)(KKb + mo + 4 * kq); gk = *(const u32x2*)(Kb + mo + 4 * kq); gr = *(const u32x2*)(Rb + mo + 4 * kq); \
        gv = Vb[mo + rq * 16 + kq]; } while (0)
#define SC_STORE(buf) do { LAS unsigned char* bp = lds + (buf) * SC_STRIDE; LAS float* vp = (LAS float*)(bp + (ss * 5) * 256 + kq * 16); \
        f32x4 kk4 = (f32x4){bflo(gkk.x), bfhi(gkk.x), bflo(gkk.y), bfhi(gkk.y)}; f32x4 k4 = (f32x4){bflo(gk.x), bfhi(gk.x), bflo(gk.y), bfhi(gk.y)}; f32x4 r4 = (f32x4){bflo(gr.x), bfhi(gr.x), bflo(gr.y), bfhi(gr.y)}; \
        *(LAS f32x4*)(vp) = gw_; *(LAS f32x4*)(vp + 64) = kk4; *(LAS f32x4*)(vp + 128) = kk4 * ga_; *(LAS f32x4*)(vp + 192) = k4 * (1.0f + (ga_ - 1.0f) * ka4); *(LAS f32x4*)(vp + 256) = r4; \
        ((LAS float*)(bp + SC_VOFF))[ss * 16 + kq] = __uint_as_float((unsigned)gv << 16); } while (0)
    const int rowsel = lane >> 5, kp = lane & 31, myrow = 2 * wave + rowsel;
    float S0 = 0.f, S1 = 0.f;
    SC_LOAD(0); SC_STORE(0);
    __syncthreads();
    constexpr int NCH = SEQ / SC_TC;
    for (int ci = 0; ci < NCH; ++ci) {
        const int buf = ci & 1;
        if (ci + 1 < NCH) SC_LOAD(ci + 1);
        const LAS unsigned char* bp = lds + buf * SC_STRIDE;
        const LAS float* vb = (const LAS float*)(bp + SC_VOFF); LAS float* yb = (LAS float*)(lds + buf * SC_STRIDE + SC_YOFF);
#pragma unroll 4
        for (int s = 0; s < SC_TC; ++s) {
            const LAS float* vp = (const LAS float*)(bp + s * 5 * 256) + 2 * kp;
            const f32x2 w2 = *(const LAS f32x2*)(vp), kk2 = *(const LAS f32x2*)(vp + 64), b2 = *(const LAS f32x2*)(vp + 128), kd2 = *(const LAS f32x2*)(vp + 192), r2 = *(const LAS f32x2*)(vp + 256);
            const float vv = vb[s * 16 + myrow];
            float d = S0 * kk2.x + S1 * kk2.y;
            d += __shfl_xor(d, 1); d += __shfl_xor(d, 2); d += __shfl_xor(d, 4); d += __shfl_xor(d, 8); d += __shfl_xor(d, 16);
            S0 = S0 * w2.x + (vv * kd2.x - d * b2.x);
            S1 = S1 * w2.y + (vv * kd2.y - d * b2.y);
            float y = S0 * r2.x + S1 * r2.y;
            y += __shfl_xor(y, 1); y += __shfl_xor(y, 2); y += __shfl_xor(y, 4); y += __shfl_xor(y, 8); y += __shfl_xor(y, 16);
            if (kp == 0) yb[s * 16 + myrow] = y;
        }
        if (ci + 1 < NCH) SC_STORE(buf ^ 1);
        __syncthreads();
        { const int tk = ci * SC_TC + ss; const int tok = dir ? (SEQ - 1 - tk) : tk;
          Y[(size_t)(bb * SEQ + tok) * RW + h * 64 + rq * 16 + kq] = ((const LAS float*)(lds + buf * SC_STRIDE + SC_YOFF))[ss * 16 + kq]; }
    }
    __syncthreads();
#undef SC_LOAD
#undef SC_STORE
}

__device__ __forceinline__ void phase_post(KArgs a, int l, int gw, int NGW, int lane) {
    unsigned char* ws = a->ws;
    const float* YF = (const float*)(ws + WS_YF); const float* YB = (const float*)(ws + WS_YB);
    const float* A0 = (const float*)(ws + WS_A2); const float* A1 = A0 + (size_t)M * RW;
    const bf16_t* Rb = (const bf16_t*)(ws + WS_R); const bf16_t* Kb = (const bf16_t*)(ws + WS_K); const bf16_t* Vb = (const bf16_t*)(ws + WS_V); const bf16_t* Gb = (const bf16_t*)(ws + WS_G);
    bf16_t* YS = (bf16_t*)(ws + WS_YS);
    const float* k_a = a->in[I_KA] + (size_t)l * RW; const float* r_k = a->in[I_RK] + (size_t)l * RW; const float* gng = a->in[I_GNG] + (size_t)l * RW; const float* gnb = a->in[I_GNB] + (size_t)l * RW;
    for (int m = gw; m < M; m += NGW) {
#pragma unroll
        for (int j = 0; j < 2; ++j) {
            const int c = 8 * (lane + 64 * j); const size_t o = (size_t)m * RW + c;
            float y[8], rr[8], kk[8], vv[8], gg[8], a0[8], a1[8];
            { const f32x4 f0 = *(const f32x4*)(YF + o), f1 = *(const f32x4*)(YF + o + 4), b0 = *(const f32x4*)(YB + o), b1 = *(const f32x4*)(YB + o + 4);
#pragma unroll
              for (int e = 0; e < 4; ++e) { y[e] = f0[e] + b0[e]; y[4 + e] = f1[e] + b1[e]; } }
            { const f32x4 p0 = *(const f32x4*)(A0 + o), p1 = *(const f32x4*)(A0 + o + 4), q0 = *(const f32x4*)(A1 + o), q1 = *(const f32x4*)(A1 + o + 4);
#pragma unroll
              for (int e = 0; e < 4; ++e) { a0[e] = p0[e]; a0[4 + e] = p1[e]; a1[e] = q0[e]; a1[4 + e] = q1[e]; } }
            unpack8(*(const u32x4*)(Rb + o), rr); unpack8(*(const u32x4*)(Kb + o), kk); unpack8(*(const u32x4*)(Vb + o), vv); unpack8(*(const u32x4*)(Gb + o), gg);
            float s = 0.f;
#pragma unroll
            for (int e = 0; e < 8; ++e) s += y[e];
            const float mean = sum8(s) * (1.f / 64.f); float q = 0.f;
#pragma unroll
            for (int e = 0; e < 8; ++e) { y[e] -= mean; q += y[e] * y[e]; }
            const float rstd = rsqrtf(sum8(q) * (1.f / 64.f) + GN_EPS);
            float bs = 0.f;
#pragma unroll
            for (int e = 0; e < 8; ++e) { const float kb = kk[e] * (1.0f + (0.5f * (a0[e] + a1[e]) - 1.0f) * k_a[c + e]); bs += rr[e] * kb * r_k[c + e]; }
            bs = sum8(bs);
            float ov[8];
#pragma unroll
            for (int e = 0; e < 8; ++e) ov[e] = (y[e] * rstd * gng[c + e] + gnb[c + e] + bs * vv[e]) * gg[e];
            *(u32x4*)(YS + (size_t)m * 3072 + c) = pack8(ov);
        }
    }
}

__global__ void __launch_bounds__(512, 2) mk_fwd(Args args) {
    extern __shared__ __attribute__((aligned(16))) unsigned char lds_raw[];
    LAS unsigned char* lds = (LAS unsigned char*)lds_raw;
    volatile LAS unsigned* MISC = (volatile LAS unsigned*)(lds + LDS_MISC);
    for (int u = threadIdx.x; u < 64; u += 512) MISC[u] = 0u;
    __syncthreads();
    const int lo = args.ph_lo, hi = args.ph_hi;
    XcdBarrier bar = xcd_barrier_post((unsigned*)(args.ws + WS_CTL) + CW_BAR, MISC + 8);
#define PH_LOCALS() int tid = threadIdx.x; asm volatile("" : "+v"(tid)); int bid = blockIdx.x; asm volatile("" : "+s"(bid)); int G = gridDim.x; asm volatile("" : "+s"(G)); \
    const int lane = tid & 63, wave = __builtin_amdgcn_readfirstlane(tid >> 6), gw = bid * 8 + wave, NGW = G * 8; \
    unsigned char* ws = kargs()->ws; (void)lane; (void)gw; (void)ws; (void)NGW
#define IN(k) (lo <= (k) && (k) < hi)
#define SEAM(k) do { if ((k) + 1 < hi) xcd_barrier(bar); } while (0)
    using namespace pg8;
#define XB ((bf16_t*)(ws + WS_XB))
#define X ((float*)(ws + WS_X))
#define H ((bf16_t*)(ws + WS_H))
#define P ((bf16_t*)(ws + WS_P))

    for (int l = 0; l < DEPTH; ++l) {
        const int pb = l * NPH;
        if (PH_EN(0) && IN(pb + 0)) { PH_LOCALS(); phase_cvt(kargs(), l, gw, NGW, lane); SEAM(pb + 0); }
        if (PH_EN(1) && IN(pb + 1)) { PH_LOCALS();
            { Gemm g{XB, (const bf16_t*)(ws + WS_WGU1), M, 2 * FF, DM, DM, DM}; StaticOrder S; S.init(M, 2 * FF, G, bid); EpiSwiglu E{H, FF};
              gemm_phase<EpiSwiglu, StaticOrder, true, true>(lds, g, S, E); }
            { Gemm g{(const bf16_t*)(ws + WS_MEMN), (const bf16_t*)(ws + WS_WKV), BATCH * NMEM, 1024, DM, DM, DM}; StaticOrder S; S.init(BATCH * NMEM, 1024, G, bid); EpiBf16 E{(bf16_t*)(ws + WS_KMEM), 1024};
              gemm_phase<EpiBf16, StaticOrder, true, true>(lds, g, S, E); }
            { Gemm g{(const bf16_t*)(ws + WS_WKV) + (size_t)1024 * DM, (const bf16_t*)(ws + WS_MEMN), 1024, BATCH * NMEM, DM, DM, DM}; StaticOrder S; S.init(1024, BATCH * NMEM, G, bid); EpiBf16 E{(bf16_t*)(ws + WS_VT), BATCH * NMEM};
              gemm_phase<EpiBf16, StaticOrder, true, true>(lds, g, S, E); }
            SEAM(pb + 1);
        }
        if (PH_EN(2) && IN(pb + 2)) { PH_LOCALS();
            Gemm g{H, (const bf16_t*)(ws + WS_WD1), M, DM, FF, FF, FF}; StaticOrder S; S.init(M, DM, G, bid); EpiRes E{l == 0 ? kargs()->in[I_X] : X, X, DM, ALPHA, 0.5f};
            gemm_phase<EpiRes, StaticOrder, false, true>(lds, g, S, E);
            SEAM(pb + 2);
        }
        if (PH_EN(3) && IN(pb + 3)) { PH_LOCALS(); phase_ln(X, X, XB, kargs()->in[I_LN1G] + (size_t)l * DM, kargs()->in[I_LN1B] + (size_t)l * DM, gw, NGW, lane); SEAM(pb + 3); }
        if (PH_EN(4) && IN(pb + 4)) { PH_LOCALS();
            Gemm g{XB, (const bf16_t*)(ws + WS_WIN), M, DINP, DM, DM, DM}; StaticOrder S; S.init(M, DINP, G, bid); EpiBf16 E{P, DINP};
            gemm_phase<EpiBf16, StaticOrder, true, true>(lds, g, S, E);
            SEAM(pb + 4);
        }
        if (PH_EN(5) && IN(pb + 5)) { PH_LOCALS(); phase_elt(kargs(), l, gw, NGW, lane); SEAM(pb + 5); }
        if (PH_EN(6) && IN(pb + 6)) { PH_LOCALS();
            { Gemm g{(const bf16_t*)(ws + WS_ACAT), (const bf16_t*)(ws + WS_WLR), M, 2048, LRK, LRK, LRK}; StaticOrder S; S.init(M, 2048, G, bid);
              EpiLR<0> E{(float*)(ws + WS_W2), nullptr, kargs()->in[I_W0] + (size_t)l * 2 * RW}; gemm_phase<EpiLR<0>, StaticOrder, false, true>(lds, g, S, E); }
            { Gemm g{(const bf16_t*)(ws + WS_ACAT), (const bf16_t*)(ws + WS_WLR) + (size_t)2048 * LRK, M, 2048, LRK, LRK, LRK}; StaticOrder S; S.init(M, 2048, G, bid);
              EpiLR<1> E{(float*)(ws + WS_A2), nullptr, kargs()->in[I_A0] + (size_t)l * 2 * RW}; gemm_phase<EpiLR<1>, StaticOrder, false, true>(lds, g, S, E); }
            { Gemm g{(const bf16_t*)(ws + WS_ACAT), (const bf16_t*)(ws + WS_WLR) + (size_t)4096 * LRK, M, 1024, LRK, LRK, LRK}; StaticOrder S; S.init(M, 1024, G, bid);
              EpiLR<2> E{nullptr, (bf16_t*)(ws + WS_G), nullptr}; gemm_phase<EpiLR<2>, StaticOrder, false, true>(lds, g, S, E); }
            for (int u = bid; u < 256; u += G) xattn_unit(kargs(), u, lds, tid, wave, lane);
            SEAM(pb + 6);
        }
        if (PH_EN(7) && IN(pb + 7)) { PH_LOCALS(); for (int u = bid; u < 256; u += G) phase_scan(kargs(), l, u, lds, tid, wave, lane); SEAM(pb + 7); }
        if (PH_EN(8) && IN(pb + 8)) { PH_LOCALS(); phase_post(kargs(), l, gw, NGW, lane); SEAM(pb + 8); }
        if (PH_EN(9) && IN(pb + 9)) { PH_LOCALS();
            const bf16_t* YS = (const bf16_t*)(ws + WS_YS); const bf16_t* WBR = (const bf16_t*)(ws + WS_WBR); const float* gb = kargs()->in[I_GATEB] + (size_t)l * 3 * DM;
            float* MIXF = (float*)(ws + WS_MIXF); bf16_t* MIXB = (bf16_t*)(ws + WS_MIXB);
            { Gemm g{YS, WBR, M, DM, RW, 3072, RW}; StaticOrder S; S.init(M, DM, G, bid); EpiGate<0> E{P, gb, MIXF, MIXB}; gemm_phase<EpiGate<0>, StaticOrder, false, true>(lds, g, S, E); }
            { Gemm g{YS + 1024, WBR + (size_t)DM * RW, M, DM, RW, 3072, RW}; StaticOrder S; S.init(M, DM, G, bid); EpiGate<1> E{P, gb, MIXF, MIXB}; gemm_phase<EpiGate<1>, StaticOrder, false, true>(lds, g, S, E); }
            { Gemm g{YS + 2048, WBR + (size_t)2 * DM * RW, M, DM, RW, 3072, RW}; StaticOrder S; S.init(M, DM, G, bid); EpiGate<2> E{P, gb, MIXF, MIXB}; gemm_phase<EpiGate<2>, StaticOrder, false, true>(lds, g, S, E); }
            SEAM(pb + 9);
        }
        if (PH_EN(10) && IN(pb + 10)) { PH_LOCALS();
            Gemm g{(const bf16_t*)(ws + WS_MIXB), (const bf16_t*)(ws + WS_WOUT), M, DM, DM, DM, DM}; StaticOrder S; S.init(M, DM, G, bid); EpiRes E{X, X, DM, ALPHA, 1.0f};
            gemm_phase<EpiRes, StaticOrder, false, true>(lds, g, S, E);
            SEAM(pb + 10);
        }
        if (PH_EN(11) && IN(pb + 11)) { PH_LOCALS(); phase_ln(X, X, XB, kargs()->in[I_LN2G] + (size_t)l * DM, kargs()->in[I_LN2B] + (size_t)l * DM, gw, NGW, lane); SEAM(pb + 11); }
        if (PH_EN(12) && IN(pb + 12)) { PH_LOCALS();
            Gemm g{XB, (const bf16_t*)(ws + WS_WGU2), M, 2 * FF, DM, DM, DM}; StaticOrder S; S.init(M, 2 * FF, G, bid); EpiSwiglu E{H, FF};
            gemm_phase<EpiSwiglu, StaticOrder, true, true>(lds, g, S, E);
            SEAM(pb + 12);
        }
        if (PH_EN(13) && IN(pb + 13)) { PH_LOCALS();
            Gemm g{H, (const bf16_t*)(ws + WS_WD2), M, DM, FF, FF, FF}; StaticOrder S; S.init(M, DM, G, bid); EpiRes E{X, X, DM, ALPHA, 0.5f};
            gemm_phase<EpiRes, StaticOrder, false, true>(lds, g, S, E);
            SEAM(pb + 13);
        }
        if (PH_EN(14) && IN(pb + 14)) { PH_LOCALS(); phase_ln(X, l == DEPTH - 1 ? kargs()->out : X, l == DEPTH - 1 ? (bf16_t*)nullptr : XB, kargs()->in[I_LN3G] + (size_t)l * DM, kargs()->in[I_LN3B] + (size_t)l * DM, gw, NGW, lane); SEAM(pb + 14); }
    }
#undef IN
#undef SEAM
#undef XB
#undef X
#undef H
#undef P
#undef PH_LOCALS
}

extern "C" void kernel_launch(void* const* d_in, const int* in_sizes, int n_in, void* d_out, int out_size, void* d_ws, size_t ws_size, hipStream_t stream) {
    static int grid = 0;
    if (grid == 0) {
        if (n_in != N_IN || out_size != M * DM || ws_size < WS_END) { fprintf(stderr, "kernel_launch: unexpected problem (n_in %d, out %d, ws %zu < %zu)\n", n_in, out_size, ws_size, (size_t)WS_END); grid = -1; return; }
        int dev = 0, cus = 0, per_cu = 0;
        if (hipGetDevice(&dev) != hipSuccess || hipDeviceGetAttribute(&cus, hipDeviceAttributeMultiprocessorCount, dev) != hipSuccess) { grid = -1; return; }
        if (hipFuncSetAttribute((const void*)mk_fwd, hipFuncAttributeMaxDynamicSharedMemorySize, LDS_BYTES) != hipSuccess) { fprintf(stderr, "kernel_launch: hipFuncSetAttribute failed\n"); grid = -1; return; }
        if (hipOccupancyMaxActiveBlocksPerMultiprocessor(&per_cu, (const void*)mk_fwd, 512, LDS_BYTES) != hipSuccess || per_cu < 1) fprintf(stderr, "kernel_launch: occupancy query says %d\n", per_cu);
        (void)hipGetLastError();
        grid = cus;
    }
    if (grid < 0) return;
    (void)hipMemsetAsync((char*)d_ws + WS_CTL, 0, CTL_BYTES, stream);
    Args a{};
    for (int i = 0; i < N_IN; ++i) a.in[i] = (const float*)d_in[i];
    a.out = (float*)d_out; a.ws = (unsigned char*)d_ws;
#if MK_ONE_LAUNCH
    a.ph_lo = 0; a.ph_hi = DEPTH * NPH;
    hipLaunchKernelGGL(mk_fwd, dim3(grid), dim3(512), LDS_BYTES, stream, a);
#else
    for (int p = 0; p < DEPTH * NPH; ++p) { a.ph_lo = p; a.ph_hi = p + 1; hipLaunchKernelGGL(mk_fwd, dim3(grid), dim3(512), LDS_BYTES, stream, a); }
#endif
}
```

```cpp
#include <hip/hip_runtime.h>
#include <cstdio>

#ifndef PHMASK
#define PHMASK 0x7fff
#endif
#define PH_EN(k) (((PHMASK) >> (k)) & 1)
#ifndef DUP_PHASE
#define DUP_PHASE -1
#endif
#ifndef MK_ONE_LAUNCH
#define MK_ONE_LAUNCH 1
#endif

#define LAS __attribute__((address_space(3)))
#define GAS __attribute__((address_space(1)))
typedef unsigned short bf16_t;
typedef short bf16x8 __attribute__((ext_vector_type(8)));
typedef float f32x4 __attribute__((ext_vector_type(4)));
typedef float f32x2 __attribute__((ext_vector_type(2)));
typedef unsigned u32x4 __attribute__((ext_vector_type(4)));
typedef unsigned u32x2 __attribute__((ext_vector_type(2)));

constexpr int DM = 2048, BATCH = 2, SEQ = 4096, M = BATCH * SEQ, DEPTH = 2, NMEM = 256, FF = 5504;
constexpr int RW = 1024, DIN = 13696, DINP = 13824;
constexpr int PC_R = 0, PC_K = 1024, PC_V = 2048, PC_LR = 3072, PC_CB = 3456, PC_CC = 4480, PC_CH = 5504, PC_Q = 6528, PC_G = 7552;
constexpr int LRK = 384, LRN = 5120;
constexpr float ALPHA = 1.41421356237309515f;
constexpr float LN_EPS = 1e-5f, GN_EPS = 64e-5f, DECAY_SCALE = 0.606531f;
constexpr int NPH = 15;

enum { I_X = 0, I_MEM, I_F1G, I_F1U, I_F1D, I_LN1G, I_LN1B, I_WIN, I_MU, I_W0, I_WUP, I_A0, I_AUP, I_GUP, I_KK, I_KA, I_RK, I_GNG, I_GNB, I_CONVW,
       I_MLNG, I_MLNB, I_WKV, I_WBR, I_GATEB, I_WOUT, I_LN2G, I_LN2B, I_F2G, I_F2U, I_F2D, I_LN3G, I_LN3B, N_IN };

constexpr size_t MiB = 1u << 20;
constexpr size_t WS_CTL = 0, CTL_BYTES = 1 * MiB;
constexpr size_t WS_WGU1 = 1 * MiB;
constexpr size_t WS_WD1 = WS_WGU1 + 43 * MiB;
constexpr size_t WS_WIN = WS_WD1 + 22 * MiB;
constexpr size_t WS_WKV = WS_WIN + 54 * MiB;
constexpr size_t WS_WBR = WS_WKV + 8 * MiB;
constexpr size_t WS_WOUT = WS_WBR + 12 * MiB;
constexpr size_t WS_WGU2 = WS_WOUT + 8 * MiB;
constexpr size_t WS_WD2 = WS_WGU2 + 43 * MiB;
constexpr size_t WS_WLR = WS_WD2 + 22 * MiB;
constexpr size_t WS_X = WS_WLR + 4 * MiB;
constexpr size_t WS_XB = WS_X + 64 * MiB;
constexpr size_t WS_H = WS_XB + 32 * MiB;
constexpr size_t WS_P = WS_H + 86 * MiB;
constexpr size_t WS_W2 = WS_P + 216 * MiB;
constexpr size_t WS_A2 = WS_W2 + 64 * MiB;
constexpr size_t WS_R = WS_A2 + 64 * MiB;
constexpr size_t WS_K = WS_R + 16 * MiB;
constexpr size_t WS_V = WS_K + 16 * MiB;
constexpr size_t WS_KK = WS_V + 16 * MiB;
constexpr size_t WS_G = WS_KK + 16 * MiB;
constexpr size_t WS_ACAT = WS_G + 16 * MiB;
constexpr size_t WS_YS = WS_ACAT + 6 * MiB;
constexpr size_t WS_MEMN = WS_YS + 48 * MiB;
constexpr size_t WS_KMEM = WS_MEMN + 2 * MiB;
constexpr size_t WS_VT = WS_KMEM + 1 * MiB;
constexpr size_t WS_END = WS_VT + 1 * MiB;
constexpr size_t WS_YF = WS_H, WS_YB = WS_H + 32 * MiB, WS_MIXF = WS_H, WS_MIXB = WS_XB;
constexpr int CW_BAR = 4096;

constexpr int LDS_MISC = 140 * 1024;
constexpr int LDS_BYTES = 147456;

__device__ __forceinline__ unsigned cvt_pk_bf16(float lo, float hi) { unsigned r; asm volatile("v_cvt_pk_bf16_f32 %0, %1, %2" : "=v"(r) : "v"(lo), "v"(hi)); return r; }
__device__ __forceinline__ float bflo(unsigned w) { return __uint_as_float(w << 16); }
__device__ __forceinline__ float bfhi(unsigned w) { return __uint_as_float(w & 0xffff0000u); }
__device__ __forceinline__ void unpack8(const u32x4 w, float (&f)[8]) { f[0] = bflo(w.x); f[1] = bfhi(w.x); f[2] = bflo(w.y); f[3] = bfhi(w.y); f[4] = bflo(w.z); f[5] = bfhi(w.z); f[6] = bflo(w.w); f[7] = bfhi(w.w); }
__device__ __forceinline__ u32x4 pack8(const float (&f)[8]) { u32x4 w; w.x = cvt_pk_bf16(f[0], f[1]); w.y = cvt_pk_bf16(f[2], f[3]); w.z = cvt_pk_bf16(f[4], f[5]); w.w = cvt_pk_bf16(f[6], f[7]); return w; }
__device__ __forceinline__ float sigmoidf_(float x) { return __builtin_amdgcn_rcpf(1.0f + __expf(-x)); }
__device__ __forceinline__ float wave_sum(float v) {
#pragma unroll
    for (int o = 1; o < 64; o <<= 1) v += __shfl_xor(v, o);
    return v;
}
__device__ __forceinline__ float sum8(float v) { v += __shfl_xor(v, 1); v += __shfl_xor(v, 2); v += __shfl_xor(v, 4); return v; }

namespace pg8 {
constexpr int BM = 256, BK = 64, HALF = 128, HTB = HALF * BK * 2, STAGE_BYTES = 8 * HTB, NXCD = 8, WGM = 8;
__host__ __device__ __forceinline__ int lds_byte(int r, int c) { const int st = (r >> 4) * 2 + (c >> 5), rr = r & 15, cc = c & 31, ob = rr * 64 + cc * 2; return st * 1024 + (ob ^ (((ob >> 9) & 1) << 5)); }
__host__ __device__ __forceinline__ void stage_rc(int b, int& R, int& C) { const int st = b / 1024, sb = b % 1024, swz = sb ^ (((sb >> 9) & 1) << 5); R = (st >> 1) * 16 + swz / 64; C = (st & 1) * 32 + (swz % 64) / 2; }
__host__ __device__ __forceinline__ int perm32(int rho) { const int n = rho >> 4, i = rho & 15; return 8 * (i >> 2) + 4 * n + (i & 3); }
struct Unit { int pm, pn; };
struct Gemm { const bf16_t* A; const bf16_t* Bt; int M, N, K, lda, ldb; };
struct StaticOrder {
    int nM, nN, nwg, G, c;
    __host__ __device__ void init(int M_, int N_, int G_, int c_) { nM = M_ / BM; nN = N_ / BM; nwg = nM * nN; G = G_; c = c_; }
    __host__ __device__ bool next(int i, Unit& u) const {
        const long L = (long)i * G + c; if (L >= nwg) return false;
        int wgid = (int)L; { const int q = nwg / NXCD, r = nwg % NXCD, xcd = wgid % NXCD, off = wgid / NXCD; wgid = (xcd < r ? xcd * (q + 1) : r * (q + 1) + (xcd - r) * q) + off; }
        const int nig = WGM * nN, gid = wgid / nig, fm = gid * WGM, gsz = (nM - fm) < WGM ? (nM - fm) : WGM;
        u.pm = fm + ((wgid % nig) % gsz); u.pn = (wgid % nig) / gsz; return true;
    }
    __device__ __forceinline__ void a_ready(const Unit&) const {}
    __device__ __forceinline__ void done(const Unit&) const {}
};
template <class Epi, class Sched, bool ALIGN_EPI = false, bool SP2 = false>
__device__ __forceinline__ void gemm_phase(LAS unsigned char* lds, const Gemm g, const Sched& S, const Epi& E) {
    int tid_ = threadIdx.x; asm volatile("" : "+v"(tid_));
    const int tid = tid_, wid = __builtin_amdgcn_readfirstlane(tid >> 6), lane = tid & 63, wr = wid >> 2, wc = wid & 3, fr = lane & 15, fq = lane >> 4;
    const int K = g.K, nt = K / BK;
    unsigned voffA[2], voffB[2];
#pragma unroll
    for (int i = 0; i < 2; ++i) { int R, C; stage_rc(tid * 16 + i * 8192, R, C); const int Rb = Epi::PERM ? ((R & ~31) + perm32(R & 31)) : R;
        voffA[i] = (unsigned)(R * g.lda + C) * 2u; voffB[i] = (unsigned)(Rb * g.ldb + C) * 2u; }
    const size_t kstep = (size_t)(BK * 2);
    const size_t hsA = (size_t)HALF * g.lda * 2, hsB = (size_t)HALF * g.ldb * 2;
    const size_t tsA = 2 * hsA, tsB = 2 * hsB;
    const unsigned ldsw = (unsigned)wid * 1024u;
    const int aoff = lds_byte(wr * 64 + fr, fq * 8), boff = lds_byte(wc * 32 + fr, fq * 8);
#define PG8_SA(b, h) (((b) * 2 + (h)) * HTB)
#define PG8_SB(b, h) ((4 + (b) * 2 + (h)) * HTB)
#define PG8_STAGE(bufoff, gbase, voff) do { _Pragma("unroll") for (int _i = 0; _i < 2; ++_i) \
        __builtin_amdgcn_global_load_lds((const unsigned*)((const char*)(gbase) + (voff)[_i]), (LAS unsigned*)(lds + (bufoff) + ldsw + _i * 8192), 16, 0, 0); } while (0)
#define PG8_LDA(dst, b, h) do { _Pragma("unroll") for (int m = 0; m < 4; ++m) _Pragma("unroll") for (int k = 0; k < 2; ++k) dst[m][k] = *(const LAS bf16x8*)(lds + PG8_SA(b, h) + aoff + m * 2048 + k * 1024); } while (0)
#define PG8_LDB(dst, b, h) do { _Pragma("unroll") for (int n = 0; n < 2; ++n) _Pragma("unroll") for (int k = 0; k < 2; ++k) dst[n][k] = *(const LAS bf16x8*)(lds + PG8_SB(b, h) + boff + n * 2048 + k * 1024); } while (0)
#define PG8_MMA(ai, bj, At, Bt) do { __builtin_amdgcn_s_setprio(1); _Pragma("unroll") for (int m = 0; m < 4; ++m) _Pragma("unroll") for (int n = 0; n < 2; ++n) _Pragma("unroll") for (int k = 0; k < 2; ++k) \
        acc[ai][bj][m][n] = __builtin_amdgcn_mfma_f32_16x16x32_bf16(Bt[n][k], At[m][k], acc[ai][bj][m][n], 0, 0, 0); __builtin_amdgcn_s_setprio(0); } while (0)
#define PG8_WAIT_V(n) asm volatile("s_waitcnt vmcnt(" #n ")" ::: "memory")
#define PG8_WAIT_L(n) asm volatile("s_waitcnt lgkmcnt(" #n ")" ::: "memory")
#define PG8_BAR __builtin_amdgcn_s_barrier()
#define PG8_SCHED __builtin_amdgcn_sched_barrier(0)
    Unit cur, nxt; int ui = 0;
    if (!S.next(0, cur)) return;
    f32x4 acc[2][2][4][2];
#pragma unroll
    for (int a = 0; a < 2; ++a)
#pragma unroll
        for (int b = 0; b < 2; ++b)
#pragma unroll
            for (int m = 0; m < 4; ++m)
#pragma unroll
                for (int n = 0; n < 2; ++n) acc[a][b][m][n] = (f32x4){0.f, 0.f, 0.f, 0.f};
    bf16x8 At[4][2], B0[2][2], B1[2][2];
    const char* cA = (const char*)g.A + (size_t)cur.pm * tsA; const char* cB = (const char*)g.Bt + (size_t)cur.pn * tsB;
    S.a_ready(cur);
    if constexpr (SP2) {
        PG8_STAGE(PG8_SB(0, 0), cB, voffB); PG8_STAGE(PG8_SB(0, 1), cB + hsB, voffB); PG8_STAGE(PG8_SA(0, 0), cA, voffA); PG8_STAGE(PG8_SA(0, 1), cA + hsA, voffA);
        if (wr == 1) PG8_BAR;
        PG8_WAIT_V(2); PG8_BAR;
        PG8_STAGE(PG8_SB(1, 0), cB + kstep, voffB); PG8_STAGE(PG8_SA(1, 0), cA + kstep, voffA); PG8_STAGE(PG8_SB(1, 1), cB + hsB + kstep, voffB);
        PG8_WAIT_V(6); PG8_BAR;
    } else {
        PG8_STAGE(PG8_SB(0, 0), cB, voffB); PG8_STAGE(PG8_SA(0, 0), cA, voffA); PG8_STAGE(PG8_SB(0, 1), cB + hsB, voffB); PG8_STAGE(PG8_SA(0, 1), cA + hsA, voffA);
        if (wr == 1) PG8_BAR;
        PG8_WAIT_V(4); PG8_BAR;
        PG8_STAGE(PG8_SB(1, 0), cB + kstep, voffB); PG8_STAGE(PG8_SA(1, 0), cA + kstep, voffA); PG8_STAGE(PG8_SB(1, 1), cB + hsB + kstep, voffB);
        PG8_WAIT_V(6); PG8_BAR;
    }
    for (;;) {
        const bool has_next = S.next(ui + 1, nxt);
        const char* nA = has_next ? (const char*)g.A + (size_t)nxt.pm * tsA : cA; const char* nB = has_next ? (const char*)g.Bt + (size_t)nxt.pn * tsB : cB;
#pragma nounroll
        for (int t = 0; t < nt; t += 2) {
            const bool last = (t == nt - 2);
            const char* a1 = cA + (size_t)(t + 1) * kstep;
            const char* a2 = last ? nA : cA + (size_t)(t + 2) * kstep; const char* b2 = last ? nB : cB + (size_t)(t + 2) * kstep;
            const char* a3 = a2 + kstep; const char* b3 = b2 + kstep;
            if (last && has_next) S.a_ready(nxt);
            if constexpr (SP2) {
            PG8_LDB(B0, 0, 0); PG8_LDB(B1, 0, 1); PG8_SCHED; PG8_LDA(At, 0, 0); PG8_STAGE(PG8_SA(1, 1), a1 + hsA, voffA);
            PG8_WAIT_V(8); PG8_WAIT_L(0); PG8_BAR; PG8_MMA(0, 0, At, B0); PG8_MMA(0, 1, At, B1); PG8_BAR; PG8_SCHED;
            PG8_LDA(At, 0, 1); PG8_STAGE(PG8_SB(0, 0), b2, voffB); PG8_STAGE(PG8_SB(0, 1), b2 + hsB, voffB); PG8_STAGE(PG8_SA(0, 0), a2, voffA);
            PG8_WAIT_V(8); PG8_WAIT_L(0); PG8_BAR; PG8_MMA(1, 0, At, B0); PG8_MMA(1, 1, At, B1); PG8_BAR; PG8_SCHED;
            PG8_LDB(B0, 1, 0); PG8_LDB(B1, 1, 1); PG8_SCHED; PG8_LDA(At, 1, 0); PG8_STAGE(PG8_SA(0, 1), a2 + hsA, voffA);
            PG8_WAIT_V(8); PG8_WAIT_L(0); PG8_BAR; PG8_MMA(0, 0, At, B0); PG8_MMA(0, 1, At, B1); PG8_BAR; PG8_SCHED;
            PG8_LDA(At, 1, 1); PG8_STAGE(PG8_SB(1, 0), b3, voffB); PG8_STAGE(PG8_SB(1, 1), b3 + hsB, voffB); PG8_STAGE(PG8_SA(1, 0), a3, voffA);
            PG8_WAIT_V(8); PG8_WAIT_L(0); PG8_BAR; PG8_MMA(1, 0, At, B0); PG8_MMA(1, 1, At, B1); PG8_BAR; PG8_SCHED;
            } else {
            PG8_LDB(B0, 0, 0); PG8_SCHED; PG8_LDA(At, 0, 0); PG8_STAGE(PG8_SA(1, 1), a1 + hsA, voffA);
            PG8_WAIT_L(8); PG8_BAR; PG8_WAIT_L(0); PG8_MMA(0, 0, At, B0); PG8_BAR; PG8_SCHED;
            PG8_LDB(B1, 0, 1); PG8_STAGE(PG8_SB(0, 0), b2, voffB);
            PG8_BAR; PG8_WAIT_L(0); PG8_MMA(0, 1, At, B1); PG8_BAR;
            PG8_LDA(At, 0, 1); PG8_STAGE(PG8_SA(0, 0), a2, voffA);
            PG8_BAR; PG8_WAIT_L(0); PG8_MMA(1, 0, At, B0); PG8_BAR; PG8_SCHED;
            PG8_STAGE(PG8_SB(0, 1), b2 + hsB, voffB);
            PG8_WAIT_V(6); PG8_BAR; PG8_MMA(1, 1, At, B1); PG8_BAR;
            PG8_LDB(B0, 1, 0); PG8_SCHED; PG8_LDA(At, 1, 0); PG8_STAGE(PG8_SA(0, 1), a2 + hsA, voffA);
            PG8_WAIT_L(8); PG8_BAR; PG8_WAIT_L(0); PG8_MMA(0, 0, At, B0); PG8_BAR; PG8_SCHED;
            PG8_LDB(B1, 1, 1); PG8_STAGE(PG8_SB(1, 0), b3, voffB);
            PG8_BAR; PG8_WAIT_L(0); PG8_MMA(0, 1, At, B1); PG8_BAR;
            PG8_LDA(At, 1, 1); PG8_STAGE(PG8_SA(1, 0), a3, voffA);
            PG8_BAR; PG8_WAIT_L(0); PG8_MMA(1, 0, At, B0); PG8_BAR; PG8_SCHED;
            PG8_STAGE(PG8_SB(1, 1), b3 + hsB, voffB);
            PG8_WAIT_V(6); PG8_BAR; PG8_MMA(1, 1, At, B1); PG8_BAR;
            }
        }
        if constexpr (ALIGN_EPI) { if (wr == 0) PG8_BAR; }
        E(acc, cur, wr, wc, fr, fq); S.done(cur);
        if (!has_next) break;
#pragma unroll
        for (int a = 0; a < 2; ++a)
#pragma unroll
            for (int b = 0; b < 2; ++b)
#pragma unroll
                for (int m = 0; m < 4; ++m)
#pragma unroll
                    for (int n = 0; n < 2; ++n) acc[a][b][m][n] = (f32x4){0.f, 0.f, 0.f, 0.f};
        cur = nxt; cA = nA; cB = nB; ++ui;
        if constexpr (ALIGN_EPI) { if (wr == 1) PG8_BAR; }
    }
    PG8_WAIT_V(0);
    if constexpr (!ALIGN_EPI) { if (wr == 0) PG8_BAR; }
    PG8_BAR;
#undef PG8_SA
#undef PG8_SB
#undef PG8_STAGE
#undef PG8_LDA
#undef PG8_LDB
#undef PG8_MMA
#undef PG8_WAIT_V
#undef PG8_WAIT_L
#undef PG8_BAR
#undef PG8_SCHED
}

struct EpiBf16 {
    static constexpr bool PERM = true;
    bf16_t* O; int ldc;
    __device__ __forceinline__ void operator()(const f32x4 (&acc)[2][2][4][2], const Unit& u, int wr, int wc, int fr, int fq) const {
        const int row0 = u.pm * BM + wr * 64 + fr, col0 = u.pn * BM + wc * 32 + 8 * fq;
#pragma unroll
        for (int ai = 0; ai < 2; ++ai)
#pragma unroll
            for (int m = 0; m < 4; ++m) { bf16_t* rowp = O + (size_t)(row0 + ai * HALF + m * 16) * ldc + col0;
#pragma unroll
                for (int bj = 0; bj < 2; ++bj) { const f32x4 v0 = acc[ai][bj][m][0], v1 = acc[ai][bj][m][1];
                    u32x4 w; w.x = cvt_pk_bf16(v0[0], v0[1]); w.y = cvt_pk_bf16(v0[2], v0[3]); w.z = cvt_pk_bf16(v1[0], v1[1]); w.w = cvt_pk_bf16(v1[2], v1[3]);
                    *(u32x4*)(rowp + bj * HALF) = w; } }
    }
};
struct EpiSwiglu {
    static constexpr bool PERM = true;
    bf16_t* H; int ldh;
    __device__ __forceinline__ void operator()(const f32x4 (&acc)[2][2][4][2], const Unit& u, int wr, int wc, int fr, int fq) const {
        const int row0 = u.pm * BM + wr * 64 + fr, col0 = u.pn * HALF + wc * 32 + 8 * fq;
#pragma unroll
        for (int ai = 0; ai < 2; ++ai)
#pragma unroll
            for (int m = 0; m < 4; ++m) { bf16_t* rowp = H + (size_t)(row0 + ai * HALF + m * 16) * ldh + col0;
                float h[8];
#pragma unroll
                for (int n = 0; n < 2; ++n)
#pragma unroll
                    for (int j = 0; j < 4; ++j) { const float gt = acc[ai][0][m][n][j], up = acc[ai][1][m][n][j]; h[n * 4 + j] = gt * __builtin_amdgcn_rcpf(1.0f + __expf(-gt)) * up; }
                *(u32x4*)rowp = pack8(h); }
    }
};
struct EpiRes {
    static constexpr bool PERM = false;
    const float* base; float* out; int ldc; float alpha, beta;
    __device__ __forceinline__ void operator()(const f32x4 (&acc)[2][2][4][2], const Unit& u, int wr, int wc, int fr, int fq) const {
        const int row0 = u.pm * BM + wr * 64 + fr, col0 = u.pn * BM + wc * 32 + 4 * fq;
#pragma unroll
        for (int ai = 0; ai < 2; ++ai)
#pragma unroll
            for (int m = 0; m < 4; ++m) { const size_t off = (size_t)(row0 + ai * HALF + m * 16) * ldc + col0;
#pragma unroll
                for (int bj = 0; bj < 2; ++bj)
#pragma unroll
                    for (int n = 0; n < 2; ++n) { const f32x4 b = *(const f32x4*)(base + off + bj * HALF + n * 16); *(f32x4*)(out + off + bj * HALF + n * 16) = b * alpha + acc[ai][bj][m][n] * beta; } }
    }
};
template <int KIND> struct EpiLR {
    static constexpr bool PERM = false;
    float* O32; bf16_t* G; const float* bias;
    __device__ __forceinline__ void operator()(const f32x4 (&acc)[2][2][4][2], const Unit& u, int wr, int wc, int fr, int fq) const {
        const int row0 = u.pm * BM + wr * 64 + fr, col0 = u.pn * BM + wc * 32 + 4 * fq;
#pragma unroll
        for (int bj = 0; bj < 2; ++bj)
#pragma unroll
            for (int n = 0; n < 2; ++n) { const int col = col0 + bj * HALF + n * 16;
                if (KIND < 2) { const f32x4 bb = *(const f32x4*)(bias + col); float* dst = O32 + (size_t)(col >> 10) * M * RW + (col & 1023);
#pragma unroll
                    for (int ai = 0; ai < 2; ++ai)
#pragma unroll
                        for (int m = 0; m < 4; ++m) { f32x4 o;
#pragma unroll
                            for (int j = 0; j < 4; ++j) { const float sg = sigmoidf_(acc[ai][bj][m][n][j] + bb[j]); o[j] = KIND == 0 ? __expf(-DECAY_SCALE * sg) : sg; }
                            *(f32x4*)(dst + (size_t)(row0 + ai * HALF + m * 16) * RW) = o; }
                } else { bf16_t* dst = G + col;
#pragma unroll
                    for (int ai = 0; ai < 2; ++ai)
#pragma unroll
                        for (int m = 0; m < 4; ++m) { const f32x4 v = acc[ai][bj][m][n]; u32x2 w; w.x = cvt_pk_bf16(v[0], v[1]); w.y = cvt_pk_bf16(v[2], v[3]);
                            *(u32x2*)(dst + (size_t)(row0 + ai * HALF + m * 16) * RW) = w; }
                } }
    }
};
template <int BR> struct EpiGate {
    static constexpr bool PERM = false;
    const bf16_t* P; const float* gb; float* MIXF; bf16_t* MIXB;
    __device__ __forceinline__ void operator()(const f32x4 (&acc)[2][2][4][2], const Unit& u, int wr, int wc, int fr, int fq) const {
        const int row0 = u.pm * BM + wr * 64 + fr, col0 = u.pn * BM + wc * 32 + 4 * fq;
#pragma unroll
        for (int bj = 0; bj < 2; ++bj)
#pragma unroll
            for (int n = 0; n < 2; ++n) { const int col = col0 + bj * HALF + n * 16; const f32x4 bb = *(const f32x4*)(gb + BR * DM + col);
#pragma unroll
                for (int ai = 0; ai < 2; ++ai)
#pragma unroll
                    for (int m = 0; m < 4; ++m) { const int row = row0 + ai * HALF + m * 16;
                        const u32x2 gl = *(const u32x2*)(P + (size_t)row * DINP + PC_G + BR * DM + col);
                        f32x4 v;
                        v[0] = sigmoidf_(bflo(gl.x) + bb[0]) * acc[ai][bj][m][n][0]; v[1] = sigmoidf_(bfhi(gl.x) + bb[1]) * acc[ai][bj][m][n][1];
                        v[2] = sigmoidf_(bflo(gl.y) + bb[2]) * acc[ai][bj][m][n][2]; v[3] = sigmoidf_(bfhi(gl.y) + bb[3]) * acc[ai][bj][m][n][3];
                        float* mp = MIXF + (size_t)row * DM + col;
                        if (BR == 0) *(f32x4*)mp = v;
                        else if (BR == 1) *(f32x4*)mp = *(const f32x4*)mp + v;
                        else { const f32x4 t = *(const f32x4*)mp + v; u32x2 w; w.x = cvt_pk_bf16(t[0], t[1]); w.y = cvt_pk_bf16(t[2], t[3]); *(u32x2*)(MIXB + (size_t)row * DM + col) = w; } } }
    }
};
}

#define XB_TMO      128
#define XB_XCNT(j)  (256  + 64 * (j))
#define XB_XSUB(j)  (1280 + 64 * (j))
#define XB_XGEN(j)  (2304 + 64 * (j))
#define XB_TOP      3328
#define XB_TOPGEN   3392
#define XCD_BAR_WORDS 3456
#define XB_SPIN_CAP (1u << 18)
__device__ __forceinline__ unsigned xb_ld(unsigned* p)              { return __hip_atomic_load(p, __ATOMIC_RELAXED, __HIP_MEMORY_SCOPE_AGENT); }
__device__ __forceinline__ unsigned xb_add(unsigned* p, unsigned v) { return __hip_atomic_fetch_add(p, v, __ATOMIC_RELAXED, __HIP_MEMORY_SCOPE_AGENT); }
__device__ __forceinline__ unsigned xb_xcc_id() { return (unsigned)__builtin_amdgcn_s_getreg((3 << 11) | 20) & 0xFu; }
#define XB_SPIN(cond, bar) do { unsigned _sp = 0; while (cond) { __builtin_amdgcn_s_sleep(1); \
    if ((++_sp & 255u) == 0u) { if (xb_ld(&(bar)[XB_TMO])) break; if (_sp > XB_SPIN_CAP) { atomicAdd(&(bar)[XB_TMO], 1u); break; } } } } while (0)
struct XcdBarrier { unsigned* bar; unsigned x; volatile LAS unsigned* st; };
__device__ __forceinline__ XcdBarrier xcd_barrier_post(unsigned* bar, volatile LAS unsigned* st) {
    XcdBarrier b; b.bar = bar; b.x = xb_xcc_id(); b.st = st;
    if (threadIdx.x == 0) (void)xb_add(&bar[XB_XCNT(b.x)], 1u);
    return b;
}
__device__ __forceinline__ void xcd_barrier_complete(unsigned* bar, unsigned x, unsigned& nloc, unsigned& nx) {
    const unsigned G = gridDim.x * gridDim.y * gridDim.z;
    unsigned sum, cnt, mine, sp = 0u;
    for (;;) {
        sum = 0u; cnt = 0u; mine = 0u;
#pragma unroll
        for (unsigned j = 0; j < 16; ++j) { const unsigned c = xb_ld(&bar[XB_XCNT(j)]); sum += c; cnt += (c > 0u) ? 1u : 0u; mine = (j == x) ? c : mine; }
        if (sum == G) break;
        __builtin_amdgcn_s_sleep(1);
        if ((++sp & 255u) == 0u) { if (xb_ld(&bar[XB_TMO])) break; if (sp > XB_SPIN_CAP) { atomicAdd(&bar[XB_TMO], 1u); break; } }
    }
    nloc = mine > 0u ? mine : 1u; nx = cnt > 0u ? cnt : 1u;
}
__device__ __forceinline__ void xcd_barrier(const XcdBarrier& b) {
    asm volatile("s_waitcnt vmcnt(0)" ::: "memory");
    __syncthreads();
    if (threadIdx.x == 0) {
        unsigned* bar = b.bar;
        __builtin_amdgcn_s_waitcnt(0);
        unsigned nloc = b.st[0], nx = b.st[1];
        if (nloc == 0u) { xcd_barrier_complete(bar, b.x, nloc, nx); b.st[0] = nloc; b.st[1] = nx; }
        const unsigned old = xb_add(&bar[XB_XSUB(b.x)], 1u);
        const unsigned gen = old / nloc;
        if (old + 1u == (gen + 1u) * nloc) {
            __builtin_amdgcn_fence(__ATOMIC_RELEASE, "agent");
            asm volatile("s_waitcnt vmcnt(0)" ::: "memory");
            const unsigned og = xb_add(&bar[XB_TOP], 1u);
            const unsigned tg = og / nx;
            if (og + 1u == (tg + 1u) * nx) xb_add(&bar[XB_TOPGEN], 1u);
            else XB_SPIN(xb_ld(&bar[XB_TOPGEN]) == tg, bar);
            __builtin_amdgcn_fence(__ATOMIC_ACQUIRE, "agent");
            xb_add(&bar[XB_XGEN(b.x)], 1u);
            asm volatile("s_waitcnt vmcnt(0)" ::: "memory");
        } else {
            XB_SPIN(xb_ld(&bar[XB_XGEN(b.x)]) == gen, bar);
            __builtin_amdgcn_fence(__ATOMIC_ACQUIRE, "agent");
            asm volatile("s_waitcnt vmcnt(0)" ::: "memory");
        }
    }
    __syncthreads();
}

struct Args { const float* in[N_IN]; float* out; unsigned char* ws; int ph_lo, ph_hi; };
typedef const __attribute__((address_space(4))) Args* KArgs;
__device__ __forceinline__ KArgs kargs() { KArgs p = (KArgs)__builtin_amdgcn_kernarg_segment_ptr(); asm volatile("" : "+s"(p)); return p; }

template <int MODE>
__device__ __forceinline__ void cvt_tile(const float* W, int K, int N, bf16_t* WT, int item, int lane) {
    const int nblk = N / 32, kb = item / nblk, nb = item - kb * nblk, k0 = kb * 64, n0 = nb * 32;
    const int n4 = lane & 7, kg = lane >> 3;
    const float* src = W + (size_t)(k0 + kg * 8) * N + n0 + n4 * 4;
    f32x4 v[8];
#pragma unroll
    for (int kk = 0; kk < 8; ++kk) v[kk] = *(const f32x4*)(src + (size_t)kk * N);
    int drow = n0 + n4 * 4;
    if (MODE == 1) drow = (drow >> 7) * 256 + (drow & 127);
    if (MODE == 2) drow = (drow >> 7) * 256 + 128 + (drow & 127);
    bf16_t* dst = WT + (size_t)drow * K + k0 + kg * 8;
#pragma unroll
    for (int j = 0; j < 4; ++j) { u32x4 w; w.x = cvt_pk_bf16(v[0][j], v[1][j]); w.y = cvt_pk_bf16(v[2][j], v[3][j]); w.z = cvt_pk_bf16(v[4][j], v[5][j]); w.w = cvt_pk_bf16(v[6][j], v[7][j]);
        *(u32x4*)(dst + (size_t)j * K) = w; }
}

__device__ __forceinline__ void phase_cvt(KArgs a, int l, int gw, int NGW, int lane) {
    unsigned char* ws = a->ws;
    const float* f1g = a->in[I_F1G] + (size_t)l * DM * FF; const float* f1u = a->in[I_F1U] + (size_t)l * DM * FF; const float* f1d = a->in[I_F1D] + (size_t)l * FF * DM;
    const float* f2g = a->in[I_F2G] + (size_t)l * DM * FF; const float* f2u = a->in[I_F2U] + (size_t)l * DM * FF; const float* f2d = a->in[I_F2D] + (size_t)l * FF * DM;
    const float* win = a->in[I_WIN] + (size_t)l * DM * DIN; const float* wkv = a->in[I_WKV] + (size_t)l * DM * DM; const float* wbr = a->in[I_WBR] + (size_t)l * 3 * RW * DM;
    const float* wout = a->in[I_WOUT] + (size_t)l * DM * DM;
    constexpr int T_GU = (DM / 64) * (FF / 32), T_D = (FF / 64) * (DM / 32), T_IN = (DM / 64) * (DIN / 32), T_SQ = (DM / 64) * (DM / 32), T_BR = (RW / 64) * (DM / 32);
    constexpr int NIT = 4 * T_GU + 2 * T_D + T_IN + 2 * T_SQ + 3 * T_BR;
    for (int it = gw; it < NIT; it += NGW) {
        int r = it;
        if (r < T_GU) { cvt_tile<1>(f1g, DM, FF, (bf16_t*)(ws + WS_WGU1), r, lane); continue; } r -= T_GU;
        if (r < T_GU) { cvt_tile<2>(f1u, DM, FF, (bf16_t*)(ws + WS_WGU1), r, lane); continue; } r -= T_GU;
        if (r < T_D) { cvt_tile<0>(f1d, FF, DM, (bf16_t*)(ws + WS_WD1), r, lane); continue; } r -= T_D;
        if (r < T_IN) { cvt_tile<0>(win, DM, DIN, (bf16_t*)(ws + WS_WIN), r, lane); continue; } r -= T_IN;
        if (r < T_SQ) { cvt_tile<0>(wkv, DM, DM, (bf16_t*)(ws + WS_WKV), r, lane); continue; } r -= T_SQ;
        if (r < T_BR) { cvt_tile<0>(wbr, RW, DM, (bf16_t*)(ws + WS_WBR), r, lane); continue; } r -= T_BR;
        if (r < T_BR) { cvt_tile<0>(wbr + (size_t)RW * DM, RW, DM, (bf16_t*)(ws + WS_WBR) + (size_t)DM * RW, r, lane); continue; } r -= T_BR;
        if (r < T_BR) { cvt_tile<0>(wbr + (size_t)2 * RW * DM, RW, DM, (bf16_t*)(ws + WS_WBR) + (size_t)2 * DM * RW, r, lane); continue; } r -= T_BR;
        if (r < T_SQ) { cvt_tile<0>(wout, DM, DM, (bf16_t*)(ws + WS_WOUT), r, lane); continue; } r -= T_SQ;
        if (r < T_GU) { cvt_tile<1>(f2g, DM, FF, (bf16_t*)(ws + WS_WGU2), r, lane); continue; } r -= T_GU;
        if (r < T_GU) { cvt_tile<2>(f2u, DM, FF, (bf16_t*)(ws + WS_WGU2), r, lane); continue; } r -= T_GU;
        cvt_tile<0>(f2d, FF, DM, (bf16_t*)(ws + WS_WD2), r, lane);
    }
    { u32x4* z = (u32x4*)((bf16_t*)(ws + WS_WIN) + (size_t)DIN * DM); const int nz = (DINP - DIN) * DM / 8;
      for (int i = gw * 64 + lane; i < nz; i += NGW * 64) z[i] = (u32x4){0u, 0u, 0u, 0u}; }
    { const float* wup = a->in[I_WUP] + (size_t)l * 2 * 64 * RW; const float* aup = a->in[I_AUP] + (size_t)l * 2 * 64 * RW; const float* gup = a->in[I_GUP] + (size_t)l * 128 * RW;
      bf16_t* wlr = (bf16_t*)(ws + WS_WLR);
      for (int i = gw * 64 + lane; i < LRN * (LRK / 8); i += NGW * 64) { const int n = i / (LRK / 8), kc = (i - n * (LRK / 8)) * 8; const int blk = n >> 10, nn = n & 1023;
          const int kb0 = blk < 4 ? 64 * blk : 256, kb1 = blk < 4 ? kb0 + 64 : 384;
          const float* src = blk < 2 ? wup + (size_t)blk * 64 * RW : (blk < 4 ? aup + (size_t)(blk - 2) * 64 * RW : gup);
          float f[8];
#pragma unroll
          for (int e = 0; e < 8; ++e) { const int k = kc + e; f[e] = (k >= kb0 && k < kb1) ? src[(size_t)(k - kb0) * RW + nn] : 0.f; }
          *(u32x4*)(wlr + (size_t)n * LRK + kc) = pack8(f); } }
    if (l == 0) { const f32x4* xs = (const f32x4*)a->in[I_X]; u32x2* xb = (u32x2*)(ws + WS_XB);
        for (size_t i = (size_t)gw * 64 + lane; i < (size_t)M * DM / 4; i += (size_t)NGW * 64) { const f32x4 v = xs[i]; u32x2 w; w.x = cvt_pk_bf16(v[0], v[1]); w.y = cvt_pk_bf16(v[2], v[3]); xb[i] = w; } }
    { const float* mg = a->in[I_MLNG] + (size_t)l * DM; const float* mb = a->in[I_MLNB] + (size_t)l * DM; bf16_t* memn = (bf16_t*)(ws + WS_MEMN);
      for (int m = gw; m < BATCH * NMEM; m += NGW) {
          const f32x4* xr = (const f32x4*)(a->in[I_MEM] + (size_t)m * DM) + lane; f32x4 v[8]; float s = 0.f;
#pragma unroll
          for (int j = 0; j < 8; ++j) { v[j] = xr[64 * j]; s += (v[j][0] + v[j][1]) + (v[j][2] + v[j][3]); }
          const float mean = wave_sum(s) * (1.f / DM); float s2 = 0.f;
#pragma unroll
          for (int j = 0; j < 8; ++j) { v[j] = v[j] - mean; s2 += (v[j][0] * v[j][0] + v[j][1] * v[j][1]) + (v[j][2] * v[j][2] + v[j][3] * v[j][3]); }
          const float rstd = rsqrtf(wave_sum(s2) * (1.f / DM) + LN_EPS);
#pragma unroll
          for (int j = 0; j < 8; ++j) { const f32x4 gg = *((const f32x4*)mg + lane + 64 * j), bb = *((const f32x4*)mb + lane + 64 * j); const f32x4 y = v[j] * rstd * gg + bb;
              u32x2 w; w.x = cvt_pk_bf16(y[0], y[1]); w.y = cvt_pk_bf16(y[2], y[3]); *((u32x2*)(memn + (size_t)m * DM) + lane + 64 * j) = w; } } }
}

__device__ __forceinline__ void phase_ln(const float* src, float* dst, bf16_t* dstb, const float* g, const float* b, int gw, int NGW, int lane) {
    for (int m = gw; m < M; m += NGW) {
        const f32x4* xr = (const f32x4*)(src + (size_t)m * DM) + lane; f32x4 v[8]; float s = 0.f;
#pragma unroll
        for (int j = 0; j < 8; ++j) { v[j] = xr[64 * j]; s += (v[j][0] + v[j][1]) + (v[j][2] + v[j][3]); }
        const float mean = wave_sum(s) * (1.f / DM); float s2 = 0.f;
#pragma unroll
        for (int j = 0; j < 8; ++j) { v[j] = v[j] - mean; s2 += (v[j][0] * v[j][0] + v[j][1] * v[j][1]) + (v[j][2] * v[j][2] + v[j][3] * v[j][3]); }
        const float rstd = rsqrtf(wave_sum(s2) * (1.f / DM) + LN_EPS);
#pragma unroll
        for (int j = 0; j < 8; ++j) { const f32x4 gg = *((const f32x4*)g + lane + 64 * j), bb = *((const f32x4*)b + lane + 64 * j); const f32x4 y = v[j] * rstd * gg + bb;
            *((f32x4*)(dst + (size_t)m * DM) + lane + 64 * j) = y;
            if (dstb) { u32x2 w; w.x = cvt_pk_bf16(y[0], y[1]); w.y = cvt_pk_bf16(y[2], y[3]); *((u32x2*)(dstb + (size_t)m * DM) + lane + 64 * j) = w; } }
    }
}

__device__ __forceinline__ void phase_elt(KArgs a, int l, int gw, int NGW, int lane) {
    unsigned char* ws = a->ws;
    const bf16_t* P = (const bf16_t*)(ws + WS_P);
    bf16_t* Rb = (bf16_t*)(ws + WS_R); bf16_t* Kb = (bf16_t*)(ws + WS_K); bf16_t* Vb = (bf16_t*)(ws + WS_V); bf16_t* KKb = (bf16_t*)(ws + WS_KK);
    bf16_t* AC = (bf16_t*)(ws + WS_ACAT); bf16_t* YS = (bf16_t*)(ws + WS_YS);
    const float* mu = a->in[I_MU] + (size_t)l * 3456; const float* k_k = a->in[I_KK] + (size_t)l * RW; const float* cw = a->in[I_CONVW] + (size_t)l * 3 * RW;
    for (int m = gw; m < M; m += NGW) {
        const int t = m & (SEQ - 1); const bool hp = t > 0, hn = t < SEQ - 1;
        const bf16_t* pc = P + (size_t)m * DINP;
#pragma unroll
        for (int j = 0; j < 7; ++j) {
            const int c0 = 8 * (lane + 64 * j);
            if (j == 6 && lane >= 48) continue;
            const u32x4 zc = (u32x4){0u, 0u, 0u, 0u};
            const u32x4 wc_ = *(const u32x4*)(pc + c0); const u32x4 wp = hp ? *(const u32x4*)(pc - DINP + c0) : zc; const u32x4 wn = hn ? *(const u32x4*)(pc + DINP + c0) : zc;
            float cu[8], pv[8], nx[8], s[8]; unpack8(wc_, cu); unpack8(wp, pv); unpack8(wn, nx);
            const f32x4 m0 = *(const f32x4*)(mu + c0), m1 = *(const f32x4*)(mu + c0 + 4);
#pragma unroll
            for (int e = 0; e < 8; ++e) { const float mm = e < 4 ? m0[e] : m1[e - 4]; s[e] = cu[e] + mm * (0.5f * (pv[e] + nx[e]) - cu[e]); }
            if (j < 2) { *(u32x4*)(Rb + (size_t)m * RW + c0) = pack8(s); }
            else if (j < 4) { const int c = c0 - 1024; *(u32x4*)(Kb + (size_t)m * RW + c) = pack8(s);
                const f32x4 k0 = *(const f32x4*)(k_k + c), k1 = *(const f32x4*)(k_k + c + 4); float kx[8]; float ss = 0.f;
#pragma unroll
                for (int e = 0; e < 8; ++e) { kx[e] = s[e] * (e < 4 ? k0[e] : k1[e - 4]); ss += kx[e] * kx[e]; }
                ss = sum8(ss); const float inv = rsqrtf(ss + 1e-12f);
#pragma unroll
                for (int e = 0; e < 8; ++e) kx[e] *= inv;
                *(u32x4*)(KKb + (size_t)m * RW + c) = pack8(kx); }
            else if (j < 6) { *(u32x4*)(Vb + (size_t)m * RW + (c0 - 2048)) = pack8(s); }
            else { const int cc = c0 - 3072; float f[8];
#pragma unroll
                for (int e = 0; e < 8; ++e) f[e] = cc < 128 ? tanhf(s[e]) : (cc < 256 ? s[e] : sigmoidf_(s[e]));
                *(u32x4*)(AC + (size_t)m * LRK + cc) = pack8(f); }
        }
#pragma unroll
        for (int j = 0; j < 2; ++j) {
            const int c = 8 * (lane + 64 * j);
            const u32x4 zc = (u32x4){0u, 0u, 0u, 0u};
            float gbv[8], gc[8], hh[8], up[8], uc[8], un[8];
            unpack8(*(const u32x4*)(pc + PC_CB + c), gbv);
            unpack8(*(const u32x4*)(pc + PC_CC + c), gc); unpack8(*(const u32x4*)(pc + PC_CH + c), hh);
#pragma unroll
            for (int e = 0; e < 8; ++e) uc[e] = gc[e] * hh[e];
            unpack8(hp ? *(const u32x4*)(pc - DINP + PC_CC + c) : zc, gc); unpack8(hp ? *(const u32x4*)(pc - DINP + PC_CH + c) : zc, hh);
#pragma unroll
            for (int e = 0; e < 8; ++e) up[e] = gc[e] * hh[e];
            unpack8(hn ? *(const u32x4*)(pc + DINP + PC_CC + c) : zc, gc); unpack8(hn ? *(const u32x4*)(pc + DINP + PC_CH + c) : zc, hh);
#pragma unroll
            for (int e = 0; e < 8; ++e) un[e] = gc[e] * hh[e];
            float o[8];
#pragma unroll
            for (int e = 0; e < 8; ++e) o[e] = gbv[e] * (cw[c + e] * up[e] + cw[RW + c + e] * uc[e] + cw[2 * RW + c + e] * un[e]);
            *(u32x4*)(YS + (size_t)m * 3072 + 1024 + c) = pack8(o);
        }
    }
}

constexpr int XA_PITCH = 528;
__device__ __forceinline__ void xattn_unit(KArgs a, int unit, LAS unsigned char* lds, int tid, int wave, int lane) {
    unsigned char* ws = a->ws;
    const bf16_t* P = (const bf16_t*)(ws + WS_P); const bf16_t* KM = (const bf16_t*)(ws + WS_KMEM); const bf16_t* VT = (const bf16_t*)(ws + WS_VT); bf16_t* YS = (bf16_t*)(ws + WS_YS);
    const int bb = unit >> 7, h = (unit >> 5) & 3, qt = unit & 31, fr = lane & 15, fq = lane >> 4;
    const int mrow = bb * SEQ + qt * 128 + wave * 16 + fr;
    bf16x8 qf[8];
#pragma unroll
    for (int ks = 0; ks < 8; ++ks) qf[ks] = *(const bf16x8*)(P + (size_t)mrow * DINP + PC_Q + h * 256 + 32 * ks + 8 * fq);
#pragma unroll 4
    for (int it = 0; it < 16; ++it) { const int idx = tid + 512 * it, key = idx >> 5, ch = idx & 31;
        const u32x4 v = *(const u32x4*)(KM + (size_t)(bb * NMEM + key) * 1024 + h * 256 + ch * 8);
        *(LAS u32x4*)(lds + key * XA_PITCH + ch * 16) = v; }
    __syncthreads();
    f32x4 sacc[16];
#pragma unroll
    for (int kb = 0; kb < 16; ++kb) { f32x4 acc = (f32x4){0.f, 0.f, 0.f, 0.f};
#pragma unroll
        for (int ks = 0; ks < 8; ++ks) { const bf16x8 kf = *(const LAS bf16x8*)(lds + (kb * 16 + fr) * XA_PITCH + (32 * ks + 8 * fq) * 2);
            acc = __builtin_amdgcn_mfma_f32_16x16x32_bf16(kf, qf[ks], acc, 0, 0, 0); }
        sacc[kb] = acc; }
    float mx = -3.0e38f;
#pragma unroll
    for (int kb = 0; kb < 16; ++kb)
#pragma unroll
        for (int i = 0; i < 4; ++i) mx = fmaxf(mx, sacc[kb][i]);
    mx = fmaxf(mx, __shfl_xor(mx, 16)); mx = fmaxf(mx, __shfl_xor(mx, 32));
    float sum = 0.f;
#pragma unroll
    for (int kb = 0; kb < 16; ++kb)
#pragma unroll
        for (int i = 0; i < 4; ++i) { const float p = __expf((sacc[kb][i] - mx) * 0.0625f); sacc[kb][i] = p; sum += p; }
    sum += __shfl_xor(sum, 16); sum += __shfl_xor(sum, 32);
    const float rs = 1.0f / sum;
    bf16x8 pf[8];
#pragma unroll
    for (int s2 = 0; s2 < 8; ++s2) { u32x4 w; w.x = cvt_pk_bf16(sacc[2 * s2][0], sacc[2 * s2][1]); w.y = cvt_pk_bf16(sacc[2 * s2][2], sacc[2 * s2][3]);
        w.z = cvt_pk_bf16(sacc[2 * s2 + 1][0], sacc[2 * s2 + 1][1]); w.w = cvt_pk_bf16(sacc[2 * s2 + 1][2], sacc[2 * s2 + 1][3]); pf[s2] = __builtin_bit_cast(bf16x8, w); }
    __syncthreads();
#pragma unroll 4
    for (int it = 0; it < 16; ++it) { const int idx = tid + 512 * it, d = idx >> 5, ch = idx & 31;
        const u32x4 v = *(const u32x4*)(VT + (size_t)(h * 256 + d) * 512 + bb * NMEM + ch * 8);
        *(LAS u32x4*)(lds + d * XA_PITCH + ch * 16) = v; }
    __syncthreads();
#pragma unroll
    for (int db = 0; db < 16; ++db) { f32x4 acc = (f32x4){0.f, 0.f, 0.f, 0.f};
#pragma unroll
        for (int s2 = 0; s2 < 8; ++s2) { const LAS unsigned char* rp = lds + (db * 16 + fr) * XA_PITCH;
            const u32x2 lo = *(const LAS u32x2*)(rp + (32 * s2 + 4 * fq) * 2), hi = *(const LAS u32x2*)(rp + (32 * s2 + 16 + 4 * fq) * 2);
            u32x4 w; w.x = lo.x; w.y = lo.y; w.z = hi.x; w.w = hi.y;
            acc = __builtin_amdgcn_mfma_f32_16x16x32_bf16(__builtin_bit_cast(bf16x8, w), pf[s2], acc, 0, 0, 0); }
        u32x2 o; o.x = cvt_pk_bf16(acc[0] * rs, acc[1] * rs); o.y = cvt_pk_bf16(acc[2] * rs, acc[3] * rs);
        *(u32x2*)(YS + (size_t)mrow * 3072 + 2048 + h * 256 + db * 16 + 4 * fq) = o; }
    __syncthreads();
}

constexpr int SC_TC = 32;
constexpr int SC_BUF = SC_TC * 5 * 64 * 4;
constexpr int SC_VOFF = SC_BUF, SC_YOFF = SC_BUF + SC_TC * 16 * 4, SC_STRIDE = SC_YOFF + SC_TC * 16 * 4;
__device__ __forceinline__ void phase_scan(KArgs a, int l, int wgid, LAS unsigned char* lds, int tid, int wave, int lane) {
    unsigned char* ws = a->ws;
    const int seq = wgid >> 2, rq = wgid & 3, dir = seq >> 5, bb = (seq >> 4) & 1, h = seq & 15;
    const float* W2 = (const float*)(ws + WS_W2) + (size_t)dir * M * RW; const float* A2 = (const float*)(ws + WS_A2) + (size_t)dir * M * RW;
    const bf16_t* KKb = (const bf16_t*)(ws + WS_KK); const bf16_t* Kb = (const bf16_t*)(ws + WS_K); const bf16_t* Rb = (const bf16_t*)(ws + WS_R); const bf16_t* Vb = (const bf16_t*)(ws + WS_V);
    float* Y = (float*)(ws + (dir ? WS_YB : WS_YF));
    const float* k_a = a->in[I_KA] + (size_t)l * RW;
    const int ss = tid >> 4, kq = tid & 15;
    const f32x4 ka4 = *(const f32x4*)(k_a + h * 64 + 4 * kq);
    f32x4 gw_, ga_; u32x2 gkk, gk, gr; unsigned short gv;
#define SC_LOAD(ci) do { const int tk = (ci) * SC_TC + ss; const int tok = dir ? (SEQ - 1 - tk) : tk; const size_t mo = (size_t)(bb * SEQ + tok) * RW + h * 64; \
        gw_ = *(const f32x4*)(W2 + mo + 4 * kq); ga_ = *(const f32x4*)(A2 + mo + 4 * kq); gkk = *(const u32x2*)(KKb + mo + 4 * kq); gk = *(const u32x2*)(Kb + mo + 4 * kq); gr = *(const u32x2*)(Rb + mo + 4 * kq); \
        gv = Vb[mo + rq * 16 + kq]; } while (0)
#define SC_STORE(buf) do { LAS unsigned char* bp = lds + (buf) * SC_STRIDE; LAS float* vp = (LAS float*)(bp + (ss * 5) * 256 + kq * 16); \
        f32x4 kk4 = (f32x4){bflo(gkk.x), bfhi(gkk.x), bflo(gkk.y), bfhi(gkk.y)}; f32x4 k4 = (f32x4){bflo(gk.x), bfhi(gk.x), bflo(gk.y), bfhi(gk.y)}; f32x4 r4 = (f32x4){bflo(gr.x), bfhi(gr.x), bflo(gr.y), bfhi(gr.y)}; \
        *(LAS f32x4*)(vp) = gw_; *(LAS f32x4*)(vp + 64) = kk4; *(LAS f32x4*)(vp + 128) = kk4 * ga_; *(LAS f32x4*)(vp + 192) = k4 * (1.0f + (ga_ - 1.0f) * ka4); *(LAS f32x4*)(vp + 256) = r4; \
        ((LAS float*)(bp + SC_VOFF))[ss * 16 + kq] = __uint_as_float((unsigned)gv << 16); } while (0)
    const int rg = lane >> 4, kc = lane & 15, myrow = 4 * wave + rg;
    f32x4 S = (f32x4){0.f, 0.f, 0.f, 0.f};
#define SC_ROWSUM(x) do { x += __builtin_bit_cast(float, __builtin_amdgcn_update_dpp(0, __builtin_bit_cast(int, x), 0x128, 0xf, 0xf, false)); \
        x += __builtin_bit_cast(float, __builtin_amdgcn_update_dpp(0, __builtin_bit_cast(int, x), 0x124, 0xf, 0xf, false)); \
        x += __builtin_bit_cast(float, __builtin_amdgcn_update_dpp(0, __builtin_bit_cast(int, x), 0x122, 0xf, 0xf, false)); \
        x += __builtin_bit_cast(float, __builtin_amdgcn_update_dpp(0, __builtin_bit_cast(int, x), 0x121, 0xf, 0xf, false)); } while (0)
    SC_LOAD(0); SC_STORE(0);
    __syncthreads();
    constexpr int NCH = SEQ / SC_TC;
    for (int ci = 0; ci < NCH; ++ci) {
        const int buf = ci & 1;
        if (ci + 1 < NCH) SC_LOAD(ci + 1);
        if (wave < 4) {
            const LAS unsigned char* bp = lds + buf * SC_STRIDE;
            const LAS float* vb = (const LAS float*)(bp + SC_VOFF) + myrow; LAS float* yb = (LAS float*)(lds + buf * SC_STRIDE + SC_YOFF) + kc * 16 + myrow;
            const LAS float* vp0 = (const LAS float*)bp + 4 * kc;
            f32x4 w4 = *(const LAS f32x4*)(vp0), kk4 = *(const LAS f32x4*)(vp0 + 64), b4 = *(const LAS f32x4*)(vp0 + 128), kd4 = *(const LAS f32x4*)(vp0 + 192), r4 = *(const LAS f32x4*)(vp0 + 256);
            float vv = vb[0], ykeep = 0.f;
#pragma unroll
            for (int s = 0; s < SC_TC; ++s) {
                const LAS float* vpn = vp0 + ((s + 1) & (SC_TC - 1)) * 320;
                const f32x4 nw4 = *(const LAS f32x4*)(vpn), nkk4 = *(const LAS f32x4*)(vpn + 64), nb4 = *(const LAS f32x4*)(vpn + 128), nkd4 = *(const LAS f32x4*)(vpn + 192), nr4 = *(const LAS f32x4*)(vpn + 256);
                const float nvv = vb[((s + 1) & (SC_TC - 1)) * 16];
                f32x2 p = (f32x2){S[0], S[1]} * (f32x2){kk4[0], kk4[1]}; p = (f32x2){S[2], S[3]} * (f32x2){kk4[2], kk4[3]} + p;
                float d = p.x + p.y;
                SC_ROWSUM(d);
                S = S * w4 + (kd4 * vv - b4 * d);
                f32x2 q = (f32x2){S[0], S[1]} * (f32x2){r4[0], r4[1]}; q = (f32x2){S[2], S[3]} * (f32x2){r4[2], r4[3]} + q;
                float y = q.x + q.y;
                SC_ROWSUM(y);
                ykeep = (kc == (s & 15)) ? y : ykeep;
                if ((s & 15) == 15) yb[(s >> 4) * 256] = ykeep;
                w4 = nw4; kk4 = nkk4; b4 = nb4; kd4 = nkd4; r4 = nr4; vv = nvv;
            }
        }
        if (ci + 1 < NCH) SC_STORE(buf ^ 1);
        __syncthreads();
        { const int tk = ci * SC_TC + ss; const int tok = dir ? (SEQ - 1 - tk) : tk;
          Y[(size_t)(bb * SEQ + tok) * RW + h * 64 + rq * 16 + kq] = ((const LAS float*)(lds + buf * SC_STRIDE + SC_YOFF))[ss * 16 + kq]; }
    }
    __syncthreads();
#undef SC_LOAD
#undef SC_STORE
}

__device__ __forceinline__ void phase_post(KArgs a, int l, int gw, int NGW, int lane) {
    unsigned char* ws = a->ws;
    const float* YF = (const float*)(ws + WS_YF); const float* YB = (const float*)(ws + WS_YB);
    const float* A0 = (const float*)(ws + WS_A2); const float* A1 = A0 + (size_t)M * RW;
    const bf16_t* Rb = (const bf16_t*)(ws + WS_R); const bf16_t* Kb = (const bf16_t*)(ws + WS_K); const bf16_t* Vb = (const bf16_t*)(ws + WS_V); const bf16_t* Gb = (const bf16_t*)(ws + WS_G);
    bf16_t* YS = (bf16_t*)(ws + WS_YS);
    const float* k_a = a->in[I_KA] + (size_t)l * RW; const float* r_k = a->in[I_RK] + (size_t)l * RW; const float* gng = a->in[I_GNG] + (size_t)l * RW; const float* gnb = a->in[I_GNB] + (size_t)l * RW;
    for (int m = gw; m < M; m += NGW) {
#pragma unroll
        for (int j = 0; j < 2; ++j) {
            const int c = 8 * (lane + 64 * j); const size_t o = (size_t)m * RW + c;
            float y[8], rr[8], kk[8], vv[8], gg[8], a0[8], a1[8];
            { const f32x4 f0 = *(const f32x4*)(YF + o), f1 = *(const f32x4*)(YF + o + 4), b0 = *(const f32x4*)(YB + o), b1 = *(const f32x4*)(YB + o + 4);
#pragma unroll
              for (int e = 0; e < 4; ++e) { y[e] = f0[e] + b0[e]; y[4 + e] = f1[e] + b1[e]; } }
            { const f32x4 p0 = *(const f32x4*)(A0 + o), p1 = *(const f32x4*)(A0 + o + 4), q0 = *(const f32x4*)(A1 + o), q1 = *(const f32x4*)(A1 + o + 4);
#pragma unroll
              for (int e = 0; e < 4; ++e) { a0[e] = p0[e]; a0[4 + e] = p1[e]; a1[e] = q0[e]; a1[4 + e] = q1[e]; } }
            unpack8(*(const u32x4*)(Rb + o), rr); unpack8(*(const u32x4*)(Kb + o), kk); unpack8(*(const u32x4*)(Vb + o), vv); unpack8(*(const u32x4*)(Gb + o), gg);
            float s = 0.f;
#pragma unroll
            for (int e = 0; e < 8; ++e) s += y[e];
            const float mean = sum8(s) * (1.f / 64.f); float q = 0.f;
#pragma unroll
            for (int e = 0; e < 8; ++e) { y[e] -= mean; q += y[e] * y[e]; }
            const float rstd = rsqrtf(sum8(q) * (1.f / 64.f) + GN_EPS);
            float bs = 0.f;
#pragma unroll
            for (int e = 0; e < 8; ++e) { const float kb = kk[e] * (1.0f + (0.5f * (a0[e] + a1[e]) - 1.0f) * k_a[c + e]); bs += rr[e] * kb * r_k[c + e]; }
            bs = sum8(bs);
            float ov[8];
#pragma unroll
            for (int e = 0; e < 8; ++e) ov[e] = (y[e] * rstd * gng[c + e] + gnb[c + e] + bs * vv[e]) * gg[e];
            *(u32x4*)(YS + (size_t)m * 3072 + c) = pack8(ov);
        }
    }
}

__global__ void __launch_bounds__(512, 2) mk_fwd(Args args) {
    extern __shared__ __attribute__((aligned(16))) unsigned char lds_raw[];
    LAS unsigned char* lds = (LAS unsigned char*)lds_raw;
    volatile LAS unsigned* MISC = (volatile LAS unsigned*)(lds + LDS_MISC);
    for (int u = threadIdx.x; u < 64; u += 512) MISC[u] = 0u;
    __syncthreads();
    const int lo = args.ph_lo, hi = args.ph_hi;
    XcdBarrier bar = xcd_barrier_post((unsigned*)(args.ws + WS_CTL) + CW_BAR, MISC + 8);
#define PH_LOCALS() int tid = threadIdx.x; asm volatile("" : "+v"(tid)); int bid = blockIdx.x; asm volatile("" : "+s"(bid)); int G = gridDim.x; asm volatile("" : "+s"(G)); \
    const int lane = tid & 63, wave = __builtin_amdgcn_readfirstlane(tid >> 6), gw = bid * 8 + wave, NGW = G * 8; \
    unsigned char* ws = kargs()->ws; (void)lane; (void)gw; (void)ws; (void)NGW
#define IN(k) (lo <= (k) && (k) < hi)
#define SEAM(k) do { if ((k) + 1 < hi) xcd_barrier(bar); } while (0)
    using namespace pg8;
#define XB ((bf16_t*)(ws + WS_XB))
#define X ((float*)(ws + WS_X))
#define H ((bf16_t*)(ws + WS_H))
#define P ((bf16_t*)(ws + WS_P))

    for (int l = 0; l < DEPTH; ++l) {
        const int pb = l * NPH;
        if (PH_EN(0) && IN(pb + 0)) { PH_LOCALS(); for (int rep = 0; rep < (DUP_PHASE == 0 ? 2 : 1); ++rep) phase_cvt(kargs(), l, gw, NGW, lane); SEAM(pb + 0); }
        if (PH_EN(1) && IN(pb + 1)) { PH_LOCALS();
            for (int rep = 0; rep < (DUP_PHASE == 1 ? 2 : 1); ++rep)
            { Gemm g{XB, (const bf16_t*)(ws + WS_WGU1), M, 2 * FF, DM, DM, DM}; StaticOrder S; S.init(M, 2 * FF, G, bid); EpiSwiglu E{H, FF};
              gemm_phase<EpiSwiglu, StaticOrder, true, true>(lds, g, S, E); }
            { Gemm g{(const bf16_t*)(ws + WS_MEMN), (const bf16_t*)(ws + WS_WKV), BATCH * NMEM, 1024, DM, DM, DM}; StaticOrder S; S.init(BATCH * NMEM, 1024, G, bid); EpiBf16 E{(bf16_t*)(ws + WS_KMEM), 1024};
              gemm_phase<EpiBf16, StaticOrder, true, true>(lds, g, S, E); }
            { Gemm g{(const bf16_t*)(ws + WS_WKV) + (size_t)1024 * DM, (const bf16_t*)(ws + WS_MEMN), 1024, BATCH * NMEM, DM, DM, DM}; StaticOrder S; S.init(1024, BATCH * NMEM, G, bid); EpiBf16 E{(bf16_t*)(ws + WS_VT), BATCH * NMEM};
              gemm_phase<EpiBf16, StaticOrder, true, true>(lds, g, S, E); }
            SEAM(pb + 1);
        }
        if (PH_EN(2) && IN(pb + 2)) { PH_LOCALS();
            Gemm g{H, (const bf16_t*)(ws + WS_WD1), M, DM, FF, FF, FF}; StaticOrder S; S.init(M, DM, G, bid); EpiRes E{l == 0 ? kargs()->in[I_X] : X, X, DM, ALPHA, 0.5f};
            gemm_phase<EpiRes, StaticOrder, false, true>(lds, g, S, E);
            SEAM(pb + 2);
        }
        if (PH_EN(3) && IN(pb + 3)) { PH_LOCALS(); phase_ln(X, X, XB, kargs()->in[I_LN1G] + (size_t)l * DM, kargs()->in[I_LN1B] + (size_t)l * DM, gw, NGW, lane); SEAM(pb + 3); }
        if (PH_EN(4) && IN(pb + 4)) { PH_LOCALS();
            Gemm g{XB, (const bf16_t*)(ws + WS_WIN), M, DINP, DM, DM, DM}; StaticOrder S; S.init(M, DINP, G, bid); EpiBf16 E{P, DINP};
            gemm_phase<EpiBf16, StaticOrder, true, true>(lds, g, S, E);
            SEAM(pb + 4);
        }
        if (PH_EN(5) && IN(pb + 5)) { PH_LOCALS(); phase_elt(kargs(), l, gw, NGW, lane); SEAM(pb + 5); }
        if (PH_EN(6) && IN(pb + 6)) { PH_LOCALS();
            { Gemm g{(const bf16_t*)(ws + WS_ACAT), (const bf16_t*)(ws + WS_WLR), M, 2048, LRK, LRK, LRK}; StaticOrder S; S.init(M, 2048, G, bid);
              EpiLR<0> E{(float*)(ws + WS_W2), nullptr, kargs()->in[I_W0] + (size_t)l * 2 * RW}; gemm_phase<EpiLR<0>, StaticOrder, false, true>(lds, g, S, E); }
            { Gemm g{(const bf16_t*)(ws + WS_ACAT), (const bf16_t*)(ws + WS_WLR) + (size_t)2048 * LRK, M, 2048, LRK, LRK, LRK}; StaticOrder S; S.init(M, 2048, G, bid);
              EpiLR<1> E{(float*)(ws + WS_A2), nullptr, kargs()->in[I_A0] + (size_t)l * 2 * RW}; gemm_phase<EpiLR<1>, StaticOrder, false, true>(lds, g, S, E); }
            { Gemm g{(const bf16_t*)(ws + WS_ACAT), (const bf16_t*)(ws + WS_WLR) + (size_t)4096 * LRK, M, 1024, LRK, LRK, LRK}; StaticOrder S; S.init(M, 1024, G, bid);
              EpiLR<2> E{nullptr, (bf16_t*)(ws + WS_G), nullptr}; gemm_phase<EpiLR<2>, StaticOrder, false, true>(lds, g, S, E); }
            for (int u = bid; u < 256; u += G) xattn_unit(kargs(), u, lds, tid, wave, lane);
            SEAM(pb + 6);
        }
        if (PH_EN(7) && IN(pb + 7)) { PH_LOCALS(); for (int rep = 0; rep < (DUP_PHASE == 7 ? 2 : 1); ++rep) for (int u = bid; u < 256; u += G) phase_scan(kargs(), l, u, lds, tid, wave, lane); SEAM(pb + 7); }
        if (PH_EN(8) && IN(pb + 8)) { PH_LOCALS(); phase_post(kargs(), l, gw, NGW, lane); SEAM(pb + 8); }
        if (PH_EN(9) && IN(pb + 9)) { PH_LOCALS();
            const bf16_t* YS = (const bf16_t*)(ws + WS_YS); const bf16_t* WBR = (const bf16_t*)(ws + WS_WBR); const float* gb = kargs()->in[I_GATEB] + (size_t)l * 3 * DM;
            float* MIXF = (float*)(ws + WS_MIXF); bf16_t* MIXB = (bf16_t*)(ws + WS_MIXB);
            { Gemm g{YS, WBR, M, DM, RW, 3072, RW}; StaticOrder S; S.init(M, DM, G, bid); EpiGate<0> E{P, gb, MIXF, MIXB}; gemm_phase<EpiGate<0>, StaticOrder, false, true>(lds, g, S, E); }
            { Gemm g{YS + 1024, WBR + (size_t)DM * RW, M, DM, RW, 3072, RW}; StaticOrder S; S.init(M, DM, G, bid); EpiGate<1> E{P, gb, MIXF, MIXB}; gemm_phase<EpiGate<1>, StaticOrder, false, true>(lds, g, S, E); }
            { Gemm g{YS + 2048, WBR + (size_t)2 * DM * RW, M, DM, RW, 3072, RW}; StaticOrder S; S.init(M, DM, G, bid); EpiGate<2> E{P, gb, MIXF, MIXB}; gemm_phase<EpiGate<2>, StaticOrder, false, true>(lds, g, S, E); }
            SEAM(pb + 9);
        }
        if (PH_EN(10) && IN(pb + 10)) { PH_LOCALS();
            Gemm g{(const bf16_t*)(ws + WS_MIXB), (const bf16_t*)(ws + WS_WOUT), M, DM, DM, DM, DM}; StaticOrder S; S.init(M, DM, G, bid); EpiRes E{X, X, DM, ALPHA, 1.0f};
            gemm_phase<EpiRes, StaticOrder, false, true>(lds, g, S, E);
            SEAM(pb + 10);
        }
        if (PH_EN(11) && IN(pb + 11)) { PH_LOCALS(); phase_ln(X, X, XB, kargs()->in[I_LN2G] + (size_t)l * DM, kargs()->in[I_LN2B] + (size_t)l * DM, gw, NGW, lane); SEAM(pb + 11); }
        if (PH_EN(12) && IN(pb + 12)) { PH_LOCALS();
            Gemm g{XB, (const bf16_t*)(ws + WS_WGU2), M, 2 * FF, DM, DM, DM}; StaticOrder S; S.init(M, 2 * FF, G, bid); EpiSwiglu E{H, FF};
            gemm_phase<EpiSwiglu, StaticOrder, true, true>(lds, g, S, E);
            SEAM(pb + 12);
        }
        if (PH_EN(13) && IN(pb + 13)) { PH_LOCALS();
            Gemm g{H, (const bf16_t*)(ws + WS_WD2), M, DM, FF, FF, FF}; StaticOrder S; S.init(M, DM, G, bid); EpiRes E{X, X, DM, ALPHA, 0.5f};
            gemm_phase<EpiRes, StaticOrder, false, true>(lds, g, S, E);
            SEAM(pb + 13);
        }
        if (PH_EN(14) && IN(pb + 14)) { PH_LOCALS(); phase_ln(X, l == DEPTH - 1 ? kargs()->out : X, l == DEPTH - 1 ? (bf16_t*)nullptr : XB, kargs()->in[I_LN3G] + (size_t)l * DM, kargs()->in[I_LN3B] + (size_t)l * DM, gw, NGW, lane); SEAM(pb + 14); }
    }
#undef IN
#undef SEAM
#undef XB
#undef X
#undef H
#undef P
#undef PH_LOCALS
}

extern "C" void kernel_launch(void* const* d_in, const int* in_sizes, int n_in, void* d_out, int out_size, void* d_ws, size_t ws_size, hipStream_t stream) {
    static int grid = 0;
    if (grid == 0) {
        if (n_in != N_IN || out_size != M * DM || ws_size < WS_END) { fprintf(stderr, "kernel_launch: unexpected problem (n_in %d, out %d, ws %zu < %zu)\n", n_in, out_size, ws_size, (size_t)WS_END); grid = -1; return; }
        int dev = 0, cus = 0, per_cu = 0;
        if (hipGetDevice(&dev) != hipSuccess || hipDeviceGetAttribute(&cus, hipDeviceAttributeMultiprocessorCount, dev) != hipSuccess) { grid = -1; return; }
        if (hipFuncSetAttribute((const void*)mk_fwd, hipFuncAttributeMaxDynamicSharedMemorySize, LDS_BYTES) != hipSuccess) { fprintf(stderr, "kernel_launch: hipFuncSetAttribute failed\n"); grid = -1; return; }
        if (hipOccupancyMaxActiveBlocksPerMultiprocessor(&per_cu, (const void*)mk_fwd, 512, LDS_BYTES) != hipSuccess || per_cu < 1) fprintf(stderr, "kernel_launch: occupancy query says %d\n", per_cu);
        (void)hipGetLastError();
        grid = cus;
    }
    if (grid < 0) return;
    (void)hipMemsetAsync((char*)d_ws + WS_CTL, 0, CTL_BYTES, stream);
    Args a{};
    for (int i = 0; i < N_IN; ++i) a.in[i] = (const float*)d_in[i];
    a.out = (float*)d_out; a.ws = (unsigned char*)d_ws;
#if MK_ONE_LAUNCH
    a.ph_lo = 0; a.ph_hi = DEPTH * NPH;
    hipLaunchKernelGGL(mk_fwd, dim3(grid), dim3(512), LDS_BYTES, stream, a);
#else
    for (int p = 0; p < DEPTH * NPH; ++p) { a.ph_lo = p; a.ph_hi = p + 1; hipLaunchKernelGGL(mk_fwd, dim3(grid), dim3(512), LDS_BYTES, stream, a); }
#endif
}
```

```cpp
#include <hip/hip_runtime.h>
#include <cstdio>

#ifndef PHMASK
#define PHMASK 0xffff
#endif
#define PH_EN(k) (((PHMASK) >> (k)) & 1)
#ifndef SCAN_SEQ
#define SCAN_SEQ 0
#endif
#ifndef DUP_PHASE
#define DUP_PHASE -1
#endif
#ifndef MK_ONE_LAUNCH
#define MK_ONE_LAUNCH 1
#endif

#define LAS __attribute__((address_space(3)))
#define GAS __attribute__((address_space(1)))
typedef unsigned short bf16_t;
typedef short bf16x8 __attribute__((ext_vector_type(8)));
typedef float f32x4 __attribute__((ext_vector_type(4)));
typedef float f32x2 __attribute__((ext_vector_type(2)));
typedef unsigned u32x4 __attribute__((ext_vector_type(4)));
typedef unsigned u32x2 __attribute__((ext_vector_type(2)));

constexpr int DM = 2048, BATCH = 2, SEQ = 4096, M = BATCH * SEQ, DEPTH = 2, NMEM = 256, FF = 5504;
constexpr int RW = 1024, DIN = 13696, DINP = 13824;
constexpr int PC_R = 0, PC_K = 1024, PC_V = 2048, PC_LR = 3072, PC_CB = 3456, PC_CC = 4480, PC_CH = 5504, PC_Q = 6528, PC_G = 7552;
constexpr int LRK = 384, LRN = 5120;
constexpr float ALPHA = 1.41421356237309515f;
constexpr float LN_EPS = 1e-5f, GN_EPS = 64e-5f, DECAY_SCALE = 0.606531f;
constexpr int NPH = 16;

enum { I_X = 0, I_MEM, I_F1G, I_F1U, I_F1D, I_LN1G, I_LN1B, I_WIN, I_MU, I_W0, I_WUP, I_A0, I_AUP, I_GUP, I_KK, I_KA, I_RK, I_GNG, I_GNB, I_CONVW,
       I_MLNG, I_MLNB, I_WKV, I_WBR, I_GATEB, I_WOUT, I_LN2G, I_LN2B, I_F2G, I_F2U, I_F2D, I_LN3G, I_LN3B, N_IN };

constexpr size_t MiB = 1u << 20;
constexpr size_t WS_CTL = 0, CTL_BYTES = 1 * MiB;
constexpr size_t WS_WGU1 = 1 * MiB;
constexpr size_t WS_WD1 = WS_WGU1 + 43 * MiB;
constexpr size_t WS_WGU2 = WS_WD1 + 22 * MiB;
constexpr size_t WS_WD2 = WS_WGU2 + 43 * MiB;
constexpr size_t WS_WIN = WS_WD2 + 22 * MiB;
constexpr size_t WS_WKV = WS_WIN + 54 * MiB;
constexpr size_t WS_WBR = WS_WKV + 8 * MiB;
constexpr size_t WS_WOUT = WS_WBR + 12 * MiB;
constexpr size_t WS_WLR = WS_WOUT + 8 * MiB;
constexpr size_t WS_X = WS_WLR + 4 * MiB;
constexpr size_t WS_XB = WS_X + 64 * MiB;
constexpr size_t WS_H = WS_XB + 32 * MiB;
constexpr size_t WS_P = WS_H + 86 * MiB;
constexpr size_t WS_W2 = WS_P + 216 * MiB;
constexpr size_t WS_A2 = WS_W2 + 64 * MiB;
constexpr size_t WS_R = WS_A2 + 64 * MiB;
constexpr size_t WS_K = WS_R + 16 * MiB;
constexpr size_t WS_V = WS_K + 16 * MiB;
constexpr size_t WS_KK = WS_V + 16 * MiB;
constexpr size_t WS_G = WS_KK + 16 * MiB;
constexpr size_t WS_ACAT = WS_G + 16 * MiB;
constexpr size_t WS_YS = WS_ACAT + 6 * MiB;
constexpr size_t WS_MEMN = WS_YS + 48 * MiB;
constexpr size_t WS_KMEM = WS_MEMN + 2 * MiB;
constexpr size_t WS_VT = WS_KMEM + 1 * MiB;
constexpr size_t WS_END = WS_VT + 1 * MiB;
constexpr size_t WS_YF = WS_H, WS_YB = WS_H + 16 * MiB, WS_MIXF = WS_H, WS_MIXB = WS_XB;
constexpr size_t WS_CMS = WS_WGU1;
constexpr size_t WS_CNS = WS_WGU2;
constexpr size_t WS_CGY = WS_XB;
constexpr size_t WS_CYL = WS_H + 32 * MiB;
constexpr int CW_BAR = 4096;

constexpr int LDS_MISC = 150 * 1024;
constexpr int LDS_BYTES = 163840;

__device__ __forceinline__ unsigned cvt_pk_bf16(float lo, float hi) { unsigned r; asm volatile("v_cvt_pk_bf16_f32 %0, %1, %2" : "=v"(r) : "v"(lo), "v"(hi)); return r; }
__device__ __forceinline__ float bflo(unsigned w) { return __uint_as_float(w << 16); }
__device__ __forceinline__ float bfhi(unsigned w) { return __uint_as_float(w & 0xffff0000u); }
__device__ __forceinline__ void unpack8(const u32x4 w, float (&f)[8]) { f[0] = bflo(w.x); f[1] = bfhi(w.x); f[2] = bflo(w.y); f[3] = bfhi(w.y); f[4] = bflo(w.z); f[5] = bfhi(w.z); f[6] = bflo(w.w); f[7] = bfhi(w.w); }
__device__ __forceinline__ u32x4 pack8(const float (&f)[8]) { u32x4 w; w.x = cvt_pk_bf16(f[0], f[1]); w.y = cvt_pk_bf16(f[2], f[3]); w.z = cvt_pk_bf16(f[4], f[5]); w.w = cvt_pk_bf16(f[6], f[7]); return w; }
__device__ __forceinline__ float sigmoidf_(float x) { return __builtin_amdgcn_rcpf(1.0f + __expf(-x)); }
__device__ __forceinline__ float wave_sum(float v) {
#pragma unroll
    for (int o = 1; o < 64; o <<= 1) v += __shfl_xor(v, o);
    return v;
}
__device__ __forceinline__ float sum8(float v) { v += __shfl_xor(v, 1); v += __shfl_xor(v, 2); v += __shfl_xor(v, 4); return v; }

namespace pg8 {
constexpr int BM = 256, BK = 64, HALF = 128, HTB = HALF * BK * 2, STAGE_BYTES = 8 * HTB, NXCD = 8, WGM = 8;
__host__ __device__ __forceinline__ int lds_byte(int r, int c) { const int st = (r >> 4) * 2 + (c >> 5), rr = r & 15, cc = c & 31, ob = rr * 64 + cc * 2; return st * 1024 + (ob ^ (((ob >> 9) & 1) << 5)); }
__host__ __device__ __forceinline__ void stage_rc(int b, int& R, int& C) { const int st = b / 1024, sb = b % 1024, swz = sb ^ (((sb >> 9) & 1) << 5); R = (st >> 1) * 16 + swz / 64; C = (st & 1) * 32 + (swz % 64) / 2; }
__host__ __device__ __forceinline__ int perm32(int rho) { const int n = rho >> 4, i = rho & 15; return 8 * (i >> 2) + 4 * n + (i & 3); }
struct Unit { int pm, pn; };
struct Gemm { const bf16_t* A; const bf16_t* Bt; int M, N, K, lda, ldb; };
struct StaticOrder {
    int nM, nN, nwg, G, c;
    __host__ __device__ void init(int M_, int N_, int G_, int c_) { nM = M_ / BM; nN = N_ / BM; nwg = nM * nN; G = G_; c = c_; }
    __host__ __device__ bool next(int i, Unit& u) const {
        const long L = (long)i * G + c; if (L >= nwg) return false;
        int wgid = (int)L; { const int q = nwg / NXCD, r = nwg % NXCD, xcd = wgid % NXCD, off = wgid / NXCD; wgid = (xcd < r ? xcd * (q + 1) : r * (q + 1) + (xcd - r) * q) + off; }
        const int nig = WGM * nN, gid = wgid / nig, fm = gid * WGM, gsz = (nM - fm) < WGM ? (nM - fm) : WGM;
        u.pm = fm + ((wgid % nig) % gsz); u.pn = (wgid % nig) / gsz; return true;
    }
    __device__ __forceinline__ void a_ready(const Unit&) const {}
    __device__ __forceinline__ void done(const Unit&) const {}
};
template <class Epi, class Sched, bool ALIGN_EPI = false, bool SP2 = false>
__device__ __forceinline__ void gemm_phase(LAS unsigned char* lds, const Gemm g, const Sched& S, const Epi& E) {
    int tid_ = threadIdx.x; asm volatile("" : "+v"(tid_));
    const int tid = tid_, wid = __builtin_amdgcn_readfirstlane(tid >> 6), lane = tid & 63, wr = wid >> 2, wc = wid & 3, fr = lane & 15, fq = lane >> 4;
    const int K = g.K, nt = K / BK;
    unsigned voffA[2], voffB[2];
#pragma unroll
    for (int i = 0; i < 2; ++i) { int R, C; stage_rc(tid * 16 + i * 8192, R, C); const int Rb = Epi::PERM ? ((R & ~31) + perm32(R & 31)) : R;
        voffA[i] = (unsigned)(R * g.lda + C) * 2u; voffB[i] = (unsigned)(Rb * g.ldb + C) * 2u; }
    const size_t kstep = (size_t)(BK * 2);
    const size_t hsA = (size_t)HALF * g.lda * 2, hsB = (size_t)HALF * g.ldb * 2;
    const size_t tsA = 2 * hsA, tsB = 2 * hsB;
    const unsigned ldsw = (unsigned)wid * 1024u;
    const int aoff = lds_byte(wr * 64 + fr, fq * 8), boff = lds_byte(wc * 32 + fr, fq * 8);
#define PG8_SA(b, h) (((b) * 2 + (h)) * HTB)
#define PG8_SB(b, h) ((4 + (b) * 2 + (h)) * HTB)
#define PG8_STAGE(bufoff, gbase, voff) do { _Pragma("unroll") for (int _i = 0; _i < 2; ++_i) \
        __builtin_amdgcn_global_load_lds((const unsigned*)((const char*)(gbase) + (voff)[_i]), (LAS unsigned*)(lds + (bufoff) + ldsw + _i * 8192), 16, 0, 0); } while (0)
#define PG8_LDA(dst, b, h) do { _Pragma("unroll") for (int m = 0; m < 4; ++m) _Pragma("unroll") for (int k = 0; k < 2; ++k) dst[m][k] = *(const LAS bf16x8*)(lds + PG8_SA(b, h) + aoff + m * 2048 + k * 1024); } while (0)
#define PG8_LDB(dst, b, h) do { _Pragma("unroll") for (int n = 0; n < 2; ++n) _Pragma("unroll") for (int k = 0; k < 2; ++k) dst[n][k] = *(const LAS bf16x8*)(lds + PG8_SB(b, h) + boff + n * 2048 + k * 1024); } while (0)
#define PG8_MMA(ai, bj, At, Bt) do { __builtin_amdgcn_s_setprio(1); _Pragma("unroll") for (int m = 0; m < 4; ++m) _Pragma("unroll") for (int n = 0; n < 2; ++n) _Pragma("unroll") for (int k = 0; k < 2; ++k) \
        acc[ai][bj][m][n] = __builtin_amdgcn_mfma_f32_16x16x32_bf16(Bt[n][k], At[m][k], acc[ai][bj][m][n], 0, 0, 0); __builtin_amdgcn_s_setprio(0); } while (0)
#define PG8_WAIT_V(n) asm volatile("s_waitcnt vmcnt(" #n ")" ::: "memory")
#define PG8_WAIT_L(n) asm volatile("s_waitcnt lgkmcnt(" #n ")" ::: "memory")
#define PG8_BAR __builtin_amdgcn_s_barrier()
#define PG8_SCHED __builtin_amdgcn_sched_barrier(0)
    Unit cur, nxt; int ui = 0;
    if (!S.next(0, cur)) return;
    f32x4 acc[2][2][4][2];
#pragma unroll
    for (int a = 0; a < 2; ++a)
#pragma unroll
        for (int b = 0; b < 2; ++b)
#pragma unroll
            for (int m = 0; m < 4; ++m)
#pragma unroll
                for (int n = 0; n < 2; ++n) acc[a][b][m][n] = (f32x4){0.f, 0.f, 0.f, 0.f};
    bf16x8 At[4][2], B0[2][2], B1[2][2];
    const char* cA = (const char*)g.A + (size_t)cur.pm * tsA; const char* cB = (const char*)g.Bt + (size_t)cur.pn * tsB;
    S.a_ready(cur);
    if constexpr (SP2) {
        PG8_STAGE(PG8_SB(0, 0), cB, voffB); PG8_STAGE(PG8_SB(0, 1), cB + hsB, voffB); PG8_STAGE(PG8_SA(0, 0), cA, voffA); PG8_STAGE(PG8_SA(0, 1), cA + hsA, voffA);
        if (wr == 1) PG8_BAR;
        PG8_WAIT_V(2); PG8_BAR;
        PG8_STAGE(PG8_SB(1, 0), cB + kstep, voffB); PG8_STAGE(PG8_SA(1, 0), cA + kstep, voffA); PG8_STAGE(PG8_SB(1, 1), cB + hsB + kstep, voffB);
        PG8_WAIT_V(6); PG8_BAR;
    } else {
        PG8_STAGE(PG8_SB(0, 0), cB, voffB); PG8_STAGE(PG8_SA(0, 0), cA, voffA); PG8_STAGE(PG8_SB(0, 1), cB + hsB, voffB); PG8_STAGE(PG8_SA(0, 1), cA + hsA, voffA);
        if (wr == 1) PG8_BAR;
        PG8_WAIT_V(4); PG8_BAR;
        PG8_STAGE(PG8_SB(1, 0), cB + kstep, voffB); PG8_STAGE(PG8_SA(1, 0), cA + kstep, voffA); PG8_STAGE(PG8_SB(1, 1), cB + hsB + kstep, voffB);
        PG8_WAIT_V(6); PG8_BAR;
    }
    for (;;) {
        const bool has_next = S.next(ui + 1, nxt);
        const char* nA = has_next ? (const char*)g.A + (size_t)nxt.pm * tsA : cA; const char* nB = has_next ? (const char*)g.Bt + (size_t)nxt.pn * tsB : cB;
#pragma nounroll
        for (int t = 0; t < nt; t += 2) {
            const bool last = (t == nt - 2);
            const char* a1 = cA + (size_t)(t + 1) * kstep;
            const char* a2 = last ? nA : cA + (size_t)(t + 2) * kstep; const char* b2 = last ? nB : cB + (size_t)(t + 2) * kstep;
            const char* a3 = a2 + kstep; const char* b3 = b2 + kstep;
            if (last && has_next) S.a_ready(nxt);
            if constexpr (SP2) {
            PG8_LDB(B0, 0, 0); PG8_LDB(B1, 0, 1); PG8_SCHED; PG8_LDA(At, 0, 0); PG8_STAGE(PG8_SA(1, 1), a1 + hsA, voffA);
            PG8_WAIT_V(8); PG8_WAIT_L(0); PG8_BAR; PG8_MMA(0, 0, At, B0); PG8_MMA(0, 1, At, B1); PG8_BAR; PG8_SCHED;
            PG8_LDA(At, 0, 1); PG8_STAGE(PG8_SB(0, 0), b2, voffB); PG8_STAGE(PG8_SB(0, 1), b2 + hsB, voffB); PG8_STAGE(PG8_SA(0, 0), a2, voffA);
            PG8_WAIT_V(8); PG8_WAIT_L(0); PG8_BAR; PG8_MMA(1, 0, At, B0); PG8_MMA(1, 1, At, B1); PG8_BAR; PG8_SCHED;
            PG8_LDB(B0, 1, 0); PG8_LDB(B1, 1, 1); PG8_SCHED; PG8_LDA(At, 1, 0); PG8_STAGE(PG8_SA(0, 1), a2 + hsA, voffA);
            PG8_WAIT_V(8); PG8_WAIT_L(0); PG8_BAR; PG8_MMA(0, 0, At, B0); PG8_MMA(0, 1, At, B1); PG8_BAR; PG8_SCHED;
            PG8_LDA(At, 1, 1); PG8_STAGE(PG8_SB(1, 0), b3, voffB); PG8_STAGE(PG8_SB(1, 1), b3 + hsB, voffB); PG8_STAGE(PG8_SA(1, 0), a3, voffA);
            PG8_WAIT_V(8); PG8_WAIT_L(0); PG8_BAR; PG8_MMA(1, 0, At, B0); PG8_MMA(1, 1, At, B1); PG8_BAR; PG8_SCHED;
            } else {
            PG8_LDB(B0, 0, 0); PG8_SCHED; PG8_LDA(At, 0, 0); PG8_STAGE(PG8_SA(1, 1), a1 + hsA, voffA);
            PG8_WAIT_L(8); PG8_BAR; PG8_WAIT_L(0); PG8_MMA(0, 0, At, B0); PG8_BAR; PG8_SCHED;
            PG8_LDB(B1, 0, 1); PG8_STAGE(PG8_SB(0, 0), b2, voffB);
            PG8_BAR; PG8_WAIT_L(0); PG8_MMA(0, 1, At, B1); PG8_BAR;
            PG8_LDA(At, 0, 1); PG8_STAGE(PG8_SA(0, 0), a2, voffA);
            PG8_BAR; PG8_WAIT_L(0); PG8_MMA(1, 0, At, B0); PG8_BAR; PG8_SCHED;
            PG8_STAGE(PG8_SB(0, 1), b2 + hsB, voffB);
            PG8_WAIT_V(6); PG8_BAR; PG8_MMA(1, 1, At, B1); PG8_BAR;
            PG8_LDB(B0, 1, 0); PG8_SCHED; PG8_LDA(At, 1, 0); PG8_STAGE(PG8_SA(0, 1), a2 + hsA, voffA);
            PG8_WAIT_L(8); PG8_BAR; PG8_WAIT_L(0); PG8_MMA(0, 0, At, B0); PG8_BAR; PG8_SCHED;
            PG8_LDB(B1, 1, 1); PG8_STAGE(PG8_SB(1, 0), b3, voffB);
            PG8_BAR; PG8_WAIT_L(0); PG8_MMA(0, 1, At, B1); PG8_BAR;
            PG8_LDA(At, 1, 1); PG8_STAGE(PG8_SA(1, 0), a3, voffA);
            PG8_BAR; PG8_WAIT_L(0); PG8_MMA(1, 0, At, B0); PG8_BAR; PG8_SCHED;
            PG8_STAGE(PG8_SB(1, 1), b3 + hsB, voffB);
            PG8_WAIT_V(6); PG8_BAR; PG8_MMA(1, 1, At, B1); PG8_BAR;
            }
        }
        if constexpr (ALIGN_EPI) { if (wr == 0) PG8_BAR; }
        E(acc, cur, wr, wc, fr, fq); S.done(cur);
        if (!has_next) break;
#pragma unroll
        for (int a = 0; a < 2; ++a)
#pragma unroll
            for (int b = 0; b < 2; ++b)
#pragma unroll
                for (int m = 0; m < 4; ++m)
#pragma unroll
                    for (int n = 0; n < 2; ++n) acc[a][b][m][n] = (f32x4){0.f, 0.f, 0.f, 0.f};
        cur = nxt; cA = nA; cB = nB; ++ui;
        if constexpr (ALIGN_EPI) { if (wr == 1) PG8_BAR; }
    }
    PG8_WAIT_V(0);
    if constexpr (!ALIGN_EPI) { if (wr == 0) PG8_BAR; }
    PG8_BAR;
#undef PG8_SA
#undef PG8_SB
#undef PG8_STAGE
#undef PG8_LDA
#undef PG8_LDB
#undef PG8_MMA
#undef PG8_WAIT_V
#undef PG8_WAIT_L
#undef PG8_BAR
#undef PG8_SCHED
}

struct EpiBf16 {
    static constexpr bool PERM = true;
    bf16_t* O; int ldc;
    __device__ __forceinline__ void operator()(const f32x4 (&acc)[2][2][4][2], const Unit& u, int wr, int wc, int fr, int fq) const {
        const int row0 = u.pm * BM + wr * 64 + fr, col0 = u.pn * BM + wc * 32 + 8 * fq;
#pragma unroll
        for (int ai = 0; ai < 2; ++ai)
#pragma unroll
            for (int m = 0; m < 4; ++m) { bf16_t* rowp = O + (size_t)(row0 + ai * HALF + m * 16) * ldc + col0;
#pragma unroll
                for (int bj = 0; bj < 2; ++bj) { const f32x4 v0 = acc[ai][bj][m][0], v1 = acc[ai][bj][m][1];
                    u32x4 w; w.x = cvt_pk_bf16(v0[0], v0[1]); w.y = cvt_pk_bf16(v0[2], v0[3]); w.z = cvt_pk_bf16(v1[0], v1[1]); w.w = cvt_pk_bf16(v1[2], v1[3]);
                    *(u32x4*)(rowp + bj * HALF) = w; } }
    }
};
struct EpiSwiglu {
    static constexpr bool PERM = true;
    bf16_t* H; int ldh;
    __device__ __forceinline__ void operator()(const f32x4 (&acc)[2][2][4][2], const Unit& u, int wr, int wc, int fr, int fq) const {
        const int row0 = u.pm * BM + wr * 64 + fr, col0 = u.pn * HALF + wc * 32 + 8 * fq;
#pragma unroll
        for (int ai = 0; ai < 2; ++ai)
#pragma unroll
            for (int m = 0; m < 4; ++m) { bf16_t* rowp = H + (size_t)(row0 + ai * HALF + m * 16) * ldh + col0;
                float h[8];
#pragma unroll
                for (int n = 0; n < 2; ++n)
#pragma unroll
                    for (int j = 0; j < 4; ++j) { const float gt = acc[ai][0][m][n][j], up = acc[ai][1][m][n][j]; h[n * 4 + j] = gt * __builtin_amdgcn_rcpf(1.0f + __expf(-gt)) * up; }
                *(u32x4*)rowp = pack8(h); }
    }
};
struct EpiRes {
    static constexpr bool PERM = false;
    const float* base; float* out; int ldc; float alpha, beta;
    __device__ __forceinline__ void operator()(const f32x4 (&acc)[2][2][4][2], const Unit& u, int wr, int wc, int fr, int fq) const {
        const int row0 = u.pm * BM + wr * 64 + fr, col0 = u.pn * BM + wc * 32 + 4 * fq;
#pragma unroll
        for (int ai = 0; ai < 2; ++ai)
#pragma unroll
            for (int m = 0; m < 4; ++m) { const size_t off = (size_t)(row0 + ai * HALF + m * 16) * ldc + col0;
#pragma unroll
                for (int bj = 0; bj < 2; ++bj)
#pragma unroll
                    for (int n = 0; n < 2; ++n) { const f32x4 b = *(const f32x4*)(base + off + bj * HALF + n * 16); *(f32x4*)(out + off + bj * HALF + n * 16) = b * alpha + acc[ai][bj][m][n] * beta; } }
    }
};
template <int KIND> struct EpiLR {
    static constexpr bool PERM = false;
    float* O32; bf16_t* G; const float* bias;
    __device__ __forceinline__ void operator()(const f32x4 (&acc)[2][2][4][2], const Unit& u, int wr, int wc, int fr, int fq) const {
        const int row0 = u.pm * BM + wr * 64 + fr, col0 = u.pn * BM + wc * 32 + 4 * fq;
#pragma unroll
        for (int bj = 0; bj < 2; ++bj)
#pragma unroll
            for (int n = 0; n < 2; ++n) { const int col = col0 + bj * HALF + n * 16;
                if (KIND < 2) { const f32x4 bb = *(const f32x4*)(bias + col); float* dst = O32 + (size_t)(col >> 10) * M * RW + (col & 1023);
#pragma unroll
                    for (int ai = 0; ai < 2; ++ai)
#pragma unroll
                        for (int m = 0; m < 4; ++m) { f32x4 o;
#pragma unroll
                            for (int j = 0; j < 4; ++j) { const float sg = sigmoidf_(acc[ai][bj][m][n][j] + bb[j]); o[j] = KIND == 0 ? -DECAY_SCALE * sg : sg; }
                            *(f32x4*)(dst + (size_t)(row0 + ai * HALF + m * 16) * RW) = o; }
                } else { bf16_t* dst = G + col;
#pragma unroll
                    for (int ai = 0; ai < 2; ++ai)
#pragma unroll
                        for (int m = 0; m < 4; ++m) { const f32x4 v = acc[ai][bj][m][n]; u32x2 w; w.x = cvt_pk_bf16(v[0], v[1]); w.y = cvt_pk_bf16(v[2], v[3]);
                            *(u32x2*)(dst + (size_t)(row0 + ai * HALF + m * 16) * RW) = w; }
                } }
    }
};
template <int BR> struct EpiGate {
    static constexpr bool PERM = false;
    const bf16_t* P; const float* gb; float* MIXF; bf16_t* MIXB;
    __device__ __forceinline__ void operator()(const f32x4 (&acc)[2][2][4][2], const Unit& u, int wr, int wc, int fr, int fq) const {
        const int row0 = u.pm * BM + wr * 64 + fr, col0 = u.pn * BM + wc * 32 + 4 * fq;
#pragma unroll
        for (int bj = 0; bj < 2; ++bj)
#pragma unroll
            for (int n = 0; n < 2; ++n) { const int col = col0 + bj * HALF + n * 16; const f32x4 bb = *(const f32x4*)(gb + BR * DM + col);
#pragma unroll
                for (int ai = 0; ai < 2; ++ai)
#pragma unroll
                    for (int m = 0; m < 4; ++m) { const int row = row0 + ai * HALF + m * 16;
                        const u32x2 gl = *(const u32x2*)(P + (size_t)row * DINP + PC_G + BR * DM + col);
                        f32x4 v;
                        v[0] = sigmoidf_(bflo(gl.x) + bb[0]) * acc[ai][bj][m][n][0]; v[1] = sigmoidf_(bfhi(gl.x) + bb[1]) * acc[ai][bj][m][n][1];
                        v[2] = sigmoidf_(bflo(gl.y) + bb[2]) * acc[ai][bj][m][n][2]; v[3] = sigmoidf_(bfhi(gl.y) + bb[3]) * acc[ai][bj][m][n][3];
                        float* mp = MIXF + (size_t)row * DM + col;
                        if (BR == 0) *(f32x4*)mp = v;
                        else if (BR == 1) *(f32x4*)mp = *(const f32x4*)mp + v;
                        else { const f32x4 t = *(const f32x4*)mp + v; u32x2 w; w.x = cvt_pk_bf16(t[0], t[1]); w.y = cvt_pk_bf16(t[2], t[3]); *(u32x2*)(MIXB + (size_t)row * DM + col) = w; } } }
    }
};
}

#define XB_TMO      128
#define XB_XCNT(j)  (256  + 64 * (j))
#define XB_XSUB(j)  (1280 + 64 * (j))
#define XB_XGEN(j)  (2304 + 64 * (j))
#define XB_TOP      3328
#define XB_TOPGEN   3392
#define XCD_BAR_WORDS 3456
#define XB_SPIN_CAP (1u << 18)
__device__ __forceinline__ unsigned xb_ld(unsigned* p)              { return __hip_atomic_load(p, __ATOMIC_RELAXED, __HIP_MEMORY_SCOPE_AGENT); }
__device__ __forceinline__ unsigned xb_add(unsigned* p, unsigned v) { return __hip_atomic_fetch_add(p, v, __ATOMIC_RELAXED, __HIP_MEMORY_SCOPE_AGENT); }
__device__ __forceinline__ unsigned xb_xcc_id() { return (unsigned)__builtin_amdgcn_s_getreg((3 << 11) | 20) & 0xFu; }
#define XB_SPIN(cond, bar) do { unsigned _sp = 0; while (cond) { __builtin_amdgcn_s_sleep(1); \
    if ((++_sp & 255u) == 0u) { if (xb_ld(&(bar)[XB_TMO])) break; if (_sp > XB_SPIN_CAP) { atomicAdd(&(bar)[XB_TMO], 1u); break; } } } } while (0)
struct XcdBarrier { unsigned* bar; unsigned x; volatile LAS unsigned* st; };
__device__ __forceinline__ XcdBarrier xcd_barrier_post(unsigned* bar, volatile LAS unsigned* st) {
    XcdBarrier b; b.bar = bar; b.x = xb_xcc_id(); b.st = st;
    if (threadIdx.x == 0) (void)xb_add(&bar[XB_XCNT(b.x)], 1u);
    return b;
}
__device__ __forceinline__ void xcd_barrier_complete(unsigned* bar, unsigned x, unsigned& nloc, unsigned& nx) {
    const unsigned G = gridDim.x * gridDim.y * gridDim.z;
    unsigned sum, cnt, mine, sp = 0u;
    for (;;) {
        sum = 0u; cnt = 0u; mine = 0u;
#pragma unroll
        for (unsigned j = 0; j < 16; ++j) { const unsigned c = xb_ld(&bar[XB_XCNT(j)]); sum += c; cnt += (c > 0u) ? 1u : 0u; mine = (j == x) ? c : mine; }
        if (sum == G) break;
        __builtin_amdgcn_s_sleep(1);
        if ((++sp & 255u) == 0u) { if (xb_ld(&bar[XB_TMO])) break; if (sp > XB_SPIN_CAP) { atomicAdd(&bar[XB_TMO], 1u); break; } }
    }
    nloc = mine > 0u ? mine : 1u; nx = cnt > 0u ? cnt : 1u;
}
__device__ __forceinline__ void xcd_barrier(const XcdBarrier& b) {
    asm volatile("s_waitcnt vmcnt(0)" ::: "memory");
    __syncthreads();
    if (threadIdx.x == 0) {
        unsigned* bar = b.bar;
        __builtin_amdgcn_s_waitcnt(0);
        unsigned nloc = b.st[0], nx = b.st[1];
        if (nloc == 0u) { xcd_barrier_complete(bar, b.x, nloc, nx); b.st[0] = nloc; b.st[1] = nx; }
        const unsigned old = xb_add(&bar[XB_XSUB(b.x)], 1u);
        const unsigned gen = old / nloc;
        if (old + 1u == (gen + 1u) * nloc) {
            __builtin_amdgcn_fence(__ATOMIC_RELEASE, "agent");
            asm volatile("s_waitcnt vmcnt(0)" ::: "memory");
            const unsigned og = xb_add(&bar[XB_TOP], 1u);
            const unsigned tg = og / nx;
            if (og + 1u == (tg + 1u) * nx) xb_add(&bar[XB_TOPGEN], 1u);
            else XB_SPIN(xb_ld(&bar[XB_TOPGEN]) == tg, bar);
            __builtin_amdgcn_fence(__ATOMIC_ACQUIRE, "agent");
            xb_add(&bar[XB_XGEN(b.x)], 1u);
            asm volatile("s_waitcnt vmcnt(0)" ::: "memory");
        } else {
            XB_SPIN(xb_ld(&bar[XB_XGEN(b.x)]) == gen, bar);
            __builtin_amdgcn_fence(__ATOMIC_ACQUIRE, "agent");
            asm volatile("s_waitcnt vmcnt(0)" ::: "memory");
        }
    }
    __syncthreads();
}

struct Args { const float* in[N_IN]; float* out; unsigned char* ws; int ph_lo, ph_hi; };
typedef const __attribute__((address_space(4))) Args* KArgs;
__device__ __forceinline__ KArgs kargs() { KArgs p = (KArgs)__builtin_amdgcn_kernarg_segment_ptr(); asm volatile("" : "+s"(p)); return p; }

template <int MODE>
__device__ __forceinline__ void cvt_tile(const float* W, int K, int N, bf16_t* WT, int item, int lane) {
    const int nblk = N / 32, kb = item / nblk, nb = item - kb * nblk, k0 = kb * 64, n0 = nb * 32;
    const int n4 = lane & 7, kg = lane >> 3;
    const float* src = W + (size_t)(k0 + kg * 8) * N + n0 + n4 * 4;
    f32x4 v[8];
#pragma unroll
    for (int kk = 0; kk < 8; ++kk) v[kk] = *(const f32x4*)(src + (size_t)kk * N);
    int drow = n0 + n4 * 4;
    if (MODE == 1) drow = (drow >> 7) * 256 + (drow & 127);
    if (MODE == 2) drow = (drow >> 7) * 256 + 128 + (drow & 127);
    bf16_t* dst = WT + (size_t)drow * K + k0 + kg * 8;
#pragma unroll
    for (int j = 0; j < 4; ++j) { u32x4 w; w.x = cvt_pk_bf16(v[0][j], v[1][j]); w.y = cvt_pk_bf16(v[2][j], v[3][j]); w.z = cvt_pk_bf16(v[4][j], v[5][j]); w.w = cvt_pk_bf16(v[6][j], v[7][j]);
        *(u32x4*)(dst + (size_t)j * K) = w; }
}

__device__ __forceinline__ void phase_cvt(KArgs a, int l, int gw, int NGW, int lane) {
    unsigned char* ws = a->ws;
    const float* f1g = a->in[I_F1G] + (size_t)l * DM * FF; const float* f1u = a->in[I_F1U] + (size_t)l * DM * FF; const float* f1d = a->in[I_F1D] + (size_t)l * FF * DM;
    const float* win = a->in[I_WIN] + (size_t)l * DM * DIN; const float* wkv = a->in[I_WKV] + (size_t)l * DM * DM; const float* wbr = a->in[I_WBR] + (size_t)l * 3 * RW * DM;
    const float* wout = a->in[I_WOUT] + (size_t)l * DM * DM;
    constexpr int T_GU = (DM / 64) * (FF / 32), T_D = (FF / 64) * (DM / 32), T_IN = (DM / 64) * (DIN / 32), T_SQ = (DM / 64) * (DM / 32), T_BR = (RW / 64) * (DM / 32);
    constexpr int NIT = 2 * T_GU + T_D + T_IN + 2 * T_SQ + 3 * T_BR;
    for (int it = gw; it < NIT; it += NGW) {
        int r = it;
        if (r < T_GU) { cvt_tile<1>(f1g, DM, FF, (bf16_t*)(ws + WS_WGU1), r, lane); continue; } r -= T_GU;
        if (r < T_GU) { cvt_tile<2>(f1u, DM, FF, (bf16_t*)(ws + WS_WGU1), r, lane); continue; } r -= T_GU;
        if (r < T_D) { cvt_tile<0>(f1d, FF, DM, (bf16_t*)(ws + WS_WD1), r, lane); continue; } r -= T_D;
        if (r < T_IN) { cvt_tile<0>(win, DM, DIN, (bf16_t*)(ws + WS_WIN), r, lane); continue; } r -= T_IN;
        if (r < T_SQ) { cvt_tile<0>(wkv, DM, DM, (bf16_t*)(ws + WS_WKV), r, lane); continue; } r -= T_SQ;
        if (r < T_BR) { cvt_tile<0>(wbr, RW, DM, (bf16_t*)(ws + WS_WBR), r, lane); continue; } r -= T_BR;
        if (r < T_BR) { cvt_tile<0>(wbr + (size_t)RW * DM, RW, DM, (bf16_t*)(ws + WS_WBR) + (size_t)DM * RW, r, lane); continue; } r -= T_BR;
        if (r < T_BR) { cvt_tile<0>(wbr + (size_t)2 * RW * DM, RW, DM, (bf16_t*)(ws + WS_WBR) + (size_t)2 * DM * RW, r, lane); continue; } r -= T_BR;
        cvt_tile<0>(wout, DM, DM, (bf16_t*)(ws + WS_WOUT), r, lane);
    }
    { u32x4* z = (u32x4*)((bf16_t*)(ws + WS_WIN) + (size_t)DIN * DM); const int nz = (DINP - DIN) * DM / 8;
      for (int i = gw * 64 + lane; i < nz; i += NGW * 64) z[i] = (u32x4){0u, 0u, 0u, 0u}; }
    { const float* wup = a->in[I_WUP] + (size_t)l * 2 * 64 * RW; const float* aup = a->in[I_AUP] + (size_t)l * 2 * 64 * RW; const float* gup = a->in[I_GUP] + (size_t)l * 128 * RW;
      bf16_t* wlr = (bf16_t*)(ws + WS_WLR);
      for (int i = gw * 64 + lane; i < LRN * (LRK / 8); i += NGW * 64) { const int n = i / (LRK / 8), kc = (i - n * (LRK / 8)) * 8; const int blk = n >> 10, nn = n & 1023;
          const int kb0 = blk < 4 ? 64 * blk : 256, kb1 = blk < 4 ? kb0 + 64 : 384;
          const float* src = blk < 2 ? wup + (size_t)blk * 64 * RW : (blk < 4 ? aup + (size_t)(blk - 2) * 64 * RW : gup);
          float f[8];
#pragma unroll
          for (int e = 0; e < 8; ++e) { const int k = kc + e; f[e] = (k >= kb0 && k < kb1) ? src[(size_t)(k - kb0) * RW + nn] : 0.f; }
          *(u32x4*)(wlr + (size_t)n * LRK + kc) = pack8(f); } }
    if (l == 0) { const f32x4* xs = (const f32x4*)a->in[I_X]; u32x2* xb = (u32x2*)(ws + WS_XB);
        for (size_t i = (size_t)gw * 64 + lane; i < (size_t)M * DM / 4; i += (size_t)NGW * 64) { const f32x4 v = xs[i]; u32x2 w; w.x = cvt_pk_bf16(v[0], v[1]); w.y = cvt_pk_bf16(v[2], v[3]); xb[i] = w; } }
    { const float* mg = a->in[I_MLNG] + (size_t)l * DM; const float* mb = a->in[I_MLNB] + (size_t)l * DM; bf16_t* memn = (bf16_t*)(ws + WS_MEMN);
      for (int m = gw; m < BATCH * NMEM; m += NGW) {
          const f32x4* xr = (const f32x4*)(a->in[I_MEM] + (size_t)m * DM) + lane; f32x4 v[8]; float s = 0.f;
#pragma unroll
          for (int j = 0; j < 8; ++j) { v[j] = xr[64 * j]; s += (v[j][0] + v[j][1]) + (v[j][2] + v[j][3]); }
          const float mean = wave_sum(s) * (1.f / DM); float s2 = 0.f;
#pragma unroll
          for (int j = 0; j < 8; ++j) { v[j] = v[j] - mean; s2 += (v[j][0] * v[j][0] + v[j][1] * v[j][1]) + (v[j][2] * v[j][2] + v[j][3] * v[j][3]); }
          const float rstd = rsqrtf(wave_sum(s2) * (1.f / DM) + LN_EPS);
#pragma unroll
          for (int j = 0; j < 8; ++j) { const f32x4 gg = *((const f32x4*)mg + lane + 64 * j), bb = *((const f32x4*)mb + lane + 64 * j); const f32x4 y = v[j] * rstd * gg + bb;
              u32x2 w; w.x = cvt_pk_bf16(y[0], y[1]); w.y = cvt_pk_bf16(y[2], y[3]); *((u32x2*)(memn + (size_t)m * DM) + lane + 64 * j) = w; } } }
}

__device__ __forceinline__ void phase_cvt2(KArgs a, int l, int gw, int NGW, int lane) {
    unsigned char* ws = a->ws;
    const float* f2g = a->in[I_F2G] + (size_t)l * DM * FF; const float* f2u = a->in[I_F2U] + (size_t)l * DM * FF; const float* f2d = a->in[I_F2D] + (size_t)l * FF * DM;
    constexpr int T_GU = (DM / 64) * (FF / 32), T_D = (FF / 64) * (DM / 32);
    constexpr int NIT = 2 * T_GU + T_D;
    for (int it = gw; it < NIT; it += NGW) {
        int r = it;
        if (r < T_GU) { cvt_tile<1>(f2g, DM, FF, (bf16_t*)(ws + WS_WGU2), r, lane); continue; } r -= T_GU;
        if (r < T_GU) { cvt_tile<2>(f2u, DM, FF, (bf16_t*)(ws + WS_WGU2), r, lane); continue; } r -= T_GU;
        cvt_tile<0>(f2d, FF, DM, (bf16_t*)(ws + WS_WD2), r, lane);
    }
}

__device__ __forceinline__ void phase_ln(const float* src, float* dst, bf16_t* dstb, const float* g, const float* b, int gw, int NGW, int lane) {
    for (int m = gw; m < M; m += NGW) {
        const f32x4* xr = (const f32x4*)(src + (size_t)m * DM) + lane; f32x4 v[8]; float s = 0.f;
#pragma unroll
        for (int j = 0; j < 8; ++j) { v[j] = xr[64 * j]; s += (v[j][0] + v[j][1]) + (v[j][2] + v[j][3]); }
        const float mean = wave_sum(s) * (1.f / DM); float s2 = 0.f;
#pragma unroll
        for (int j = 0; j < 8; ++j) { v[j] = v[j] - mean; s2 += (v[j][0] * v[j][0] + v[j][1] * v[j][1]) + (v[j][2] * v[j][2] + v[j][3] * v[j][3]); }
        const float rstd = rsqrtf(wave_sum(s2) * (1.f / DM) + LN_EPS);
#pragma unroll
        for (int j = 0; j < 8; ++j) { const f32x4 gg = *((const f32x4*)g + lane + 64 * j), bb = *((const f32x4*)b + lane + 64 * j); const f32x4 y = v[j] * rstd * gg + bb;
            *((f32x4*)(dst + (size_t)m * DM) + lane + 64 * j) = y;
            if (dstb) { u32x2 w; w.x = cvt_pk_bf16(y[0], y[1]); w.y = cvt_pk_bf16(y[2], y[3]); *((u32x2*)(dstb + (size_t)m * DM) + lane + 64 * j) = w; } }
    }
}

__device__ __forceinline__ void phase_elt(KArgs a, int l, int gw, int NGW, int lane) {
    unsigned char* ws = a->ws;
    const bf16_t* P = (const bf16_t*)(ws + WS_P);
    bf16_t* Rb = (bf16_t*)(ws + WS_R); bf16_t* Kb = (bf16_t*)(ws + WS_K); bf16_t* Vb = (bf16_t*)(ws + WS_V); bf16_t* KKb = (bf16_t*)(ws + WS_KK);
    bf16_t* AC = (bf16_t*)(ws + WS_ACAT); bf16_t* YS = (bf16_t*)(ws + WS_YS);
    const float* mu = a->in[I_MU] + (size_t)l * 3456; const float* k_k = a->in[I_KK] + (size_t)l * RW; const float* cw = a->in[I_CONVW] + (size_t)l * 3 * RW;
    for (int m = gw; m < M; m += NGW) {
        const int t = m & (SEQ - 1); const bool hp = t > 0, hn = t < SEQ - 1;
        const bf16_t* pc = P + (size_t)m * DINP;
#pragma unroll
        for (int j = 0; j < 7; ++j) {
            const int c0 = 8 * (lane + 64 * j);
            if (j == 6 && lane >= 48) continue;
            const u32x4 zc = (u32x4){0u, 0u, 0u, 0u};
            const u32x4 wc_ = *(const u32x4*)(pc + c0); const u32x4 wp = hp ? *(const u32x4*)(pc - DINP + c0) : zc; const u32x4 wn = hn ? *(const u32x4*)(pc + DINP + c0) : zc;
            float cu[8], pv[8], nx[8], s[8]; unpack8(wc_, cu); unpack8(wp, pv); unpack8(wn, nx);
            const f32x4 m0 = *(const f32x4*)(mu + c0), m1 = *(const f32x4*)(mu + c0 + 4);
#pragma unroll
            for (int e = 0; e < 8; ++e) { const float mm = e < 4 ? m0[e] : m1[e - 4]; s[e] = cu[e] + mm * (0.5f * (pv[e] + nx[e]) - cu[e]); }
            if (j < 2) { *(u32x4*)(Rb + (size_t)m * RW + c0) = pack8(s); }
            else if (j < 4) { const int c = c0 - 1024; *(u32x4*)(Kb + (size_t)m * RW + c) = pack8(s);
                const f32x4 k0 = *(const f32x4*)(k_k + c), k1 = *(const f32x4*)(k_k + c + 4); float kx[8]; float ss = 0.f;
#pragma unroll
                for (int e = 0; e < 8; ++e) { kx[e] = s[e] * (e < 4 ? k0[e] : k1[e - 4]); ss += kx[e] * kx[e]; }
                ss = sum8(ss); const float inv = rsqrtf(ss + 1e-12f);
#pragma unroll
                for (int e = 0; e < 8; ++e) kx[e] *= inv;
                *(u32x4*)(KKb + (size_t)m * RW + c) = pack8(kx); }
            else if (j < 6) { *(u32x4*)(Vb + (size_t)m * RW + (c0 - 2048)) = pack8(s); }
            else { const int cc = c0 - 3072; float f[8];
#pragma unroll
                for (int e = 0; e < 8; ++e) f[e] = cc < 128 ? tanhf(s[e]) : (cc < 256 ? s[e] : sigmoidf_(s[e]));
                *(u32x4*)(AC + (size_t)m * LRK + cc) = pack8(f); }
        }
#pragma unroll
        for (int j = 0; j < 2; ++j) {
            const int c = 8 * (lane + 64 * j);
            const u32x4 zc = (u32x4){0u, 0u, 0u, 0u};
            float gbv[8], gc[8], hh[8], up[8], uc[8], un[8];
            unpack8(*(const u32x4*)(pc + PC_CB + c), gbv);
            unpack8(*(const u32x4*)(pc + PC_CC + c), gc); unpack8(*(const u32x4*)(pc + PC_CH + c), hh);
#pragma unroll
            for (int e = 0; e < 8; ++e) uc[e] = gc[e] * hh[e];
            unpack8(hp ? *(const u32x4*)(pc - DINP + PC_CC + c) : zc, gc); unpack8(hp ? *(const u32x4*)(pc - DINP + PC_CH + c) : zc, hh);
#pragma unroll
            for (int e = 0; e < 8; ++e) up[e] = gc[e] * hh[e];
            unpack8(hn ? *(const u32x4*)(pc + DINP + PC_CC + c) : zc, gc); unpack8(hn ? *(const u32x4*)(pc + DINP + PC_CH + c) : zc, hh);
#pragma unroll
            for (int e = 0; e < 8; ++e) un[e] = gc[e] * hh[e];
            float o[8];
#pragma unroll
            for (int e = 0; e < 8; ++e) o[e] = gbv[e] * (cw[c + e] * up[e] + cw[RW + c + e] * uc[e] + cw[2 * RW + c + e] * un[e]);
            *(u32x4*)(YS + (size_t)m * 3072 + 1024 + c) = pack8(o);
        }
    }
}

constexpr int XA_PITCH = 528;
__device__ __forceinline__ void xattn_unit(KArgs a, int unit, LAS unsigned char* lds, int tid, int wave, int lane) {
    unsigned char* ws = a->ws;
    const bf16_t* P = (const bf16_t*)(ws + WS_P); const bf16_t* KM = (const bf16_t*)(ws + WS_KMEM); const bf16_t* VT = (const bf16_t*)(ws + WS_VT); bf16_t* YS = (bf16_t*)(ws + WS_YS);
    const int bb = unit >> 7, h = (unit >> 5) & 3, qt = unit & 31, fr = lane & 15, fq = lane >> 4;
    const int mrow = bb * SEQ + qt * 128 + wave * 16 + fr;
    bf16x8 qf[8];
#pragma unroll
    for (int ks = 0; ks < 8; ++ks) qf[ks] = *(const bf16x8*)(P + (size_t)mrow * DINP + PC_Q + h * 256 + 32 * ks + 8 * fq);
#pragma unroll 4
    for (int it = 0; it < 16; ++it) { const int idx = tid + 512 * it, key = idx >> 5, ch = idx & 31;
        const u32x4 v = *(const u32x4*)(KM + (size_t)(bb * NMEM + key) * 1024 + h * 256 + ch * 8);
        *(LAS u32x4*)(lds + key * XA_PITCH + ch * 16) = v; }
    __syncthreads();
    f32x4 sacc[16];
#pragma unroll
    for (int kb = 0; kb < 16; ++kb) { f32x4 acc = (f32x4){0.f, 0.f, 0.f, 0.f};
#pragma unroll
        for (int ks = 0; ks < 8; ++ks) { const bf16x8 kf = *(const LAS bf16x8*)(lds + (kb * 16 + fr) * XA_PITCH + (32 * ks + 8 * fq) * 2);
            acc = __builtin_amdgcn_mfma_f32_16x16x32_bf16(kf, qf[ks], acc, 0, 0, 0); }
        sacc[kb] = acc; }
    float mx = -3.0e38f;
#pragma unroll
    for (int kb = 0; kb < 16; ++kb)
#pragma unroll
        for (int i = 0; i < 4; ++i) mx = fmaxf(mx, sacc[kb][i]);
    mx = fmaxf(mx, __shfl_xor(mx, 16)); mx = fmaxf(mx, __shfl_xor(mx, 32));
    float sum = 0.f;
#pragma unroll
    for (int kb = 0; kb < 16; ++kb)
#pragma unroll
        for (int i = 0; i < 4; ++i) { const float p = __expf((sacc[kb][i] - mx) * 0.0625f); sacc[kb][i] = p; sum += p; }
    sum += __shfl_xor(sum, 16); sum += __shfl_xor(sum, 32);
    const float rs = 1.0f / sum;
    bf16x8 pf[8];
#pragma unroll
    for (int s2 = 0; s2 < 8; ++s2) { u32x4 w; w.x = cvt_pk_bf16(sacc[2 * s2][0], sacc[2 * s2][1]); w.y = cvt_pk_bf16(sacc[2 * s2][2], sacc[2 * s2][3]);
        w.z = cvt_pk_bf16(sacc[2 * s2 + 1][0], sacc[2 * s2 + 1][1]); w.w = cvt_pk_bf16(sacc[2 * s2 + 1][2], sacc[2 * s2 + 1][3]); pf[s2] = __builtin_bit_cast(bf16x8, w); }
    __syncthreads();
#pragma unroll 4
    for (int it = 0; it < 16; ++it) { const int idx = tid + 512 * it, d = idx >> 5, ch = idx & 31;
        const u32x4 v = *(const u32x4*)(VT + (size_t)(h * 256 + d) * 512 + bb * NMEM + ch * 8);
        *(LAS u32x4*)(lds + d * XA_PITCH + ch * 16) = v; }
    __syncthreads();
#pragma unroll
    for (int db = 0; db < 16; ++db) { f32x4 acc = (f32x4){0.f, 0.f, 0.f, 0.f};
#pragma unroll
        for (int s2 = 0; s2 < 8; ++s2) { const LAS unsigned char* rp = lds + (db * 16 + fr) * XA_PITCH;
            const u32x2 lo = *(const LAS u32x2*)(rp + (32 * s2 + 4 * fq) * 2), hi = *(const LAS u32x2*)(rp + (32 * s2 + 16 + 4 * fq) * 2);
            u32x4 w; w.x = lo.x; w.y = lo.y; w.z = hi.x; w.w = hi.y;
            acc = __builtin_amdgcn_mfma_f32_16x16x32_bf16(__builtin_bit_cast(bf16x8, w), pf[s2], acc, 0, 0, 0); }
        u32x2 o; o.x = cvt_pk_bf16(acc[0] * rs, acc[1] * rs); o.y = cvt_pk_bf16(acc[2] * rs, acc[3] * rs);
        *(u32x2*)(YS + (size_t)mrow * 3072 + 2048 + h * 256 + db * 16 + 4 * fq) = o; }
    __syncthreads();
}

constexpr int SC_TC = 32;
constexpr int SC_BUF = SC_TC * 5 * 64 * 4;
constexpr int SC_VOFF = SC_BUF, SC_YOFF = SC_BUF + SC_TC * 16 * 4, SC_STRIDE = SC_YOFF + SC_TC * 16 * 4;
__device__ __forceinline__ void phase_scan(KArgs a, int l, int wgid, LAS unsigned char* lds, int tid, int wave, int lane) {
    unsigned char* ws = a->ws;
    const int seq = wgid >> 2, rq = wgid & 3, dir = seq >> 5, bb = (seq >> 4) & 1, h = seq & 15;
    const float* W2 = (const float*)(ws + WS_W2) + (size_t)dir * M * RW; const float* A2 = (const float*)(ws + WS_A2) + (size_t)dir * M * RW;
    const bf16_t* KKb = (const bf16_t*)(ws + WS_KK); const bf16_t* Kb = (const bf16_t*)(ws + WS_K); const bf16_t* Rb = (const bf16_t*)(ws + WS_R); const bf16_t* Vb = (const bf16_t*)(ws + WS_V);
    bf16_t* Y = (bf16_t*)(ws + (dir ? WS_YB : WS_YF));
    const float* k_a = a->in[I_KA] + (size_t)l * RW;
    const int ss = tid >> 4, kq = tid & 15;
    const f32x4 ka4 = *(const f32x4*)(k_a + h * 64 + 4 * kq);
    f32x4 gw_, ga_; u32x2 gkk, gk, gr; unsigned short gv;
#define SC_LOAD(ci) do { const int tk = (ci) * SC_TC + ss; const int tok = dir ? (SEQ - 1 - tk) : tk; const size_t mo = (size_t)(bb * SEQ + tok) * RW + h * 64; \
        gw_ = *(const f32x4*)(W2 + mo + 4 * kq); ga_ = *(const f32x4*)(A2 + mo + 4 * kq); gkk = *(const u32x2*)(KKb + mo + 4 * kq); gk = *(const u32x2*)(Kb + mo + 4 * kq); gr = *(const u32x2*)(Rb + mo + 4 * kq); \
        gv = Vb[mo + rq * 16 + kq]; } while (0)
#define SC_STORE(buf) do { LAS unsigned char* bp = lds + (buf) * SC_STRIDE; LAS float* vp = (LAS float*)(bp + (ss * 5) * 256 + kq * 16); \
        f32x4 kk4 = (f32x4){bflo(gkk.x), bfhi(gkk.x), bflo(gkk.y), bfhi(gkk.y)}; f32x4 k4 = (f32x4){bflo(gk.x), bfhi(gk.x), bflo(gk.y), bfhi(gk.y)}; f32x4 r4 = (f32x4){bflo(gr.x), bfhi(gr.x), bflo(gr.y), bfhi(gr.y)}; \
        *(LAS f32x4*)(vp) = (f32x4){__expf(gw_[0]), __expf(gw_[1]), __expf(gw_[2]), __expf(gw_[3])}; *(LAS f32x4*)(vp + 64) = kk4; *(LAS f32x4*)(vp + 128) = kk4 * ga_; *(LAS f32x4*)(vp + 192) = k4 * (1.0f + (ga_ - 1.0f) * ka4); *(LAS f32x4*)(vp + 256) = r4; \
        ((LAS float*)(bp + SC_VOFF))[ss * 16 + kq] = __uint_as_float((unsigned)gv << 16); } while (0)
    const int rg = lane >> 4, kc = lane & 15, myrow = 4 * wave + rg;
    f32x4 S = (f32x4){0.f, 0.f, 0.f, 0.f};
#define SC_ROWSUM(x) do { x += __builtin_bit_cast(float, __builtin_amdgcn_update_dpp(0, __builtin_bit_cast(int, x), 0x128, 0xf, 0xf, false)); \
        x += __builtin_bit_cast(float, __builtin_amdgcn_update_dpp(0, __builtin_bit_cast(int, x), 0x124, 0xf, 0xf, false)); \
        x += __builtin_bit_cast(float, __builtin_amdgcn_update_dpp(0, __builtin_bit_cast(int, x), 0x122, 0xf, 0xf, false)); \
        x += __builtin_bit_cast(float, __builtin_amdgcn_update_dpp(0, __builtin_bit_cast(int, x), 0x121, 0xf, 0xf, false)); } while (0)
    SC_LOAD(0); SC_STORE(0);
    __syncthreads();
    constexpr int NCH = SEQ / SC_TC;
    for (int ci = 0; ci < NCH; ++ci) {
        const int buf = ci & 1;
        if (ci + 1 < NCH) SC_LOAD(ci + 1);
        if (wave < 4) {
            const LAS unsigned char* bp = lds + buf * SC_STRIDE;
            const LAS float* vb = (const LAS float*)(bp + SC_VOFF) + myrow; LAS float* yb = (LAS float*)(lds + buf * SC_STRIDE + SC_YOFF) + kc * 16 + myrow;
            const LAS float* vp0 = (const LAS float*)bp + 4 * kc;
            f32x4 w4 = *(const LAS f32x4*)(vp0), kk4 = *(const LAS f32x4*)(vp0 + 64), b4 = *(const LAS f32x4*)(vp0 + 128), kd4 = *(const LAS f32x4*)(vp0 + 192), r4 = *(const LAS f32x4*)(vp0 + 256);
            float vv = vb[0], ykeep = 0.f;
#pragma unroll
            for (int s = 0; s < SC_TC; ++s) {
                const LAS float* vpn = vp0 + ((s + 1) & (SC_TC - 1)) * 320;
                const f32x4 nw4 = *(const LAS f32x4*)(vpn), nkk4 = *(const LAS f32x4*)(vpn + 64), nb4 = *(const LAS f32x4*)(vpn + 128), nkd4 = *(const LAS f32x4*)(vpn + 192), nr4 = *(const LAS f32x4*)(vpn + 256);
                const float nvv = vb[((s + 1) & (SC_TC - 1)) * 16];
                f32x2 p = (f32x2){S[0], S[1]} * (f32x2){kk4[0], kk4[1]}; p = (f32x2){S[2], S[3]} * (f32x2){kk4[2], kk4[3]} + p;
                float d = p.x + p.y;
                SC_ROWSUM(d);
                S = S * w4 + (kd4 * vv - b4 * d);
                f32x2 q = (f32x2){S[0], S[1]} * (f32x2){r4[0], r4[1]}; q = (f32x2){S[2], S[3]} * (f32x2){r4[2], r4[3]} + q;
                float y = q.x + q.y;
                SC_ROWSUM(y);
                ykeep = (kc == (s & 15)) ? y : ykeep;
                if ((s & 15) == 15) yb[(s >> 4) * 256] = ykeep;
                w4 = nw4; kk4 = nkk4; b4 = nb4; kd4 = nkd4; r4 = nr4; vv = nvv;
            }
        }
        if (ci + 1 < NCH) SC_STORE(buf ^ 1);
        __syncthreads();
        { const int tk = ci * SC_TC + ss; const int tok = dir ? (SEQ - 1 - tk) : tk;
          Y[(size_t)(bb * SEQ + tok) * RW + h * 64 + rq * 16 + kq] = (bf16_t)(cvt_pk_bf16(((const LAS float*)(lds + buf * SC_STRIDE + SC_YOFF))[ss * 16 + kq], 0.f) & 0xffffu); }
    }
    __syncthreads();
#undef SC_LOAD
#undef SC_STORE
}

typedef float f32x16 __attribute__((ext_vector_type(16)));
typedef __bf16 bf16x2_t __attribute__((ext_vector_type(2)));
__device__ __forceinline__ unsigned pkbf(float a, float b) { const f32x2 v = {a, b}; return __builtin_bit_cast(unsigned, __builtin_convertvector(v, bf16x2_t)); }
#define CS_PACK(x, s) __builtin_bit_cast(bf16x8, (u32x4){pkbf((x)[8 * (s)], (x)[8 * (s) + 1]), pkbf((x)[8 * (s) + 2], (x)[8 * (s) + 3]), pkbf((x)[8 * (s) + 4], (x)[8 * (s) + 5]), pkbf((x)[8 * (s) + 6], (x)[8 * (s) + 7])})
#define MF32(a, b, c) __builtin_amdgcn_mfma_f32_32x32x16_bf16((a), (b), (c), 0, 0, 0)
constexpr int CS_C = 32, CS_NCH = SEQ / CS_C;
constexpr int CS_TP = 144, CS_XP = 72;
constexpr int CS_TQ = 0, CS_TR = 4608, CS_TB = 9216, CS_TK = 13824, CS_XQ = 18432, CS_XB = 23040, CS_XK = 27648, CS_XV = 32256, CS_ELC = 36864, CS_WAVE = 37376;
static_assert(4 * CS_WAVE <= LDS_MISC, "scan_pre LDS");
__device__ __forceinline__ int cs_rho(int k) { return (k >> 1) + 32 * (k & 1); }
__device__ __forceinline__ int cs_swz(int row, int pos) { return ((((pos >> 3) ^ (row & 7)) << 4) + ((pos >> 2) & 1) * 8); }
__device__ __forceinline__ void scan_pre(KArgs a, int l, int bid, int G, LAS unsigned char* lds, int wave, int lane) {
    if (wave >= 4) return;
    unsigned char* ws = a->ws;
    LAS unsigned char* wb = lds + wave * CS_WAVE;
    const int r = lane & 31, h = lane >> 5;
    const bf16_t* KKb = (const bf16_t*)(ws + WS_KK); const bf16_t* Kb = (const bf16_t*)(ws + WS_K); const bf16_t* Rb = (const bf16_t*)(ws + WS_R); const bf16_t* Vb = (const bf16_t*)(ws + WS_V);
    const float* k_a = a->in[I_KA] + (size_t)l * RW;
    f32x16 zero;
#pragma unroll
    for (int i = 0; i < 16; ++i) zero[i] = 0.f;
    for (int item = bid * 4 + wave; item < 64 * CS_NCH; item += G * 4) {
        const int seq = item >> 7, chunk = item & (CS_NCH - 1), dir = seq >> 5, bb = (seq >> 4) & 1, hd = seq & 15;
        const float* LW = (const float*)(ws + WS_W2) + (size_t)dir * M * RW; const float* A2 = (const float*)(ws + WS_A2) + (size_t)dir * M * RW;
        {
            const int half = h, kp = r, c0 = chunk * CS_C;
            const f32x2 ka2 = *(const f32x2*)(k_a + hd * 64 + 2 * kp);
            f32x2 lw[16]; f32x2 tot = (f32x2){0.f, 0.f};
#pragma unroll
            for (int i = 0; i < 16; ++i) { const int tk = c0 + 16 * half + i; const int tok = dir ? (SEQ - 1 - tk) : tk; lw[i] = *(const f32x2*)(LW + (size_t)(bb * SEQ + tok) * RW + hd * 64 + 2 * kp); tot += lw[i]; }
            f32x2 run; run.x = __shfl(tot.x, kp); run.y = __shfl(tot.y, kp);
            if (half == 0) run = (f32x2){0.f, 0.f};
            unsigned pq0 = 0, pq1 = 0, pb0 = 0, pb1 = 0, pk0 = 0, pk1 = 0, pv = 0;
            float oq0 = 0, oq1 = 0, ob0 = 0, ob1 = 0, ok0 = 0, ok1 = 0;
#pragma unroll
            for (int i = 0; i < 16; ++i) {
                const int tl = 16 * half + i, tk = c0 + tl; const int tok = dir ? (SEQ - 1 - tk) : tk; const size_t mo = (size_t)(bb * SEQ + tok) * RW + hd * 64 + 2 * kp;
                const f32x2 av = *(const f32x2*)(A2 + mo); const unsigned kkw = *(const unsigned*)(KKb + mo), kw = *(const unsigned*)(Kb + mo), rw = *(const unsigned*)(Rb + mo), vw = *(const unsigned*)(Vb + mo);
                const f32x2 Lm = run; run += lw[i];
                const f32x2 eL = (f32x2){__expf(run.x), __expf(run.y)}, eLm = (f32x2){__expf(Lm.x), __expf(Lm.y)}, ei = (f32x2){__expf(-run.x), __expf(-run.y)};
                const f32x2 kk2 = (f32x2){bflo(kkw), bfhi(kkw)}, k2 = (f32x2){bflo(kw), bfhi(kw)}, r2 = (f32x2){bflo(rw), bfhi(rw)};
                const f32x2 q = kk2 * eLm, rt = r2 * eL, bt = kk2 * av * ei, kt = k2 * (1.0f + (av - 1.0f) * ka2) * ei;
                *(LAS unsigned*)(wb + CS_TQ + tl * CS_TP + 4 * kp) = pkbf(q.x, q.y); *(LAS unsigned*)(wb + CS_TR + tl * CS_TP + 4 * kp) = pkbf(rt.x, rt.y);
                *(LAS unsigned*)(wb + CS_TB + tl * CS_TP + 4 * kp) = pkbf(bt.x, bt.y); *(LAS unsigned*)(wb + CS_TK + tl * CS_TP + 4 * kp) = pkbf(kt.x, kt.y);
                if ((i & 1) == 0) { oq0 = q.x; oq1 = q.y; ob0 = bt.x; ob1 = bt.y; ok0 = kt.x; ok1 = kt.y; pv = vw; }
                else {
                    pq0 = pkbf(oq0, q.x); pq1 = pkbf(oq1, q.y); pb0 = pkbf(ob0, bt.x); pb1 = pkbf(ob1, bt.y); pk0 = pkbf(ok0, kt.x); pk1 = pkbf(ok1, kt.y);
                    const int co = 2 * (tl - 1);
                    *(LAS unsigned*)(wb + CS_XQ + kp * CS_XP + co) = pq0; *(LAS unsigned*)(wb + CS_XQ + (32 + kp) * CS_XP + co) = pq1;
                    *(LAS unsigned*)(wb + CS_XB + kp * CS_XP + co) = pb0; *(LAS unsigned*)(wb + CS_XB + (32 + kp) * CS_XP + co) = pb1;
                    *(LAS unsigned*)(wb + CS_XK + kp * CS_XP + co) = pk0; *(LAS unsigned*)(wb + CS_XK + (32 + kp) * CS_XP + co) = pk1;
                    *(LAS unsigned*)(wb + CS_XV + kp * CS_XP + co) = (pv & 0xffffu) | (vw << 16); *(LAS unsigned*)(wb + CS_XV + (32 + kp) * CS_XP + co) = (pv >> 16) | (vw & 0xffff0000u);
                }
                if (i == 15 && half == 1) *(LAS f32x2*)(wb + CS_ELC + 8 * kp) = eL;
            }
        }
#define CS_TFRAG(off, ks) (*(const LAS bf16x8*)(wb + (off) + r * CS_TP + (16 * (ks) + 8 * h) * 2))
#define CS_XFRAG(off, tile, s) __builtin_bit_cast(bf16x8, (u32x4){ (*(const LAS u32x2*)(wb + (off) + cs_rho(32 * (tile) + r) * CS_XP + (16 * (s) + 4 * h) * 2)).x, (*(const LAS u32x2*)(wb + (off) + cs_rho(32 * (tile) + r) * CS_XP + (16 * (s) + 4 * h) * 2)).y, \
                                                             (*(const LAS u32x2*)(wb + (off) + cs_rho(32 * (tile) + r) * CS_XP + (16 * (s) + 8 + 4 * h) * 2)).x, (*(const LAS u32x2*)(wb + (off) + cs_rho(32 * (tile) + r) * CS_XP + (16 * (s) + 8 + 4 * h) * 2)).y })
        f32x16 Tm, TmT, AkqT, Abr, Akr;
        {
            bf16x8 fq[4], fr[4], fb[4], fk[4];
#pragma unroll
            for (int ks = 0; ks < 4; ++ks) { fq[ks] = CS_TFRAG(CS_TQ, ks); fr[ks] = CS_TFRAG(CS_TR, ks); fb[ks] = CS_TFRAG(CS_TB, ks); fk[ks] = CS_TFRAG(CS_TK, ks); }
            f32x16 Nn = zero, NnT = zero; AkqT = zero; Abr = zero; Akr = zero;
#pragma unroll
            for (int ks = 0; ks < 4; ++ks) { Nn = MF32(fb[ks], fq[ks], Nn); NnT = MF32(fq[ks], fb[ks], NnT); AkqT = MF32(fq[ks], fk[ks], AkqT); Abr = MF32(fb[ks], fr[ks], Abr); Akr = MF32(fk[ks], fr[ks], Akr); }
#pragma unroll
            for (int i = 0; i < 16; ++i) { const int row = (i & 3) + 8 * (i >> 2) + 4 * h;
                Nn[i] = row < r ? -Nn[i] : 0.f;
                NnT[i] = r < row ? -NnT[i] : 0.f;
                AkqT[i] = r < row ? AkqT[i] : 0.f;
                Abr[i] = row <= r ? Abr[i] : 0.f;
                Akr[i] = row <= r ? Akr[i] : 0.f; }
            f32x16 P = Nn, PT = NnT; Tm = Nn; TmT = NnT;
#pragma unroll
            for (int i = 0; i < 16; ++i) { const int row = (i & 3) + 8 * (i >> 2) + 4 * h; if (row == r) { Tm[i] += 1.0f; TmT[i] += 1.0f; } }
#pragma unroll
            for (int it = 0; it < 4; ++it) {
                const bf16x8 p0 = CS_PACK(P, 0), p1 = CS_PACK(P, 1), t0 = CS_PACK(PT, 0), t1 = CS_PACK(PT, 1);
                f32x16 P2 = MF32(t0, p0, zero); P2 = MF32(t1, p1, P2);
                if (it < 3) { f32x16 P2T = MF32(p0, t0, zero); P2T = MF32(p1, t1, P2T); PT = P2T; }
                P = P2;
                const bf16x8 n0 = CS_PACK(P, 0), n1 = CS_PACK(P, 1), m0 = CS_PACK(TmT, 0), m1 = CS_PACK(TmT, 1);
                f32x16 Tn = MF32(m0, n0, Tm); Tn = MF32(m1, n1, Tn);
                if (it < 3) { f32x16 TnT = MF32(n0, m0, TmT); TnT = MF32(n1, m1, TnT); TmT = TnT; }
                Tm = Tn;
            }
        }
        const size_t rec = (size_t)seq * CS_NCH + chunk;
        unsigned char* gMs = ws + WS_CMS + rec * 8192; unsigned char* gNs = ws + WS_CNS + rec * 8192; unsigned char* gGy = ws + WS_CGY + rec * 4096; unsigned char* gYl = ws + WS_CYL + rec * 4096;
        const bf16x8 tm0 = CS_PACK(Tm, 0), tm1 = CS_PACK(Tm, 1);
        f32x16 ATt = MF32(tm0, CS_PACK(AkqT, 0), zero); ATt = MF32(tm1, CS_PACK(AkqT, 1), ATt);
        const bf16x8 at0 = CS_PACK(ATt, 0), at1 = CS_PACK(ATt, 1), ab0 = CS_PACK(Abr, 0), ab1 = CS_PACK(Abr, 1);
        bf16x8 qa[2][2];
#pragma unroll
        for (int kt = 0; kt < 2; ++kt) { f32x16 Q_ = MF32(tm0, CS_XFRAG(CS_XQ, kt, 0), zero); Q_ = MF32(tm1, CS_XFRAG(CS_XQ, kt, 1), Q_); qa[kt][0] = CS_PACK(Q_, 0); qa[kt][1] = CS_PACK(Q_, 1); }
#pragma unroll
        for (int kt = 0; kt < 2; ++kt) { f32x16 Gm = MF32(qa[kt][0], ab0, zero); Gm = MF32(qa[kt][1], ab1, Gm);
#pragma unroll
            for (int g = 0; g < 4; ++g) { const int k0 = 32 * kt + 8 * g + 4 * h; const u32x2 rv = *(const LAS u32x2*)(wb + CS_TR + r * CS_TP + k0 * 2);
                u32x2 o; o.x = pkbf(bflo(rv.x) - Gm[4 * g], bfhi(rv.x) - Gm[4 * g + 1]); o.y = pkbf(bflo(rv.y) - Gm[4 * g + 2], bfhi(rv.y) - Gm[4 * g + 3]);
                const int pos = 32 * kt + 8 * ((2 * g + h) & 3) + 4 * (g >> 1);
                *(u32x2*)(gGy + r * 128 + cs_swz(r, pos)) = o; } }
        { f32x16 Wm = MF32(at0, ab0, zero); Wm = MF32(at1, ab1, Wm);
#pragma unroll
          for (int i = 0; i < 16; ++i) Wm[i] = Akr[i] - Wm[i];
          const bf16x8 w0 = CS_PACK(Wm, 0), w1 = CS_PACK(Wm, 1);
#pragma unroll
          for (int vt = 0; vt < 2; ++vt) { f32x16 Yl = MF32(w0, CS_XFRAG(CS_XV, vt, 0), zero); Yl = MF32(w1, CS_XFRAG(CS_XV, vt, 1), Yl);
#pragma unroll
              for (int g = 0; g < 4; ++g) { u32x2 o; o.x = pkbf(Yl[4 * g], Yl[4 * g + 1]); o.y = pkbf(Yl[4 * g + 2], Yl[4 * g + 3]);
                  *(u32x2*)(gYl + (32 * vt + r) * 64 + (8 * g + 4 * h) * 2) = o; } } }
#pragma unroll
        for (int k2t = 0; k2t < 2; ++k2t) { const float el = *(const LAS float*)(wb + CS_ELC + 4 * (32 * k2t + r)); const bf16x8 b0 = CS_XFRAG(CS_XB, k2t, 0), b1 = CS_XFRAG(CS_XB, k2t, 1);
#pragma unroll
            for (int k1t = 0; k1t < 2; ++k1t) { f32x16 Mm = MF32(qa[k1t][0], b0, zero); Mm = MF32(qa[k1t][1], b1, Mm);
#pragma unroll
                for (int g = 0; g < 4; ++g) { float o4[4];
#pragma unroll
                    for (int j = 0; j < 4; ++j) { const int k1 = 32 * k1t + 8 * g + 4 * h + j; o4[j] = ((k1 == 32 * k2t + r ? 1.0f : 0.0f) - Mm[4 * g + j]) * el; }
                    u32x2 o; o.x = pkbf(o4[0], o4[1]); o.y = pkbf(o4[2], o4[3]);
                    const int k2 = 32 * k2t + r, pos = 32 * k1t + 8 * ((2 * g + h) & 3) + 4 * (g >> 1);
                    *(u32x2*)(gMs + k2 * 128 + cs_swz(k2, pos)) = o; } } }
#pragma unroll
        for (int kt = 0; kt < 2; ++kt) { f32x16 Zm = MF32(at0, CS_XFRAG(CS_XB, kt, 0), zero); Zm = MF32(at1, CS_XFRAG(CS_XB, kt, 1), Zm);
#pragma unroll
            for (int g = 0; g < 4; ++g) { const u32x2 kv = *(const LAS u32x2*)(wb + CS_XK + cs_rho(32 * kt + r) * CS_XP + (8 * g + 4 * h) * 2);
                Zm[4 * g] = bflo(kv.x) - Zm[4 * g]; Zm[4 * g + 1] = bfhi(kv.x) - Zm[4 * g + 1]; Zm[4 * g + 2] = bflo(kv.y) - Zm[4 * g + 2]; Zm[4 * g + 3] = bfhi(kv.y) - Zm[4 * g + 3]; }
            const bf16x8 z0 = CS_PACK(Zm, 0), z1 = CS_PACK(Zm, 1);
#pragma unroll
            for (int vt = 0; vt < 2; ++vt) { f32x16 Nm = MF32(z0, CS_XFRAG(CS_XV, vt, 0), zero); Nm = MF32(z1, CS_XFRAG(CS_XV, vt, 1), Nm);
#pragma unroll
                for (int g = 0; g < 4; ++g) { const int k0 = 32 * kt + 8 * g + 4 * h; const f32x4 e4 = *(const LAS f32x4*)(wb + CS_ELC + 4 * k0);
                    u32x2 o; o.x = pkbf(Nm[4 * g] * e4[0], Nm[4 * g + 1] * e4[1]); o.y = pkbf(Nm[4 * g + 2] * e4[2], Nm[4 * g + 3] * e4[3]);
                    const int v = 32 * vt + r;
                    *(u32x2*)(gNs + v * 128 + cs_swz(v, k0)) = o; } } }
    }
#undef CS_TFRAG
#undef CS_XFRAG
}

constexpr int CQ_SLOT = 24576, CQ_R = 5, CQ_D = 4;
static_assert(CQ_R * CQ_SLOT <= LDS_MISC, "scan_seq LDS");
__device__ __forceinline__ void scan_seq(KArgs a, int seq, LAS unsigned char* lds, int wave, int lane) {
    unsigned char* ws = a->ws;
    const int dir = seq >> 5, bb = (seq >> 4) & 1, hd = seq & 15;
    if (wave >= 4) {
        const int lw = wave - 4;
        const unsigned char* pbase[6]; unsigned pstride[6];
#pragma unroll
        for (int i = 0; i < 6; ++i) { const int p = lw * 6 + i; const int arr = p < 8 ? 0 : (p < 16 ? 1 : (p < 20 ? 2 : 3)); const int po = p - (arr == 0 ? 0 : (arr == 1 ? 8 : (arr == 2 ? 16 : 20)));
            const size_t wsoff = arr == 0 ? WS_CMS : (arr == 1 ? WS_CNS : (arr == 2 ? WS_CGY : WS_CYL)); pstride[i] = arr < 2 ? 8192u : 4096u;
            pbase[i] = ws + wsoff + (size_t)seq * CS_NCH * pstride[i] + po * 1024 + lane * 16; }
#define CQ_ISSUE(cc) do { const int c_ = (cc) < CS_NCH ? (cc) : CS_NCH - 1; LAS unsigned char* sl_ = lds + ((cc) % CQ_R) * CQ_SLOT + lw * 6144; \
        _Pragma("unroll") for (int i_ = 0; i_ < 6; ++i_) __builtin_amdgcn_global_load_lds((const unsigned*)(pbase[i_] + (size_t)c_ * pstride[i_]), (LAS unsigned*)(sl_ + i_ * 1024), 16, 0, 0); } while (0)
        CQ_ISSUE(0); CQ_ISSUE(1); CQ_ISSUE(2); CQ_ISSUE(3);
        asm volatile("s_waitcnt vmcnt(18)" ::: "memory"); __builtin_amdgcn_s_barrier();
#pragma nounroll
        for (int c = 0; c < CS_NCH; ++c) { CQ_ISSUE(c + CQ_D); asm volatile("s_waitcnt vmcnt(18)" ::: "memory"); __builtin_amdgcn_s_barrier(); }
        asm volatile("s_waitcnt vmcnt(0)" ::: "memory");
#undef CQ_ISSUE
    } else {
        const int c16 = lane & 15, q = lane >> 4, v = 16 * wave + c16;
        bf16_t* Y = (bf16_t*)(ws + (dir ? WS_YB : WS_YF));
        f32x4 st[4];
#pragma unroll
        for (int I = 0; I < 4; ++I) st[I] = (f32x4){0.f, 0.f, 0.f, 0.f};
        __builtin_amdgcn_s_barrier();
#pragma nounroll
        for (int c = 0; c < CS_NCH; ++c) {
            const LAS unsigned char* sb = lds + (c % CQ_R) * CQ_SLOT;
            bf16x8 bfr[2];
#pragma unroll
            for (int s = 0; s < 2; ++s) bfr[s] = __builtin_bit_cast(bf16x8, (u32x4){pkbf(st[2 * s][0], st[2 * s][1]), pkbf(st[2 * s][2], st[2 * s][3]), pkbf(st[2 * s + 1][0], st[2 * s + 1][1]), pkbf(st[2 * s + 1][2], st[2 * s + 1][3])});
#pragma unroll
            for (int J = 0; J < 2; ++J) { const u32x2 yi = *(const LAS u32x2*)(sb + 20480 + v * 64 + (2 * J + (q >> 1)) * 16 + (q & 1) * 8);
                f32x4 acc = (f32x4){bflo(yi.x), bfhi(yi.x), bflo(yi.y), bfhi(yi.y)};
#pragma unroll
                for (int s = 0; s < 2; ++s) { const int row = 16 * J + c16; const bf16x8 af = *(const LAS bf16x8*)(sb + 16384 + row * 128 + (((4 * s + q) ^ (row & 7)) << 4));
                    acc = __builtin_amdgcn_mfma_f32_16x16x32_bf16(af, bfr[s], acc, 0, 0, 0); }
#pragma unroll
                for (int j = 0; j < 4; ++j) { const int tk = c * CS_C + 16 * J + 4 * q + j; const int tok = dir ? (SEQ - 1 - tk) : tk;
                    Y[(size_t)(bb * SEQ + tok) * RW + hd * 64 + v] = (bf16_t)(pkbf(acc[j], 0.f) & 0xffffu); } }
#pragma unroll
            for (int I = 0; I < 4; ++I) { const u32x2 ni = *(const LAS u32x2*)(sb + 8192 + v * 128 + (((2 * I + (q >> 1)) ^ (v & 7)) << 4) + (q & 1) * 8);
                f32x4 acc = (f32x4){bflo(ni.x), bfhi(ni.x), bflo(ni.y), bfhi(ni.y)};
#pragma unroll
                for (int s = 0; s < 2; ++s) { const int row = 16 * I + c16; const bf16x8 af = *(const LAS bf16x8*)(sb + row * 128 + (((4 * s + q) ^ (row & 7)) << 4));
                    acc = __builtin_amdgcn_mfma_f32_16x16x32_bf16(af, bfr[s], acc, 0, 0, 0); }
                st[I] = acc; }
            __builtin_amdgcn_s_barrier();
        }
    }
}

__device__ __forceinline__ void phase_post(KArgs a, int l, int gw, int NGW, int lane) {
    unsigned char* ws = a->ws;
    const bf16_t* YF = (const bf16_t*)(ws + WS_YF); const bf16_t* YB = (const bf16_t*)(ws + WS_YB);
    const float* A0 = (const float*)(ws + WS_A2); const float* A1 = A0 + (size_t)M * RW;
    const bf16_t* Rb = (const bf16_t*)(ws + WS_R); const bf16_t* Kb = (const bf16_t*)(ws + WS_K); const bf16_t* Vb = (const bf16_t*)(ws + WS_V); const bf16_t* Gb = (const bf16_t*)(ws + WS_G);
    bf16_t* YS = (bf16_t*)(ws + WS_YS);
    const float* k_a = a->in[I_KA] + (size_t)l * RW; const float* r_k = a->in[I_RK] + (size_t)l * RW; const float* gng = a->in[I_GNG] + (size_t)l * RW; const float* gnb = a->in[I_GNB] + (size_t)l * RW;
    for (int m = gw; m < M; m += NGW) {
#pragma unroll
        for (int j = 0; j < 2; ++j) {
            const int c = 8 * (lane + 64 * j); const size_t o = (size_t)m * RW + c;
            float y[8], rr[8], kk[8], vv[8], gg[8], a0[8], a1[8];
            { float yf[8], yb2[8]; unpack8(*(const u32x4*)(YF + o), yf); unpack8(*(const u32x4*)(YB + o), yb2);
#pragma unroll
              for (int e = 0; e < 8; ++e) y[e] = yf[e] + yb2[e]; }
            { const f32x4 p0 = *(const f32x4*)(A0 + o), p1 = *(const f32x4*)(A0 + o + 4), q0 = *(const f32x4*)(A1 + o), q1 = *(const f32x4*)(A1 + o + 4);
#pragma unroll
              for (int e = 0; e < 4; ++e) { a0[e] = p0[e]; a0[4 + e] = p1[e]; a1[e] = q0[e]; a1[4 + e] = q1[e]; } }
            unpack8(*(const u32x4*)(Rb + o), rr); unpack8(*(const u32x4*)(Kb + o), kk); unpack8(*(const u32x4*)(Vb + o), vv); unpack8(*(const u32x4*)(Gb + o), gg);
            float s = 0.f;
#pragma unroll
            for (int e = 0; e < 8; ++e) s += y[e];
            const float mean = sum8(s) * (1.f / 64.f); float q = 0.f;
#pragma unroll
            for (int e = 0; e < 8; ++e) { y[e] -= mean; q += y[e] * y[e]; }
            const float rstd = rsqrtf(sum8(q) * (1.f / 64.f) + GN_EPS);
            float bs = 0.f;
#pragma unroll
            for (int e = 0; e < 8; ++e) { const float kb = kk[e] * (1.0f + (0.5f * (a0[e] + a1[e]) - 1.0f) * k_a[c + e]); bs += rr[e] * kb * r_k[c + e]; }
            bs = sum8(bs);
            float ov[8];
#pragma unroll
            for (int e = 0; e < 8; ++e) ov[e] = (y[e] * rstd * gng[c + e] + gnb[c + e] + bs * vv[e]) * gg[e];
            *(u32x4*)(YS + (size_t)m * 3072 + c) = pack8(ov);
        }
    }
}

__global__ void __launch_bounds__(512, 2) mk_fwd(Args args) {
    extern __shared__ __attribute__((aligned(16))) unsigned char lds_raw[];
    LAS unsigned char* lds = (LAS unsigned char*)lds_raw;
    volatile LAS unsigned* MISC = (volatile LAS unsigned*)(lds + LDS_MISC);
    for (int u = threadIdx.x; u < 64; u += 512) MISC[u] = 0u;
    __syncthreads();
    const int lo = args.ph_lo, hi = args.ph_hi;
    XcdBarrier bar = xcd_barrier_post((unsigned*)(args.ws + WS_CTL) + CW_BAR, MISC + 8);
#define PH_LOCALS() int tid = threadIdx.x; asm volatile("" : "+v"(tid)); int bid = blockIdx.x; asm volatile("" : "+s"(bid)); int G = gridDim.x; asm volatile("" : "+s"(G)); \
    const int lane = tid & 63, wave = __builtin_amdgcn_readfirstlane(tid >> 6), gw = bid * 8 + wave, NGW = G * 8; \
    unsigned char* ws = kargs()->ws; (void)lane; (void)gw; (void)ws; (void)NGW
#define IN(k) (lo <= (k) && (k) < hi)
#define SEAM(k) do { if ((k) + 1 < hi) xcd_barrier(bar); } while (0)
    using namespace pg8;
#define XB ((bf16_t*)(ws + WS_XB))
#define X ((float*)(ws + WS_X))
#define H ((bf16_t*)(ws + WS_H))
#define P ((bf16_t*)(ws + WS_P))

    for (int l = 0; l < DEPTH; ++l) {
        const int pb = l * NPH;
        if (PH_EN(0) && IN(pb + 0)) { PH_LOCALS(); for (int rep = 0; rep < (DUP_PHASE == 0 ? 2 : 1); ++rep) phase_cvt(kargs(), l, gw, NGW, lane); SEAM(pb + 0); }
        if (PH_EN(1) && IN(pb + 1)) { PH_LOCALS();
            for (int rep = 0; rep < (DUP_PHASE == 1 ? 2 : 1); ++rep)
            { Gemm g{XB, (const bf16_t*)(ws + WS_WGU1), M, 2 * FF, DM, DM, DM}; StaticOrder S; S.init(M, 2 * FF, G, bid); EpiSwiglu E{H, FF};
              gemm_phase<EpiSwiglu, StaticOrder, true, true>(lds, g, S, E); }
            { Gemm g{(const bf16_t*)(ws + WS_MEMN), (const bf16_t*)(ws + WS_WKV), BATCH * NMEM, 1024, DM, DM, DM}; StaticOrder S; S.init(BATCH * NMEM, 1024, G, bid); EpiBf16 E{(bf16_t*)(ws + WS_KMEM), 1024};
              gemm_phase<EpiBf16, StaticOrder, true, true>(lds, g, S, E); }
            { Gemm g{(const bf16_t*)(ws + WS_WKV) + (size_t)1024 * DM, (const bf16_t*)(ws + WS_MEMN), 1024, BATCH * NMEM, DM, DM, DM}; StaticOrder S; S.init(1024, BATCH * NMEM, G, bid); EpiBf16 E{(bf16_t*)(ws + WS_VT), BATCH * NMEM};
              gemm_phase<EpiBf16, StaticOrder, true, true>(lds, g, S, E); }
            SEAM(pb + 1);
        }
        if (PH_EN(2) && IN(pb + 2)) { PH_LOCALS();
            Gemm g{H, (const bf16_t*)(ws + WS_WD1), M, DM, FF, FF, FF}; StaticOrder S; S.init(M, DM, G, bid); EpiRes E{l == 0 ? kargs()->in[I_X] : X, X, DM, ALPHA, 0.5f};
            gemm_phase<EpiRes, StaticOrder, false, true>(lds, g, S, E);
            SEAM(pb + 2);
        }
        if (PH_EN(3) && IN(pb + 3)) { PH_LOCALS(); phase_ln(X, X, XB, kargs()->in[I_LN1G] + (size_t)l * DM, kargs()->in[I_LN1B] + (size_t)l * DM, gw, NGW, lane); SEAM(pb + 3); }
        if (PH_EN(4) && IN(pb + 4)) { PH_LOCALS();
            Gemm g{XB, (const bf16_t*)(ws + WS_WIN), M, DINP, DM, DM, DM}; StaticOrder S; S.init(M, DINP, G, bid); EpiBf16 E{P, DINP};
            gemm_phase<EpiBf16, StaticOrder, true, true>(lds, g, S, E);
            SEAM(pb + 4);
        }
        if (PH_EN(5) && IN(pb + 5)) { PH_LOCALS(); phase_elt(kargs(), l, gw, NGW, lane); SEAM(pb + 5); }
        if (PH_EN(6) && IN(pb + 6)) { PH_LOCALS();
            { Gemm g{(const bf16_t*)(ws + WS_ACAT), (const bf16_t*)(ws + WS_WLR), M, 2048, LRK, LRK, LRK}; StaticOrder S; S.init(M, 2048, G, bid);
              EpiLR<0> E{(float*)(ws + WS_W2), nullptr, kargs()->in[I_W0] + (size_t)l * 2 * RW}; gemm_phase<EpiLR<0>, StaticOrder, false, true>(lds, g, S, E); }
            { Gemm g{(const bf16_t*)(ws + WS_ACAT), (const bf16_t*)(ws + WS_WLR) + (size_t)2048 * LRK, M, 2048, LRK, LRK, LRK}; StaticOrder S; S.init(M, 2048, G, bid);
              EpiLR<1> E{(float*)(ws + WS_A2), nullptr, kargs()->in[I_A0] + (size_t)l * 2 * RW}; gemm_phase<EpiLR<1>, StaticOrder, false, true>(lds, g, S, E); }
            { Gemm g{(const bf16_t*)(ws + WS_ACAT), (const bf16_t*)(ws + WS_WLR) + (size_t)4096 * LRK, M, 1024, LRK, LRK, LRK}; StaticOrder S; S.init(M, 1024, G, bid);
              EpiLR<2> E{nullptr, (bf16_t*)(ws + WS_G), nullptr}; gemm_phase<EpiLR<2>, StaticOrder, false, true>(lds, g, S, E); }
            for (int u = bid; u < 256; u += G) xattn_unit(kargs(), u, lds, tid, wave, lane);
            SEAM(pb + 6);
        }
        if (PH_EN(7) && IN(pb + 7)) { PH_LOCALS();
#if SCAN_SEQ
            for (int u = bid; u < 256; u += G) phase_scan(kargs(), l, u, lds, tid, wave, lane);
#else
            scan_pre(kargs(), l, bid, G, lds, wave, lane);
#endif
            SEAM(pb + 7); }
        if (PH_EN(8) && IN(pb + 8)) { PH_LOCALS();
#if !SCAN_SEQ
            const int nseq_wg = G < 64 ? G : 64;
            if (bid < nseq_wg) for (int sq = bid; sq < 64; sq += nseq_wg) scan_seq(kargs(), sq, lds, wave, lane);
#endif
            SEAM(pb + 8); }
        if (PH_EN(9) && IN(pb + 9)) { PH_LOCALS(); phase_post(kargs(), l, gw, NGW, lane); phase_cvt2(kargs(), l, gw, NGW, lane); SEAM(pb + 9); }
        if (PH_EN(10) && IN(pb + 10)) { PH_LOCALS();
            const bf16_t* YS = (const bf16_t*)(ws + WS_YS); const bf16_t* WBR = (const bf16_t*)(ws + WS_WBR); const float* gb = kargs()->in[I_GATEB] + (size_t)l * 3 * DM;
            float* MIXF = (float*)(ws + WS_MIXF); bf16_t* MIXB = (bf16_t*)(ws + WS_MIXB);
            { Gemm g{YS, WBR, M, DM, RW, 3072, RW}; StaticOrder S; S.init(M, DM, G, bid); EpiGate<0> E{P, gb, MIXF, MIXB}; gemm_phase<EpiGate<0>, StaticOrder, false, true>(lds, g, S, E); }
            { Gemm g{YS + 1024, WBR + (size_t)DM * RW, M, DM, RW, 3072, RW}; StaticOrder S; S.init(M, DM, G, bid); EpiGate<1> E{P, gb, MIXF, MIXB}; gemm_phase<EpiGate<1>, StaticOrder, false, true>(lds, g, S, E); }
            { Gemm g{YS + 2048, WBR + (size_t)2 * DM * RW, M, DM, RW, 3072, RW}; StaticOrder S; S.init(M, DM, G, bid); EpiGate<2> E{P, gb, MIXF, MIXB}; gemm_phase<EpiGate<2>, StaticOrder, false, true>(lds, g, S, E); }
            SEAM(pb + 10);
        }
        if (PH_EN(11) && IN(pb + 11)) { PH_LOCALS();
            Gemm g{(const bf16_t*)(ws + WS_MIXB), (const bf16_t*)(ws + WS_WOUT), M, DM, DM, DM, DM}; StaticOrder S; S.init(M, DM, G, bid); EpiRes E{X, X, DM, ALPHA, 1.0f};
            gemm_phase<EpiRes, StaticOrder, false, true>(lds, g, S, E);
            SEAM(pb + 11);
        }
        if (PH_EN(12) && IN(pb + 12)) { PH_LOCALS(); phase_ln(X, X, XB, kargs()->in[I_LN2G] + (size_t)l * DM, kargs()->in[I_LN2B] + (size_t)l * DM, gw, NGW, lane); SEAM(pb + 12); }
        if (PH_EN(13) && IN(pb + 13)) { PH_LOCALS();
            Gemm g{XB, (const bf16_t*)(ws + WS_WGU2), M, 2 * FF, DM, DM, DM}; StaticOrder S; S.init(M, 2 * FF, G, bid); EpiSwiglu E{H, FF};
            gemm_phase<EpiSwiglu, StaticOrder, true, true>(lds, g, S, E);
            SEAM(pb + 13);
        }
        if (PH_EN(14) && IN(pb + 14)) { PH_LOCALS();
            Gemm g{H, (const bf16_t*)(ws + WS_WD2), M, DM, FF, FF, FF}; StaticOrder S; S.init(M, DM, G, bid); EpiRes E{X, X, DM, ALPHA, 0.5f};
            gemm_phase<EpiRes, StaticOrder, false, true>(lds, g, S, E);
            SEAM(pb + 14);
        }
        if (PH_EN(15) && IN(pb + 15)) { PH_LOCALS(); phase_ln(X, l == DEPTH - 1 ? kargs()->out : X, l == DEPTH - 1 ? (bf16_t*)nullptr : XB, kargs()->in[I_LN3G] + (size_t)l * DM, kargs()->in[I_LN3B] + (size_t)l * DM, gw, NGW, lane); SEAM(pb + 15); }
    }
#undef IN
#undef SEAM
#undef XB
#undef X
#undef H
#undef P
#undef PH_LOCALS
}

extern "C" void kernel_launch(void* const* d_in, const int* in_sizes, int n_in, void* d_out, int out_size, void* d_ws, size_t ws_size, hipStream_t stream) {
    static int grid = 0;
    if (grid == 0) {
        if (n_in != N_IN || out_size != M * DM || ws_size < WS_END) { fprintf(stderr, "kernel_launch: unexpected problem (n_in %d, out %d, ws %zu < %zu)\n", n_in, out_size, ws_size, (size_t)WS_END); grid = -1; return; }
        int dev = 0, cus = 0, per_cu = 0;
        if (hipGetDevice(&dev) != hipSuccess || hipDeviceGetAttribute(&cus, hipDeviceAttributeMultiprocessorCount, dev) != hipSuccess) { grid = -1; return; }
        if (hipFuncSetAttribute((const void*)mk_fwd, hipFuncAttributeMaxDynamicSharedMemorySize, LDS_BYTES) != hipSuccess) { fprintf(stderr, "kernel_launch: hipFuncSetAttribute failed\n"); grid = -1; return; }
        if (hipOccupancyMaxActiveBlocksPerMultiprocessor(&per_cu, (const void*)mk_fwd, 512, LDS_BYTES) != hipSuccess || per_cu < 1) fprintf(stderr, "kernel_launch: occupancy query says %d\n", per_cu);
        (void)hipGetLastError();
        grid = cus;
    }
    if (grid < 0) return;
    (void)hipMemsetAsync((char*)d_ws + WS_CTL, 0, CTL_BYTES, stream);
    Args a{};
    for (int i = 0; i < N_IN; ++i) a.in[i] = (const float*)d_in[i];
    a.out = (float*)d_out; a.ws = (unsigned char*)d_ws;
#if MK_ONE_LAUNCH
    a.ph_lo = 0; a.ph_hi = DEPTH * NPH;
    hipLaunchKernelGGL(mk_fwd, dim3(grid), dim3(512), LDS_BYTES, stream, a);
#else
    for (int p = 0; p < DEPTH * NPH; ++p) { a.ph_lo = p; a.ph_hi = p + 1; hipLaunchKernelGGL(mk_fwd, dim3(grid), dim3(512), LDS_BYTES, stream, a); }
#endif
}
```

```cpp
#include <hip/hip_runtime.h>
#include <cstdio>

#ifndef PHMASK
#define PHMASK 0xffff
#endif
#define PH_EN(k) (((PHMASK) >> (k)) & 1)
#ifndef SCAN_SEQ
#define SCAN_SEQ 0
#endif
#ifndef DUP_PHASE
#define DUP_PHASE -1
#endif
#ifndef MK_ONE_LAUNCH
#define MK_ONE_LAUNCH 1
#endif

#define LAS __attribute__((address_space(3)))
#define GAS __attribute__((address_space(1)))
typedef unsigned short bf16_t;
typedef short bf16x8 __attribute__((ext_vector_type(8)));
typedef float f32x4 __attribute__((ext_vector_type(4)));
typedef float f32x2 __attribute__((ext_vector_type(2)));
typedef unsigned u32x4 __attribute__((ext_vector_type(4)));
typedef unsigned u32x2 __attribute__((ext_vector_type(2)));

constexpr int DM = 2048, BATCH = 2, SEQ = 4096, M = BATCH * SEQ, DEPTH = 2, NMEM = 256, FF = 5504;
constexpr int RW = 1024, DIN = 13696, DINP = 13824;
constexpr int PC_R = 0, PC_K = 1024, PC_V = 2048, PC_LR = 3072, PC_CB = 3456, PC_CC = 4480, PC_CH = 5504, PC_Q = 6528, PC_G = 7552;
constexpr int LRK = 384, LRN = 5120;
constexpr float ALPHA = 1.41421356237309515f;
constexpr float LN_EPS = 1e-5f, GN_EPS = 64e-5f, DECAY_SCALE = 0.606531f;
constexpr int NPH = 16;

enum { I_X = 0, I_MEM, I_F1G, I_F1U, I_F1D, I_LN1G, I_LN1B, I_WIN, I_MU, I_W0, I_WUP, I_A0, I_AUP, I_GUP, I_KK, I_KA, I_RK, I_GNG, I_GNB, I_CONVW,
       I_MLNG, I_MLNB, I_WKV, I_WBR, I_GATEB, I_WOUT, I_LN2G, I_LN2B, I_F2G, I_F2U, I_F2D, I_LN3G, I_LN3B, N_IN };

constexpr size_t MiB = 1u << 20;
constexpr size_t WS_CTL = 0, CTL_BYTES = 1 * MiB;
constexpr size_t WS_WGU1 = 1 * MiB;
constexpr size_t WS_WD1 = WS_WGU1 + 43 * MiB;
constexpr size_t WS_WGU2 = WS_WD1 + 22 * MiB;
constexpr size_t WS_WD2 = WS_WGU2 + 43 * MiB;
constexpr size_t WS_WIN = WS_WD2 + 22 * MiB;
constexpr size_t WS_WKV = WS_WIN + 54 * MiB;
constexpr size_t WS_WBR = WS_WKV + 8 * MiB;
constexpr size_t WS_WOUT = WS_WBR + 12 * MiB;
constexpr size_t WS_WLR = WS_WOUT + 8 * MiB;
constexpr size_t WS_X = WS_WLR + 4 * MiB;
constexpr size_t WS_XB = WS_X + 64 * MiB;
constexpr size_t WS_H = WS_XB + 32 * MiB;
constexpr size_t WS_P = WS_H + 86 * MiB;
constexpr size_t WS_W2 = WS_P + 216 * MiB;
constexpr size_t WS_A2 = WS_W2 + 64 * MiB;
constexpr size_t WS_R = WS_A2 + 64 * MiB;
constexpr size_t WS_K = WS_R + 16 * MiB;
constexpr size_t WS_V = WS_K + 16 * MiB;
constexpr size_t WS_KK = WS_V + 16 * MiB;
constexpr size_t WS_G = WS_KK + 16 * MiB;
constexpr size_t WS_ACAT = WS_G + 16 * MiB;
constexpr size_t WS_YS = WS_ACAT + 6 * MiB;
constexpr size_t WS_MEMN = WS_YS + 48 * MiB;
constexpr size_t WS_KMEM = WS_MEMN + 2 * MiB;
constexpr size_t WS_VT = WS_KMEM + 1 * MiB;
constexpr size_t WS_END = WS_VT + 1 * MiB;
constexpr size_t WS_YF = WS_H, WS_YB = WS_H + 16 * MiB, WS_MIXF = WS_H, WS_MIXB = WS_XB;
constexpr size_t WS_CMS = WS_WGU1;
constexpr size_t WS_CNS = WS_WGU2;
constexpr size_t WS_CGY = WS_XB;
constexpr size_t WS_CYL = WS_H + 32 * MiB;
constexpr int CW_BAR = 4096;

constexpr int LDS_MISC = 150 * 1024;
constexpr int LDS_BYTES = 163840;

__device__ __forceinline__ unsigned cvt_pk_bf16(float lo, float hi) { unsigned r; asm volatile("v_cvt_pk_bf16_f32 %0, %1, %2" : "=v"(r) : "v"(lo), "v"(hi)); return r; }
__device__ __forceinline__ float bflo(unsigned w) { return __uint_as_float(w << 16); }
__device__ __forceinline__ float bfhi(unsigned w) { return __uint_as_float(w & 0xffff0000u); }
__device__ __forceinline__ void unpack8(const u32x4 w, float (&f)[8]) { f[0] = bflo(w.x); f[1] = bfhi(w.x); f[2] = bflo(w.y); f[3] = bfhi(w.y); f[4] = bflo(w.z); f[5] = bfhi(w.z); f[6] = bflo(w.w); f[7] = bfhi(w.w); }
__device__ __forceinline__ u32x4 pack8(const float (&f)[8]) { u32x4 w; w.x = cvt_pk_bf16(f[0], f[1]); w.y = cvt_pk_bf16(f[2], f[3]); w.z = cvt_pk_bf16(f[4], f[5]); w.w = cvt_pk_bf16(f[6], f[7]); return w; }
__device__ __forceinline__ float sigmoidf_(float x) { return __builtin_amdgcn_rcpf(1.0f + __expf(-x)); }
__device__ __forceinline__ float wave_sum(float v) {
#pragma unroll
    for (int o = 1; o < 64; o <<= 1) v += __shfl_xor(v, o);
    return v;
}
__device__ __forceinline__ float sum8(float v) { v += __shfl_xor(v, 1); v += __shfl_xor(v, 2); v += __shfl_xor(v, 4); return v; }

namespace pg8 {
constexpr int BM = 256, BK = 64, HALF = 128, HTB = HALF * BK * 2, STAGE_BYTES = 8 * HTB, NXCD = 8, WGM = 8;
__host__ __device__ __forceinline__ int lds_byte(int r, int c) { const int st = (r >> 4) * 2 + (c >> 5), rr = r & 15, cc = c & 31, ob = rr * 64 + cc * 2; return st * 1024 + (ob ^ (((ob >> 9) & 1) << 5)); }
__host__ __device__ __forceinline__ void stage_rc(int b, int& R, int& C) { const int st = b / 1024, sb = b % 1024, swz = sb ^ (((sb >> 9) & 1) << 5); R = (st >> 1) * 16 + swz / 64; C = (st & 1) * 32 + (swz % 64) / 2; }
__host__ __device__ __forceinline__ int perm32(int rho) { const int n = rho >> 4, i = rho & 15; return 8 * (i >> 2) + 4 * n + (i & 3); }
struct Unit { int pm, pn; };
struct Gemm { const bf16_t* A; const bf16_t* Bt; int M, N, K, lda, ldb; };
struct StaticOrder {
    int nM, nN, nwg, G, c;
    __host__ __device__ void init(int M_, int N_, int G_, int c_) { nM = M_ / BM; nN = N_ / BM; nwg = nM * nN; G = G_; c = c_; }
    __host__ __device__ bool next(int i, Unit& u) const {
        const long L = (long)i * G + c; if (L >= nwg) return false;
        int wgid = (int)L; { const int q = nwg / NXCD, r = nwg % NXCD, xcd = wgid % NXCD, off = wgid / NXCD; wgid = (xcd < r ? xcd * (q + 1) : r * (q + 1) + (xcd - r) * q) + off; }
        const int nig = WGM * nN, gid = wgid / nig, fm = gid * WGM, gsz = (nM - fm) < WGM ? (nM - fm) : WGM;
        u.pm = fm + ((wgid % nig) % gsz); u.pn = (wgid % nig) / gsz; return true;
    }
    __device__ __forceinline__ void a_ready(const Unit&) const {}
    __device__ __forceinline__ void done(const Unit&) const {}
};
template <class Epi, class Sched, bool ALIGN_EPI = false, bool SP2 = false>
__device__ __forceinline__ void gemm_phase(LAS unsigned char* lds, const Gemm g, const Sched& S, const Epi& E) {
    int tid_ = threadIdx.x; asm volatile("" : "+v"(tid_));
    const int tid = tid_, wid = __builtin_amdgcn_readfirstlane(tid >> 6), lane = tid & 63, wr = wid >> 2, wc = wid & 3, fr = lane & 15, fq = lane >> 4;
    const int K = g.K, nt = K / BK;
    unsigned voffA[2], voffB[2];
#pragma unroll
    for (int i = 0; i < 2; ++i) { int R, C; stage_rc(tid * 16 + i * 8192, R, C); const int Rb = Epi::PERM ? ((R & ~31) + perm32(R & 31)) : R;
        voffA[i] = (unsigned)(R * g.lda + C) * 2u; voffB[i] = (unsigned)(Rb * g.ldb + C) * 2u; }
    const size_t kstep = (size_t)(BK * 2);
    const size_t hsA = (size_t)HALF * g.lda * 2, hsB = (size_t)HALF * g.ldb * 2;
    const size_t tsA = 2 * hsA, tsB = 2 * hsB;
    const unsigned ldsw = (unsigned)wid * 1024u;
    const int aoff = lds_byte(wr * 64 + fr, fq * 8), boff = lds_byte(wc * 32 + fr, fq * 8);
#define PG8_SA(b, h) (((b) * 2 + (h)) * HTB)
#define PG8_SB(b, h) ((4 + (b) * 2 + (h)) * HTB)
#define PG8_STAGE(bufoff, gbase, voff) do { _Pragma("unroll") for (int _i = 0; _i < 2; ++_i) \
        __builtin_amdgcn_global_load_lds((const unsigned*)((const char*)(gbase) + (voff)[_i]), (LAS unsigned*)(lds + (bufoff) + ldsw + _i * 8192), 16, 0, 0); } while (0)
#define PG8_LDA(dst, b, h) do { _Pragma("unroll") for (int m = 0; m < 4; ++m) _Pragma("unroll") for (int k = 0; k < 2; ++k) dst[m][k] = *(const LAS bf16x8*)(lds + PG8_SA(b, h) + aoff + m * 2048 + k * 1024); } while (0)
#define PG8_LDB(dst, b, h) do { _Pragma("unroll") for (int n = 0; n < 2; ++n) _Pragma("unroll") for (int k = 0; k < 2; ++k) dst[n][k] = *(const LAS bf16x8*)(lds + PG8_SB(b, h) + boff + n * 2048 + k * 1024); } while (0)
#define PG8_MMA(ai, bj, At, Bt) do { __builtin_amdgcn_s_setprio(1); _Pragma("unroll") for (int m = 0; m < 4; ++m) _Pragma("unroll") for (int n = 0; n < 2; ++n) _Pragma("unroll") for (int k = 0; k < 2; ++k) \
        acc[ai][bj][m][n] = __builtin_amdgcn_mfma_f32_16x16x32_bf16(Bt[n][k], At[m][k], acc[ai][bj][m][n], 0, 0, 0); __builtin_amdgcn_s_setprio(0); } while (0)
#define PG8_WAIT_V(n) asm volatile("s_waitcnt vmcnt(" #n ")" ::: "memory")
#define PG8_WAIT_L(n) asm volatile("s_waitcnt lgkmcnt(" #n ")" ::: "memory")
#define PG8_BAR __builtin_amdgcn_s_barrier()
#define PG8_SCHED __builtin_amdgcn_sched_barrier(0)
    Unit cur, nxt; int ui = 0;
    if (!S.next(0, cur)) return;
    f32x4 acc[2][2][4][2];
#pragma unroll
    for (int a = 0; a < 2; ++a)
#pragma unroll
        for (int b = 0; b < 2; ++b)
#pragma unroll
            for (int m = 0; m < 4; ++m)
#pragma unroll
                for (int n = 0; n < 2; ++n) acc[a][b][m][n] = (f32x4){0.f, 0.f, 0.f, 0.f};
    bf16x8 At[4][2], B0[2][2], B1[2][2];
    const char* cA = (const char*)g.A + (size_t)cur.pm * tsA; const char* cB = (const char*)g.Bt + (size_t)cur.pn * tsB;
    S.a_ready(cur);
    if constexpr (SP2) {
        PG8_STAGE(PG8_SB(0, 0), cB, voffB); PG8_STAGE(PG8_SB(0, 1), cB + hsB, voffB); PG8_STAGE(PG8_SA(0, 0), cA, voffA); PG8_STAGE(PG8_SA(0, 1), cA + hsA, voffA);
        if (wr == 1) PG8_BAR;
        PG8_WAIT_V(2); PG8_BAR;
        PG8_STAGE(PG8_SB(1, 0), cB + kstep, voffB); PG8_STAGE(PG8_SA(1, 0), cA + kstep, voffA); PG8_STAGE(PG8_SB(1, 1), cB + hsB + kstep, voffB);
        PG8_WAIT_V(6); PG8_BAR;
    } else {
        PG8_STAGE(PG8_SB(0, 0), cB, voffB); PG8_STAGE(PG8_SA(0, 0), cA, voffA); PG8_STAGE(PG8_SB(0, 1), cB + hsB, voffB); PG8_STAGE(PG8_SA(0, 1), cA + hsA, voffA);
        if (wr == 1) PG8_BAR;
        PG8_WAIT_V(4); PG8_BAR;
        PG8_STAGE(PG8_SB(1, 0), cB + kstep, voffB); PG8_STAGE(PG8_SA(1, 0), cA + kstep, voffA); PG8_STAGE(PG8_SB(1, 1), cB + hsB + kstep, voffB);
        PG8_WAIT_V(6); PG8_BAR;
    }
    for (;;) {
        const bool has_next = S.next(ui + 1, nxt);
        const char* nA = has_next ? (const char*)g.A + (size_t)nxt.pm * tsA : cA; const char* nB = has_next ? (const char*)g.Bt + (size_t)nxt.pn * tsB : cB;
#pragma nounroll
        for (int t = 0; t < nt; t += 2) {
            const bool last = (t == nt - 2);
            const char* a1 = cA + (size_t)(t + 1) * kstep;
            const char* a2 = last ? nA : cA + (size_t)(t + 2) * kstep; const char* b2 = last ? nB : cB + (size_t)(t + 2) * kstep;
            const char* a3 = a2 + kstep; const char* b3 = b2 + kstep;
            if (last && has_next) S.a_ready(nxt);
            if constexpr (SP2) {
            PG8_LDB(B0, 0, 0); PG8_LDB(B1, 0, 1); PG8_SCHED; PG8_LDA(At, 0, 0); PG8_STAGE(PG8_SA(1, 1), a1 + hsA, voffA);
            PG8_WAIT_V(8); PG8_WAIT_L(0); PG8_BAR; PG8_MMA(0, 0, At, B0); PG8_MMA(0, 1, At, B1); PG8_BAR; PG8_SCHED;
            PG8_LDA(At, 0, 1); PG8_STAGE(PG8_SB(0, 0), b2, voffB); PG8_STAGE(PG8_SB(0, 1), b2 + hsB, voffB); PG8_STAGE(PG8_SA(0, 0), a2, voffA);
            PG8_WAIT_V(8); PG8_WAIT_L(0); PG8_BAR; PG8_MMA(1, 0, At, B0); PG8_MMA(1, 1, At, B1); PG8_BAR; PG8_SCHED;
            PG8_LDB(B0, 1, 0); PG8_LDB(B1, 1, 1); PG8_SCHED; PG8_LDA(At, 1, 0); PG8_STAGE(PG8_SA(0, 1), a2 + hsA, voffA);
            PG8_WAIT_V(8); PG8_WAIT_L(0); PG8_BAR; PG8_MMA(0, 0, At, B0); PG8_MMA(0, 1, At, B1); PG8_BAR; PG8_SCHED;
            PG8_LDA(At, 1, 1); PG8_STAGE(PG8_SB(1, 0), b3, voffB); PG8_STAGE(PG8_SB(1, 1), b3 + hsB, voffB); PG8_STAGE(PG8_SA(1, 0), a3, voffA);
            PG8_WAIT_V(8); PG8_WAIT_L(0); PG8_BAR; PG8_MMA(1, 0, At, B0); PG8_MMA(1, 1, At, B1); PG8_BAR; PG8_SCHED;
            } else {
            PG8_LDB(B0, 0, 0); PG8_SCHED; PG8_LDA(At, 0, 0); PG8_STAGE(PG8_SA(1, 1), a1 + hsA, voffA);
            PG8_WAIT_L(8); PG8_BAR; PG8_WAIT_L(0); PG8_MMA(0, 0, At, B0); PG8_BAR; PG8_SCHED;
            PG8_LDB(B1, 0, 1); PG8_STAGE(PG8_SB(0, 0), b2, voffB);
            PG8_BAR; PG8_WAIT_L(0); PG8_MMA(0, 1, At, B1); PG8_BAR;
            PG8_LDA(At, 0, 1); PG8_STAGE(PG8_SA(0, 0), a2, voffA);
            PG8_BAR; PG8_WAIT_L(0); PG8_MMA(1, 0, At, B0); PG8_BAR; PG8_SCHED;
            PG8_STAGE(PG8_SB(0, 1), b2 + hsB, voffB);
            PG8_WAIT_V(6); PG8_BAR; PG8_MMA(1, 1, At, B1); PG8_BAR;
            PG8_LDB(B0, 1, 0); PG8_SCHED; PG8_LDA(At, 1, 0); PG8_STAGE(PG8_SA(0, 1), a2 + hsA, voffA);
            PG8_WAIT_L(8); PG8_BAR; PG8_WAIT_L(0); PG8_MMA(0, 0, At, B0); PG8_BAR; PG8_SCHED;
            PG8_LDB(B1, 1, 1); PG8_STAGE(PG8_SB(1, 0), b3, voffB);
            PG8_BAR; PG8_WAIT_L(0); PG8_MMA(0, 1, At, B1); PG8_BAR;
            PG8_LDA(At, 1, 1); PG8_STAGE(PG8_SA(1, 0), a3, voffA);
            PG8_BAR; PG8_WAIT_L(0); PG8_MMA(1, 0, At, B0); PG8_BAR; PG8_SCHED;
            PG8_STAGE(PG8_SB(1, 1), b3 + hsB, voffB);
            PG8_WAIT_V(6); PG8_BAR; PG8_MMA(1, 1, At, B1); PG8_BAR;
            }
        }
        if constexpr (ALIGN_EPI) { if (wr == 0) PG8_BAR; }
        E(acc, cur, wr, wc, fr, fq); S.done(cur);
        if (!has_next) break;
#pragma unroll
        for (int a = 0; a < 2; ++a)
#pragma unroll
            for (int b = 0; b < 2; ++b)
#pragma unroll
                for (int m = 0; m < 4; ++m)
#pragma unroll
                    for (int n = 0; n < 2; ++n) acc[a][b][m][n] = (f32x4){0.f, 0.f, 0.f, 0.f};
        cur = nxt; cA = nA; cB = nB; ++ui;
        if constexpr (ALIGN_EPI) { if (wr == 1) PG8_BAR; }
    }
    PG8_WAIT_V(0);
    if constexpr (!ALIGN_EPI) { if (wr == 0) PG8_BAR; }
    PG8_BAR;
#undef PG8_SA
#undef PG8_SB
#undef PG8_STAGE
#undef PG8_LDA
#undef PG8_LDB
#undef PG8_MMA
#undef PG8_WAIT_V
#undef PG8_WAIT_L
#undef PG8_BAR
#undef PG8_SCHED
}

struct EpiBf16 {
    static constexpr bool PERM = true;
    bf16_t* O; int ldc;
    __device__ __forceinline__ void operator()(const f32x4 (&acc)[2][2][4][2], const Unit& u, int wr, int wc, int fr, int fq) const {
        const int row0 = u.pm * BM + wr * 64 + fr, col0 = u.pn * BM + wc * 32 + 8 * fq;
#pragma unroll
        for (int ai = 0; ai < 2; ++ai)
#pragma unroll
            for (int m = 0; m < 4; ++m) { bf16_t* rowp = O + (size_t)(row0 + ai * HALF + m * 16) * ldc + col0;
#pragma unroll
                for (int bj = 0; bj < 2; ++bj) { const f32x4 v0 = acc[ai][bj][m][0], v1 = acc[ai][bj][m][1];
                    u32x4 w; w.x = cvt_pk_bf16(v0[0], v0[1]); w.y = cvt_pk_bf16(v0[2], v0[3]); w.z = cvt_pk_bf16(v1[0], v1[1]); w.w = cvt_pk_bf16(v1[2], v1[3]);
                    *(u32x4*)(rowp + bj * HALF) = w; } }
    }
};
struct EpiSwiglu {
    static constexpr bool PERM = true;
    bf16_t* H; int ldh;
    __device__ __forceinline__ void operator()(const f32x4 (&acc)[2][2][4][2], const Unit& u, int wr, int wc, int fr, int fq) const {
        const int row0 = u.pm * BM + wr * 64 + fr, col0 = u.pn * HALF + wc * 32 + 8 * fq;
#pragma unroll
        for (int ai = 0; ai < 2; ++ai)
#pragma unroll
            for (int m = 0; m < 4; ++m) { bf16_t* rowp = H + (size_t)(row0 + ai * HALF + m * 16) * ldh + col0;
                float h[8];
#pragma unroll
                for (int n = 0; n < 2; ++n)
#pragma unroll
                    for (int j = 0; j < 4; ++j) { const float gt = acc[ai][0][m][n][j], up = acc[ai][1][m][n][j]; h[n * 4 + j] = gt * __builtin_amdgcn_rcpf(1.0f + __expf(-gt)) * up; }
                *(u32x4*)rowp = pack8(h); }
    }
};
struct EpiRes {
    static constexpr bool PERM = false;
    const float* base; float* out; int ldc; float alpha, beta;
    __device__ __forceinline__ void operator()(const f32x4 (&acc)[2][2][4][2], const Unit& u, int wr, int wc, int fr, int fq) const {
        const int row0 = u.pm * BM + wr * 64 + fr, col0 = u.pn * BM + wc * 32 + 4 * fq;
#pragma unroll
        for (int ai = 0; ai < 2; ++ai)
#pragma unroll
            for (int m = 0; m < 4; ++m) { const size_t off = (size_t)(row0 + ai * HALF + m * 16) * ldc + col0;
#pragma unroll
                for (int bj = 0; bj < 2; ++bj)
#pragma unroll
                    for (int n = 0; n < 2; ++n) { const f32x4 b = *(const f32x4*)(base + off + bj * HALF + n * 16); *(f32x4*)(out + off + bj * HALF + n * 16) = b * alpha + acc[ai][bj][m][n] * beta; } }
    }
};
template <int KIND> struct EpiLR {
    static constexpr bool PERM = false;
    float* O32; bf16_t* G; const float* bias;
    __device__ __forceinline__ void operator()(const f32x4 (&acc)[2][2][4][2], const Unit& u, int wr, int wc, int fr, int fq) const {
        const int row0 = u.pm * BM + wr * 64 + fr, col0 = u.pn * BM + wc * 32 + 4 * fq;
#pragma unroll
        for (int bj = 0; bj < 2; ++bj)
#pragma unroll
            for (int n = 0; n < 2; ++n) { const int col = col0 + bj * HALF + n * 16;
                if (KIND < 2) { const f32x4 bb = *(const f32x4*)(bias + col); float* dst = O32 + (size_t)(col >> 10) * M * RW + (col & 1023);
#pragma unroll
                    for (int ai = 0; ai < 2; ++ai)
#pragma unroll
                        for (int m = 0; m < 4; ++m) { f32x4 o;
#pragma unroll
                            for (int j = 0; j < 4; ++j) { const float sg = sigmoidf_(acc[ai][bj][m][n][j] + bb[j]); o[j] = KIND == 0 ? -DECAY_SCALE * sg : sg; }
                            *(f32x4*)(dst + (size_t)(row0 + ai * HALF + m * 16) * RW) = o; }
                } else { bf16_t* dst = G + col;
#pragma unroll
                    for (int ai = 0; ai < 2; ++ai)
#pragma unroll
                        for (int m = 0; m < 4; ++m) { const f32x4 v = acc[ai][bj][m][n]; u32x2 w; w.x = cvt_pk_bf16(v[0], v[1]); w.y = cvt_pk_bf16(v[2], v[3]);
                            *(u32x2*)(dst + (size_t)(row0 + ai * HALF + m * 16) * RW) = w; }
                } }
    }
};
template <int BR> struct EpiGate {
    static constexpr bool PERM = false;
    const bf16_t* P; const float* gb; float* MIXF; bf16_t* MIXB;
    __device__ __forceinline__ void operator()(const f32x4 (&acc)[2][2][4][2], const Unit& u, int wr, int wc, int fr, int fq) const {
        const int row0 = u.pm * BM + wr * 64 + fr, col0 = u.pn * BM + wc * 32 + 4 * fq;
#pragma unroll
        for (int bj = 0; bj < 2; ++bj)
#pragma unroll
            for (int n = 0; n < 2; ++n) { const int col = col0 + bj * HALF + n * 16; const f32x4 bb = *(const f32x4*)(gb + BR * DM + col);
#pragma unroll
                for (int ai = 0; ai < 2; ++ai)
#pragma unroll
                    for (int m = 0; m < 4; ++m) { const int row = row0 + ai * HALF + m * 16;
                        const u32x2 gl = *(const u32x2*)(P + (size_t)row * DINP + PC_G + BR * DM + col);
                        f32x4 v;
                        v[0] = sigmoidf_(bflo(gl.x) + bb[0]) * acc[ai][bj][m][n][0]; v[1] = sigmoidf_(bfhi(gl.x) + bb[1]) * acc[ai][bj][m][n][1];
                        v[2] = sigmoidf_(bflo(gl.y) + bb[2]) * acc[ai][bj][m][n][2]; v[3] = sigmoidf_(bfhi(gl.y) + bb[3]) * acc[ai][bj][m][n][3];
                        float* mp = MIXF + (size_t)row * DM + col;
                        if (BR == 0) *(f32x4*)mp = v;
                        else if (BR == 1) *(f32x4*)mp = *(const f32x4*)mp + v;
                        else { const f32x4 t = *(const f32x4*)mp + v; u32x2 w; w.x = cvt_pk_bf16(t[0], t[1]); w.y = cvt_pk_bf16(t[2], t[3]); *(u32x2*)(MIXB + (size_t)row * DM + col) = w; } } }
    }
};
}

#define XB_TMO      128
#define XB_XCNT(j)  (256  + 64 * (j))
#define XB_XSUB(j)  (1280 + 64 * (j))
#define XB_XGEN(j)  (2304 + 64 * (j))
#define XB_TOP      3328
#define XB_TOPGEN   3392
#define XCD_BAR_WORDS 3456
#define XB_SPIN_CAP (1u << 18)
__device__ __forceinline__ unsigned xb_ld(unsigned* p)              { return __hip_atomic_load(p, __ATOMIC_RELAXED, __HIP_MEMORY_SCOPE_AGENT); }
__device__ __forceinline__ unsigned xb_add(unsigned* p, unsigned v) { return __hip_atomic_fetch_add(p, v, __ATOMIC_RELAXED, __HIP_MEMORY_SCOPE_AGENT); }
__device__ __forceinline__ unsigned xb_xcc_id() { return (unsigned)__builtin_amdgcn_s_getreg((3 << 11) | 20) & 0xFu; }
#define XB_SPIN(cond, bar) do { unsigned _sp = 0; while (cond) { __builtin_amdgcn_s_sleep(1); \
    if ((++_sp & 255u) == 0u) { if (xb_ld(&(bar)[XB_TMO])) break; if (_sp > XB_SPIN_CAP) { atomicAdd(&(bar)[XB_TMO], 1u); break; } } } } while (0)
struct XcdBarrier { unsigned* bar; unsigned x; volatile LAS unsigned* st; };
__device__ __forceinline__ XcdBarrier xcd_barrier_post(unsigned* bar, volatile LAS unsigned* st) {
    XcdBarrier b; b.bar = bar; b.x = xb_xcc_id(); b.st = st;
    if (threadIdx.x == 0) (void)xb_add(&bar[XB_XCNT(b.x)], 1u);
    return b;
}
__device__ __forceinline__ void xcd_barrier_complete(unsigned* bar, unsigned x, unsigned& nloc, unsigned& nx) {
    const unsigned G = gridDim.x * gridDim.y * gridDim.z;
    unsigned sum, cnt, mine, sp = 0u;
    for (;;) {
        sum = 0u; cnt = 0u; mine = 0u;
#pragma unroll
        for (unsigned j = 0; j < 16; ++j) { const unsigned c = xb_ld(&bar[XB_XCNT(j)]); sum += c; cnt += (c > 0u) ? 1u : 0u; mine = (j == x) ? c : mine; }
        if (sum == G) break;
        __builtin_amdgcn_s_sleep(1);
        if ((++sp & 255u) == 0u) { if (xb_ld(&bar[XB_TMO])) break; if (sp > XB_SPIN_CAP) { atomicAdd(&bar[XB_TMO], 1u); break; } }
    }
    nloc = mine > 0u ? mine : 1u; nx = cnt > 0u ? cnt : 1u;
}
__device__ __forceinline__ void xcd_barrier(const XcdBarrier& b) {
    asm volatile("s_waitcnt vmcnt(0)" ::: "memory");
    __syncthreads();
    if (threadIdx.x == 0) {
        unsigned* bar = b.bar;
        __builtin_amdgcn_s_waitcnt(0);
        unsigned nloc = b.st[0], nx = b.st[1];
        if (nloc == 0u) { xcd_barrier_complete(bar, b.x, nloc, nx); b.st[0] = nloc; b.st[1] = nx; }
        const unsigned old = xb_add(&bar[XB_XSUB(b.x)], 1u);
        const unsigned gen = old / nloc;
        if (old + 1u == (gen + 1u) * nloc) {
            __builtin_amdgcn_fence(__ATOMIC_RELEASE, "agent");
            asm volatile("s_waitcnt vmcnt(0)" ::: "memory");
            const unsigned og = xb_add(&bar[XB_TOP], 1u);
            const unsigned tg = og / nx;
            if (og + 1u == (tg + 1u) * nx) xb_add(&bar[XB_TOPGEN], 1u);
            else XB_SPIN(xb_ld(&bar[XB_TOPGEN]) == tg, bar);
            __builtin_amdgcn_fence(__ATOMIC_ACQUIRE, "agent");
            xb_add(&bar[XB_XGEN(b.x)], 1u);
            asm volatile("s_waitcnt vmcnt(0)" ::: "memory");
        } else {
            XB_SPIN(xb_ld(&bar[XB_XGEN(b.x)]) == gen, bar);
            __builtin_amdgcn_fence(__ATOMIC_ACQUIRE, "agent");
            asm volatile("s_waitcnt vmcnt(0)" ::: "memory");
        }
    }
    __syncthreads();
}

struct Args { const float* in[N_IN]; float* out; unsigned char* ws; int ph_lo, ph_hi; };
typedef const __attribute__((address_space(4))) Args* KArgs;
__device__ __forceinline__ KArgs kargs() { KArgs p = (KArgs)__builtin_amdgcn_kernarg_segment_ptr(); asm volatile("" : "+s"(p)); return p; }

template <int MODE>
__device__ __forceinline__ void cvt_tile(const float* W, int K, int N, bf16_t* WT, int item, int lane) {
    const int nblk = N / 32, kb = item / nblk, nb = item - kb * nblk, k0 = kb * 64, n0 = nb * 32;
    const int n4 = lane & 7, kg = lane >> 3;
    const float* src = W + (size_t)(k0 + kg * 8) * N + n0 + n4 * 4;
    f32x4 v[8];
#pragma unroll
    for (int kk = 0; kk < 8; ++kk) v[kk] = *(const f32x4*)(src + (size_t)kk * N);
    int drow = n0 + n4 * 4;
    if (MODE == 1) drow = (drow >> 7) * 256 + (drow & 127);
    if (MODE == 2) drow = (drow >> 7) * 256 + 128 + (drow & 127);
    bf16_t* dst = WT + (size_t)drow * K + k0 + kg * 8;
#pragma unroll
    for (int j = 0; j < 4; ++j) { u32x4 w; w.x = cvt_pk_bf16(v[0][j], v[1][j]); w.y = cvt_pk_bf16(v[2][j], v[3][j]); w.z = cvt_pk_bf16(v[4][j], v[5][j]); w.w = cvt_pk_bf16(v[6][j], v[7][j]);
        *(u32x4*)(dst + (size_t)j * K) = w; }
}

__device__ __forceinline__ void phase_cvt(KArgs a, int l, int gw, int NGW, int lane) {
    unsigned char* ws = a->ws;
    const float* f1g = a->in[I_F1G] + (size_t)l * DM * FF; const float* f1u = a->in[I_F1U] + (size_t)l * DM * FF; const float* f1d = a->in[I_F1D] + (size_t)l * FF * DM;
    const float* win = a->in[I_WIN] + (size_t)l * DM * DIN; const float* wkv = a->in[I_WKV] + (size_t)l * DM * DM; const float* wbr = a->in[I_WBR] + (size_t)l * 3 * RW * DM;
    const float* wout = a->in[I_WOUT] + (size_t)l * DM * DM;
    constexpr int T_GU = (DM / 64) * (FF / 32), T_D = (FF / 64) * (DM / 32), T_IN = (DM / 64) * (DIN / 32), T_SQ = (DM / 64) * (DM / 32), T_BR = (RW / 64) * (DM / 32);
    constexpr int NIT = 2 * T_GU + T_D + T_IN + 2 * T_SQ + 3 * T_BR;
    for (int it = gw; it < NIT; it += NGW) {
        int r = it;
        if (r < T_GU) { cvt_tile<1>(f1g, DM, FF, (bf16_t*)(ws + WS_WGU1), r, lane); continue; } r -= T_GU;
        if (r < T_GU) { cvt_tile<2>(f1u, DM, FF, (bf16_t*)(ws + WS_WGU1), r, lane); continue; } r -= T_GU;
        if (r < T_D) { cvt_tile<0>(f1d, FF, DM, (bf16_t*)(ws + WS_WD1), r, lane); continue; } r -= T_D;
        if (r < T_IN) { cvt_tile<0>(win, DM, DIN, (bf16_t*)(ws + WS_WIN), r, lane); continue; } r -= T_IN;
        if (r < T_SQ) { cvt_tile<0>(wkv, DM, DM, (bf16_t*)(ws + WS_WKV), r, lane); continue; } r -= T_SQ;
        if (r < T_BR) { cvt_tile<0>(wbr, RW, DM, (bf16_t*)(ws + WS_WBR), r, lane); continue; } r -= T_BR;
        if (r < T_BR) { cvt_tile<0>(wbr + (size_t)RW * DM, RW, DM, (bf16_t*)(ws + WS_WBR) + (size_t)DM * RW, r, lane); continue; } r -= T_BR;
        if (r < T_BR) { cvt_tile<0>(wbr + (size_t)2 * RW * DM, RW, DM, (bf16_t*)(ws + WS_WBR) + (size_t)2 * DM * RW, r, lane); continue; } r -= T_BR;
        cvt_tile<0>(wout, DM, DM, (bf16_t*)(ws + WS_WOUT), r, lane);
    }
    { u32x4* z = (u32x4*)((bf16_t*)(ws + WS_WIN) + (size_t)DIN * DM); const int nz = (DINP - DIN) * DM / 8;
      for (int i = gw * 64 + lane; i < nz; i += NGW * 64) z[i] = (u32x4){0u, 0u, 0u, 0u}; }
    { const float* wup = a->in[I_WUP] + (size_t)l * 2 * 64 * RW; const float* aup = a->in[I_AUP] + (size_t)l * 2 * 64 * RW; const float* gup = a->in[I_GUP] + (size_t)l * 128 * RW;
      bf16_t* wlr = (bf16_t*)(ws + WS_WLR);
      for (int i = gw * 64 + lane; i < LRN * (LRK / 8); i += NGW * 64) { const int n = i / (LRK / 8), kc = (i - n * (LRK / 8)) * 8; const int blk = n >> 10, nn = n & 1023;
          const int kb0 = blk < 4 ? 64 * blk : 256, kb1 = blk < 4 ? kb0 + 64 : 384;
          const float* src = blk < 2 ? wup + (size_t)blk * 64 * RW : (blk < 4 ? aup + (size_t)(blk - 2) * 64 * RW : gup);
          float f[8];
#pragma unroll
          for (int e = 0; e < 8; ++e) { const int k = kc + e; f[e] = (k >= kb0 && k < kb1) ? src[(size_t)(k - kb0) * RW + nn] : 0.f; }
          *(u32x4*)(wlr + (size_t)n * LRK + kc) = pack8(f); } }
    if (l == 0) { const f32x4* xs = (const f32x4*)a->in[I_X]; u32x2* xb = (u32x2*)(ws + WS_XB);
        for (size_t i = (size_t)gw * 64 + lane; i < (size_t)M * DM / 4; i += (size_t)NGW * 64) { const f32x4 v = xs[i]; u32x2 w; w.x = cvt_pk_bf16(v[0], v[1]); w.y = cvt_pk_bf16(v[2], v[3]); xb[i] = w; } }
    { const float* mg = a->in[I_MLNG] + (size_t)l * DM; const float* mb = a->in[I_MLNB] + (size_t)l * DM; bf16_t* memn = (bf16_t*)(ws + WS_MEMN);
      for (int m = gw; m < BATCH * NMEM; m += NGW) {
          const f32x4* xr = (const f32x4*)(a->in[I_MEM] + (size_t)m * DM) + lane; f32x4 v[8]; float s = 0.f;
#pragma unroll
          for (int j = 0; j < 8; ++j) { v[j] = xr[64 * j]; s += (v[j][0] + v[j][1]) + (v[j][2] + v[j][3]); }
          const float mean = wave_sum(s) * (1.f / DM); float s2 = 0.f;
#pragma unroll
          for (int j = 0; j < 8; ++j) { v[j] = v[j] - mean; s2 += (v[j][0] * v[j][0] + v[j][1] * v[j][1]) + (v[j][2] * v[j][2] + v[j][3] * v[j][3]); }
          const float rstd = rsqrtf(wave_sum(s2) * (1.f / DM) + LN_EPS);
#pragma unroll
          for (int j = 0; j < 8; ++j) { const f32x4 gg = *((const f32x4*)mg + lane + 64 * j), bb = *((const f32x4*)mb + lane + 64 * j); const f32x4 y = v[j] * rstd * gg + bb;
              u32x2 w; w.x = cvt_pk_bf16(y[0], y[1]); w.y = cvt_pk_bf16(y[2], y[3]); *((u32x2*)(memn + (size_t)m * DM) + lane + 64 * j) = w; } } }
}

__device__ __forceinline__ void phase_cvt2(KArgs a, int l, int gw, int NGW, int lane) {
    unsigned char* ws = a->ws;
    const float* f2g = a->in[I_F2G] + (size_t)l * DM * FF; const float* f2u = a->in[I_F2U] + (size_t)l * DM * FF; const float* f2d = a->in[I_F2D] + (size_t)l * FF * DM;
    constexpr int T_GU = (DM / 64) * (FF / 32), T_D = (FF / 64) * (DM / 32);
    constexpr int NIT = 2 * T_GU + T_D;
    for (int it = gw; it < NIT; it += NGW) {
        int r = it;
        if (r < T_GU) { cvt_tile<1>(f2g, DM, FF, (bf16_t*)(ws + WS_WGU2), r, lane); continue; } r -= T_GU;
        if (r < T_GU) { cvt_tile<2>(f2u, DM, FF, (bf16_t*)(ws + WS_WGU2), r, lane); continue; } r -= T_GU;
        cvt_tile<0>(f2d, FF, DM, (bf16_t*)(ws + WS_WD2), r, lane);
    }
}

__device__ __forceinline__ void phase_ln(const float* src, float* dst, bf16_t* dstb, const float* g, const float* b, int gw, int NGW, int lane) {
    for (int m = gw; m < M; m += NGW) {
        const f32x4* xr = (const f32x4*)(src + (size_t)m * DM) + lane; f32x4 v[8]; float s = 0.f;
#pragma unroll
        for (int j = 0; j < 8; ++j) { v[j] = xr[64 * j]; s += (v[j][0] + v[j][1]) + (v[j][2] + v[j][3]); }
        const float mean = wave_sum(s) * (1.f / DM); float s2 = 0.f;
#pragma unroll
        for (int j = 0; j < 8; ++j) { v[j] = v[j] - mean; s2 += (v[j][0] * v[j][0] + v[j][1] * v[j][1]) + (v[j][2] * v[j][2] + v[j][3] * v[j][3]); }
        const float rstd = rsqrtf(wave_sum(s2) * (1.f / DM) + LN_EPS);
#pragma unroll
        for (int j = 0; j < 8; ++j) { const f32x4 gg = *((const f32x4*)g + lane + 64 * j), bb = *((const f32x4*)b + lane + 64 * j); const f32x4 y = v[j] * rstd * gg + bb;
            *((f32x4*)(dst + (size_t)m * DM) + lane + 64 * j) = y;
            if (dstb) { u32x2 w; w.x = cvt_pk_bf16(y[0], y[1]); w.y = cvt_pk_bf16(y[2], y[3]); *((u32x2*)(dstb + (size_t)m * DM) + lane + 64 * j) = w; } }
    }
}

__device__ __forceinline__ void phase_elt(KArgs a, int l, int gw, int NGW, int lane) {
    unsigned char* ws = a->ws;
    const bf16_t* P = (const bf16_t*)(ws + WS_P);
    bf16_t* Rb = (bf16_t*)(ws + WS_R); bf16_t* Kb = (bf16_t*)(ws + WS_K); bf16_t* Vb = (bf16_t*)(ws + WS_V); bf16_t* KKb = (bf16_t*)(ws + WS_KK);
    bf16_t* AC = (bf16_t*)(ws + WS_ACAT); bf16_t* YS = (bf16_t*)(ws + WS_YS);
    const float* mu = a->in[I_MU] + (size_t)l * 3456; const float* k_k = a->in[I_KK] + (size_t)l * RW; const float* cw = a->in[I_CONVW] + (size_t)l * 3 * RW;
    for (int m = gw; m < M; m += NGW) {
        const int t = m & (SEQ - 1); const bool hp = t > 0, hn = t < SEQ - 1;
        const bf16_t* pc = P + (size_t)m * DINP;
#pragma unroll
        for (int j = 0; j < 7; ++j) {
            const int c0 = 8 * (lane + 64 * j);
            if (j == 6 && lane >= 48) continue;
            const u32x4 zc = (u32x4){0u, 0u, 0u, 0u};
            const u32x4 wc_ = *(const u32x4*)(pc + c0); const u32x4 wp = hp ? *(const u32x4*)(pc - DINP + c0) : zc; const u32x4 wn = hn ? *(const u32x4*)(pc + DINP + c0) : zc;
            float cu[8], pv[8], nx[8], s[8]; unpack8(wc_, cu); unpack8(wp, pv); unpack8(wn, nx);
            const f32x4 m0 = *(const f32x4*)(mu + c0), m1 = *(const f32x4*)(mu + c0 + 4);
#pragma unroll
            for (int e = 0; e < 8; ++e) { const float mm = e < 4 ? m0[e] : m1[e - 4]; s[e] = cu[e] + mm * (0.5f * (pv[e] + nx[e]) - cu[e]); }
            if (j < 2) { *(u32x4*)(Rb + (size_t)m * RW + c0) = pack8(s); }
            else if (j < 4) { const int c = c0 - 1024; *(u32x4*)(Kb + (size_t)m * RW + c) = pack8(s);
                const f32x4 k0 = *(const f32x4*)(k_k + c), k1 = *(const f32x4*)(k_k + c + 4); float kx[8]; float ss = 0.f;
#pragma unroll
                for (int e = 0; e < 8; ++e) { kx[e] = s[e] * (e < 4 ? k0[e] : k1[e - 4]); ss += kx[e] * kx[e]; }
                ss = sum8(ss); const float inv = rsqrtf(ss + 1e-12f);
#pragma unroll
                for (int e = 0; e < 8; ++e) kx[e] *= inv;
                *(u32x4*)(KKb + (size_t)m * RW + c) = pack8(kx); }
            else if (j < 6) { *(u32x4*)(Vb + (size_t)m * RW + (c0 - 2048)) = pack8(s); }
            else { const int cc = c0 - 3072; float f[8];
#pragma unroll
                for (int e = 0; e < 8; ++e) f[e] = cc < 128 ? tanhf(s[e]) : (cc < 256 ? s[e] : sigmoidf_(s[e]));
                *(u32x4*)(AC + (size_t)m * LRK + cc) = pack8(f); }
        }
#pragma unroll
        for (int j = 0; j < 2; ++j) {
            const int c = 8 * (lane + 64 * j);
            const u32x4 zc = (u32x4){0u, 0u, 0u, 0u};
            float gbv[8], gc[8], hh[8], up[8], uc[8], un[8];
            unpack8(*(const u32x4*)(pc + PC_CB + c), gbv);
            unpack8(*(const u32x4*)(pc + PC_CC + c), gc); unpack8(*(const u32x4*)(pc + PC_CH + c), hh);
#pragma unroll
            for (int e = 0; e < 8; ++e) uc[e] = gc[e] * hh[e];
            unpack8(hp ? *(const u32x4*)(pc - DINP + PC_CC + c) : zc, gc); unpack8(hp ? *(const u32x4*)(pc - DINP + PC_CH + c) : zc, hh);
#pragma unroll
            for (int e = 0; e < 8; ++e) up[e] = gc[e] * hh[e];
            unpack8(hn ? *(const u32x4*)(pc + DINP + PC_CC + c) : zc, gc); unpack8(hn ? *(const u32x4*)(pc + DINP + PC_CH + c) : zc, hh);
#pragma unroll
            for (int e = 0; e < 8; ++e) un[e] = gc[e] * hh[e];
            float o[8];
#pragma unroll
            for (int e = 0; e < 8; ++e) o[e] = gbv[e] * (cw[c + e] * up[e] + cw[RW + c + e] * uc[e] + cw[2 * RW + c + e] * un[e]);
            *(u32x4*)(YS + (size_t)m * 3072 + 1024 + c) = pack8(o);
        }
    }
}

constexpr int XA_PITCH = 528;
__device__ __forceinline__ void xattn_unit(KArgs a, int unit, LAS unsigned char* lds, int tid, int wave, int lane) {
    unsigned char* ws = a->ws;
    const bf16_t* P = (const bf16_t*)(ws + WS_P); const bf16_t* KM = (const bf16_t*)(ws + WS_KMEM); const bf16_t* VT = (const bf16_t*)(ws + WS_VT); bf16_t* YS = (bf16_t*)(ws + WS_YS);
    const int bb = unit >> 7, h = (unit >> 5) & 3, qt = unit & 31, fr = lane & 15, fq = lane >> 4;
    const int mrow = bb * SEQ + qt * 128 + wave * 16 + fr;
    bf16x8 qf[8];
#pragma unroll
    for (int ks = 0; ks < 8; ++ks) qf[ks] = *(const bf16x8*)(P + (size_t)mrow * DINP + PC_Q + h * 256 + 32 * ks + 8 * fq);
#pragma unroll 4
    for (int it = 0; it < 16; ++it) { const int idx = tid + 512 * it, key = idx >> 5, ch = idx & 31;
        const u32x4 v = *(const u32x4*)(KM + (size_t)(bb * NMEM + key) * 1024 + h * 256 + ch * 8);
        *(LAS u32x4*)(lds + key * XA_PITCH + ch * 16) = v; }
    __syncthreads();
    f32x4 sacc[16];
#pragma unroll
    for (int kb = 0; kb < 16; ++kb) { f32x4 acc = (f32x4){0.f, 0.f, 0.f, 0.f};
#pragma unroll
        for (int ks = 0; ks < 8; ++ks) { const bf16x8 kf = *(const LAS bf16x8*)(lds + (kb * 16 + fr) * XA_PITCH + (32 * ks + 8 * fq) * 2);
            acc = __builtin_amdgcn_mfma_f32_16x16x32_bf16(kf, qf[ks], acc, 0, 0, 0); }
        sacc[kb] = acc; }
    float mx = -3.0e38f;
#pragma unroll
    for (int kb = 0; kb < 16; ++kb)
#pragma unroll
        for (int i = 0; i < 4; ++i) mx = fmaxf(mx, sacc[kb][i]);
    mx = fmaxf(mx, __shfl_xor(mx, 16)); mx = fmaxf(mx, __shfl_xor(mx, 32));
    float sum = 0.f;
#pragma unroll
    for (int kb = 0; kb < 16; ++kb)
#pragma unroll
        for (int i = 0; i < 4; ++i) { const float p = __expf((sacc[kb][i] - mx) * 0.0625f); sacc[kb][i] = p; sum += p; }
    sum += __shfl_xor(sum, 16); sum += __shfl_xor(sum, 32);
    const float rs = 1.0f / sum;
    bf16x8 pf[8];
#pragma unroll
    for (int s2 = 0; s2 < 8; ++s2) { u32x4 w; w.x = cvt_pk_bf16(sacc[2 * s2][0], sacc[2 * s2][1]); w.y = cvt_pk_bf16(sacc[2 * s2][2], sacc[2 * s2][3]);
        w.z = cvt_pk_bf16(sacc[2 * s2 + 1][0], sacc[2 * s2 + 1][1]); w.w = cvt_pk_bf16(sacc[2 * s2 + 1][2], sacc[2 * s2 + 1][3]); pf[s2] = __builtin_bit_cast(bf16x8, w); }
    __syncthreads();
#pragma unroll 4
    for (int it = 0; it < 16; ++it) { const int idx = tid + 512 * it, d = idx >> 5, ch = idx & 31;
        const u32x4 v = *(const u32x4*)(VT + (size_t)(h * 256 + d) * 512 + bb * NMEM + ch * 8);
        *(LAS u32x4*)(lds + d * XA_PITCH + ch * 16) = v; }
    __syncthreads();
#pragma unroll
    for (int db = 0; db < 16; ++db) { f32x4 acc = (f32x4){0.f, 0.f, 0.f, 0.f};
#pragma unroll
        for (int s2 = 0; s2 < 8; ++s2) { const LAS unsigned char* rp = lds + (db * 16 + fr) * XA_PITCH;
            const u32x2 lo = *(const LAS u32x2*)(rp + (32 * s2 + 4 * fq) * 2), hi = *(const LAS u32x2*)(rp + (32 * s2 + 16 + 4 * fq) * 2);
            u32x4 w; w.x = lo.x; w.y = lo.y; w.z = hi.x; w.w = hi.y;
            acc = __builtin_amdgcn_mfma_f32_16x16x32_bf16(__builtin_bit_cast(bf16x8, w), pf[s2], acc, 0, 0, 0); }
        u32x2 o; o.x = cvt_pk_bf16(acc[0] * rs, acc[1] * rs); o.y = cvt_pk_bf16(acc[2] * rs, acc[3] * rs);
        *(u32x2*)(YS + (size_t)mrow * 3072 + 2048 + h * 256 + db * 16 + 4 * fq) = o; }
    __syncthreads();
}

constexpr int SC_TC = 32;
constexpr int SC_BUF = SC_TC * 5 * 64 * 4;
constexpr int SC_VOFF = SC_BUF, SC_YOFF = SC_BUF + SC_TC * 16 * 4, SC_STRIDE = SC_YOFF + SC_TC * 16 * 4;
__device__ __forceinline__ void phase_scan(KArgs a, int l, int wgid, LAS unsigned char* lds, int tid, int wave, int lane) {
    unsigned char* ws = a->ws;
    const int seq = wgid >> 2, rq = wgid & 3, dir = seq >> 5, bb = (seq >> 4) & 1, h = seq & 15;
    const float* W2 = (const float*)(ws + WS_W2) + (size_t)dir * M * RW; const float* A2 = (const float*)(ws + WS_A2) + (size_t)dir * M * RW;
    const bf16_t* KKb = (const bf16_t*)(ws + WS_KK); const bf16_t* Kb = (const bf16_t*)(ws + WS_K); const bf16_t* Rb = (const bf16_t*)(ws + WS_R); const bf16_t* Vb = (const bf16_t*)(ws + WS_V);
    bf16_t* Y = (bf16_t*)(ws + (dir ? WS_YB : WS_YF));
    const float* k_a = a->in[I_KA] + (size_t)l * RW;
    const int ss = tid >> 4, kq = tid & 15;
    const f32x4 ka4 = *(const f32x4*)(k_a + h * 64 + 4 * kq);
    f32x4 gw_, ga_; u32x2 gkk, gk, gr; unsigned short gv;
#define SC_LOAD(ci) do { const int tk = (ci) * SC_TC + ss; const int tok = dir ? (SEQ - 1 - tk) : tk; const size_t mo = (size_t)(bb * SEQ + tok) * RW + h * 64; \
        gw_ = *(const f32x4*)(W2 + mo + 4 * kq); ga_ = *(const f32x4*)(A2 + mo + 4 * kq); gkk = *(const u32x2*)(KKb + mo + 4 * kq); gk = *(const u32x2*)(Kb + mo + 4 * kq); gr = *(const u32x2*)(Rb + mo + 4 * kq); \
        gv = Vb[mo + rq * 16 + kq]; } while (0)
#define SC_STORE(buf) do { LAS unsigned char* bp = lds + (buf) * SC_STRIDE; LAS float* vp = (LAS float*)(bp + (ss * 5) * 256 + kq * 16); \
        f32x4 kk4 = (f32x4){bflo(gkk.x), bfhi(gkk.x), bflo(gkk.y), bfhi(gkk.y)}; f32x4 k4 = (f32x4){bflo(gk.x), bfhi(gk.x), bflo(gk.y), bfhi(gk.y)}; f32x4 r4 = (f32x4){bflo(gr.x), bfhi(gr.x), bflo(gr.y), bfhi(gr.y)}; \
        *(LAS f32x4*)(vp) = (f32x4){__expf(gw_[0]), __expf(gw_[1]), __expf(gw_[2]), __expf(gw_[3])}; *(LAS f32x4*)(vp + 64) = kk4; *(LAS f32x4*)(vp + 128) = kk4 * ga_; *(LAS f32x4*)(vp + 192) = k4 * (1.0f + (ga_ - 1.0f) * ka4); *(LAS f32x4*)(vp + 256) = r4; \
        ((LAS float*)(bp + SC_VOFF))[ss * 16 + kq] = __uint_as_float((unsigned)gv << 16); } while (0)
    const int rg = lane >> 4, kc = lane & 15, myrow = 4 * wave + rg;
    f32x4 S = (f32x4){0.f, 0.f, 0.f, 0.f};
#define SC_ROWSUM(x) do { x += __builtin_bit_cast(float, __builtin_amdgcn_update_dpp(0, __builtin_bit_cast(int, x), 0x128, 0xf, 0xf, false)); \
        x += __builtin_bit_cast(float, __builtin_amdgcn_update_dpp(0, __builtin_bit_cast(int, x), 0x124, 0xf, 0xf, false)); \
        x += __builtin_bit_cast(float, __builtin_amdgcn_update_dpp(0, __builtin_bit_cast(int, x), 0x122, 0xf, 0xf, false)); \
        x += __builtin_bit_cast(float, __builtin_amdgcn_update_dpp(0, __builtin_bit_cast(int, x), 0x121, 0xf, 0xf, false)); } while (0)
    SC_LOAD(0); SC_STORE(0);
    __syncthreads();
    constexpr int NCH = SEQ / SC_TC;
    for (int ci = 0; ci < NCH; ++ci) {
        const int buf = ci & 1;
        if (ci + 1 < NCH) SC_LOAD(ci + 1);
        if (wave < 4) {
            const LAS unsigned char* bp = lds + buf * SC_STRIDE;
            const LAS float* vb = (const LAS float*)(bp + SC_VOFF) + myrow; LAS float* yb = (LAS float*)(lds + buf * SC_STRIDE + SC_YOFF) + kc * 16 + myrow;
            const LAS float* vp0 = (const LAS float*)bp + 4 * kc;
            f32x4 w4 = *(const LAS f32x4*)(vp0), kk4 = *(const LAS f32x4*)(vp0 + 64), b4 = *(const LAS f32x4*)(vp0 + 128), kd4 = *(const LAS f32x4*)(vp0 + 192), r4 = *(const LAS f32x4*)(vp0 + 256);
            float vv = vb[0], ykeep = 0.f;
#pragma unroll
            for (int s = 0; s < SC_TC; ++s) {
                const LAS float* vpn = vp0 + ((s + 1) & (SC_TC - 1)) * 320;
                const f32x4 nw4 = *(const LAS f32x4*)(vpn), nkk4 = *(const LAS f32x4*)(vpn + 64), nb4 = *(const LAS f32x4*)(vpn + 128), nkd4 = *(const LAS f32x4*)(vpn + 192), nr4 = *(const LAS f32x4*)(vpn + 256);
                const float nvv = vb[((s + 1) & (SC_TC - 1)) * 16];
                f32x2 p = (f32x2){S[0], S[1]} * (f32x2){kk4[0], kk4[1]}; p = (f32x2){S[2], S[3]} * (f32x2){kk4[2], kk4[3]} + p;
                float d = p.x + p.y;
                SC_ROWSUM(d);
                S = S * w4 + (kd4 * vv - b4 * d);
                f32x2 q = (f32x2){S[0], S[1]} * (f32x2){r4[0], r4[1]}; q = (f32x2){S[2], S[3]} * (f32x2){r4[2], r4[3]} + q;
                float y = q.x + q.y;
                SC_ROWSUM(y);
                ykeep = (kc == (s & 15)) ? y : ykeep;
                if ((s & 15) == 15) yb[(s >> 4) * 256] = ykeep;
                w4 = nw4; kk4 = nkk4; b4 = nb4; kd4 = nkd4; r4 = nr4; vv = nvv;
            }
        }
        if (ci + 1 < NCH) SC_STORE(buf ^ 1);
        __syncthreads();
        { const int tk = ci * SC_TC + ss; const int tok = dir ? (SEQ - 1 - tk) : tk;
          Y[(size_t)(bb * SEQ + tok) * RW + h * 64 + rq * 16 + kq] = (bf16_t)(cvt_pk_bf16(((const LAS float*)(lds + buf * SC_STRIDE + SC_YOFF))[ss * 16 + kq], 0.f) & 0xffffu); }
    }
    __syncthreads();
#undef SC_LOAD
#undef SC_STORE
}

typedef float f32x16 __attribute__((ext_vector_type(16)));
typedef __bf16 bf16x2_t __attribute__((ext_vector_type(2)));
__device__ __forceinline__ unsigned pkbf(float a, float b) { const f32x2 v = {a, b}; return __builtin_bit_cast(unsigned, __builtin_convertvector(v, bf16x2_t)); }
#define CS_PACK(x, s) __builtin_bit_cast(bf16x8, (u32x4){pkbf((x)[8 * (s)], (x)[8 * (s) + 1]), pkbf((x)[8 * (s) + 2], (x)[8 * (s) + 3]), pkbf((x)[8 * (s) + 4], (x)[8 * (s) + 5]), pkbf((x)[8 * (s) + 6], (x)[8 * (s) + 7])})
#define MF32(a, b, c) __builtin_amdgcn_mfma_f32_32x32x16_bf16((a), (b), (c), 0, 0, 0)
constexpr int CS_C = 32, CS_NCH = SEQ / CS_C;
constexpr int CS_TP = 144, CS_XP = 72;
constexpr int CS_TQ = 0, CS_TR = 4608, CS_TB = 9216, CS_TK = 13824, CS_XQ = 18432, CS_XB = 23040, CS_XK = 27648, CS_XV = 32256, CS_ELC = 36864, CS_WAVE = 37376;
static_assert(4 * CS_WAVE <= LDS_MISC, "scan_pre LDS");
__device__ __forceinline__ int cs_rho(int k) { return (k >> 1) + 32 * (k & 1); }
__device__ __forceinline__ int cs_swz(int row, int pos) { return ((((pos >> 3) ^ (row & 7)) << 4) + ((pos >> 2) & 1) * 8); }
__device__ __forceinline__ void scan_pre(KArgs a, int l, int bid, int G, LAS unsigned char* lds, int wave, int lane) {
    if (wave >= 4) return;
    unsigned char* ws = a->ws;
    LAS unsigned char* wb = lds + wave * CS_WAVE;
    const int r = lane & 31, h = lane >> 5;
    const bf16_t* KKb = (const bf16_t*)(ws + WS_KK); const bf16_t* Kb = (const bf16_t*)(ws + WS_K); const bf16_t* Rb = (const bf16_t*)(ws + WS_R); const bf16_t* Vb = (const bf16_t*)(ws + WS_V);
    const float* k_a = a->in[I_KA] + (size_t)l * RW;
    f32x16 zero;
#pragma unroll
    for (int i = 0; i < 16; ++i) zero[i] = 0.f;
    for (int item = bid * 4 + wave; item < 64 * CS_NCH; item += G * 4) {
        const int seq = item >> 7, chunk = item & (CS_NCH - 1), dir = seq >> 5, bb = (seq >> 4) & 1, hd = seq & 15;
        const float* LW = (const float*)(ws + WS_W2) + (size_t)dir * M * RW; const float* A2 = (const float*)(ws + WS_A2) + (size_t)dir * M * RW;
        {
            const int half = h, kp = r, c0 = chunk * CS_C;
            const f32x2 ka2 = *(const f32x2*)(k_a + hd * 64 + 2 * kp);
            f32x2 lw[16], avv[16]; unsigned kkwv[16], kwv[16], rwv[16], vwv[16]; f32x2 tot = (f32x2){0.f, 0.f};
            const int tstep = dir ? -RW : RW;
            const int idx0 = (bb * SEQ + (dir ? SEQ - 1 - c0 : c0)) * RW + hd * 64 + (16 * half) * tstep + 2 * kp;
#pragma unroll
            for (int i = 0; i < 16; ++i) { const int mo = idx0 + i * tstep;
                lw[i] = *(const f32x2*)(LW + mo); avv[i] = *(const f32x2*)(A2 + mo); kkwv[i] = *(const unsigned*)(KKb + mo); kwv[i] = *(const unsigned*)(Kb + mo); rwv[i] = *(const unsigned*)(Rb + mo); vwv[i] = *(const unsigned*)(Vb + mo); }
            asm volatile("" ::: "memory");
#pragma unroll
            for (int i = 0; i < 16; ++i) tot += lw[i];
            f32x2 run; run.x = __shfl(tot.x, kp); run.y = __shfl(tot.y, kp);
            if (half == 0) run = (f32x2){0.f, 0.f};
            unsigned pq0 = 0, pq1 = 0, pb0 = 0, pb1 = 0, pk0 = 0, pk1 = 0, pv = 0;
            float oq0 = 0, oq1 = 0, ob0 = 0, ob1 = 0, ok0 = 0, ok1 = 0;
#pragma unroll
            for (int i = 0; i < 16; ++i) {
                const int tl = 16 * half + i;
                const f32x2 av = avv[i]; const unsigned kkw = kkwv[i], kw = kwv[i], rw = rwv[i], vw = vwv[i];
                const f32x2 Lm = run; run += lw[i];
                const f32x2 eL = (f32x2){__expf(run.x), __expf(run.y)}, eLm = (f32x2){__expf(Lm.x), __expf(Lm.y)}, ei = (f32x2){__expf(-run.x), __expf(-run.y)};
                const f32x2 kk2 = (f32x2){bflo(kkw), bfhi(kkw)}, k2 = (f32x2){bflo(kw), bfhi(kw)}, r2 = (f32x2){bflo(rw), bfhi(rw)};
                const f32x2 q = kk2 * eLm, rt = r2 * eL, bt = kk2 * av * ei, kt = k2 * (1.0f + (av - 1.0f) * ka2) * ei;
                *(LAS unsigned*)(wb + CS_TQ + tl * CS_TP + 4 * kp) = pkbf(q.x, q.y); *(LAS unsigned*)(wb + CS_TR + tl * CS_TP + 4 * kp) = pkbf(rt.x, rt.y);
                *(LAS unsigned*)(wb + CS_TB + tl * CS_TP + 4 * kp) = pkbf(bt.x, bt.y); *(LAS unsigned*)(wb + CS_TK + tl * CS_TP + 4 * kp) = pkbf(kt.x, kt.y);
                if ((i & 1) == 0) { oq0 = q.x; oq1 = q.y; ob0 = bt.x; ob1 = bt.y; ok0 = kt.x; ok1 = kt.y; pv = vw; }
                else {
                    pq0 = pkbf(oq0, q.x); pq1 = pkbf(oq1, q.y); pb0 = pkbf(ob0, bt.x); pb1 = pkbf(ob1, bt.y); pk0 = pkbf(ok0, kt.x); pk1 = pkbf(ok1, kt.y);
                    const int co = 2 * (tl - 1);
                    *(LAS unsigned*)(wb + CS_XQ + kp * CS_XP + co) = pq0; *(LAS unsigned*)(wb + CS_XQ + (32 + kp) * CS_XP + co) = pq1;
                    *(LAS unsigned*)(wb + CS_XB + kp * CS_XP + co) = pb0; *(LAS unsigned*)(wb + CS_XB + (32 + kp) * CS_XP + co) = pb1;
                    *(LAS unsigned*)(wb + CS_XK + kp * CS_XP + co) = pk0; *(LAS unsigned*)(wb + CS_XK + (32 + kp) * CS_XP + co) = pk1;
                    *(LAS unsigned*)(wb + CS_XV + kp * CS_XP + co) = (pv & 0xffffu) | (vw << 16); *(LAS unsigned*)(wb + CS_XV + (32 + kp) * CS_XP + co) = (pv >> 16) | (vw & 0xffff0000u);
                }
                if (i == 15 && half == 1) *(LAS f32x2*)(wb + CS_ELC + 8 * kp) = eL;
            }
        }
#define CS_TFRAG(off, ks) (*(const LAS bf16x8*)(wb + (off) + r * CS_TP + (16 * (ks) + 8 * h) * 2))
#define CS_XFRAG(off, tile, s) __builtin_bit_cast(bf16x8, (u32x4){ (*(const LAS u32x2*)(wb + (off) + cs_rho(32 * (tile) + r) * CS_XP + (16 * (s) + 4 * h) * 2)).x, (*(const LAS u32x2*)(wb + (off) + cs_rho(32 * (tile) + r) * CS_XP + (16 * (s) + 4 * h) * 2)).y, \
                                                             (*(const LAS u32x2*)(wb + (off) + cs_rho(32 * (tile) + r) * CS_XP + (16 * (s) + 8 + 4 * h) * 2)).x, (*(const LAS u32x2*)(wb + (off) + cs_rho(32 * (tile) + r) * CS_XP + (16 * (s) + 8 + 4 * h) * 2)).y })
        f32x16 Tm, TmT, AkqT, Abr, Akr;
        {
            bf16x8 fq[4], fr[4], fb[4], fk[4];
#pragma unroll
            for (int ks = 0; ks < 4; ++ks) { fq[ks] = CS_TFRAG(CS_TQ, ks); fr[ks] = CS_TFRAG(CS_TR, ks); fb[ks] = CS_TFRAG(CS_TB, ks); fk[ks] = CS_TFRAG(CS_TK, ks); }
            f32x16 Nn = zero, NnT = zero; AkqT = zero; Abr = zero; Akr = zero;
#pragma unroll
            for (int ks = 0; ks < 4; ++ks) { Nn = MF32(fb[ks], fq[ks], Nn); NnT = MF32(fq[ks], fb[ks], NnT); AkqT = MF32(fq[ks], fk[ks], AkqT); Abr = MF32(fb[ks], fr[ks], Abr); Akr = MF32(fk[ks], fr[ks], Akr); }
#pragma unroll
            for (int i = 0; i < 16; ++i) { const int row = (i & 3) + 8 * (i >> 2) + 4 * h;
                Nn[i] = row < r ? -Nn[i] : 0.f;
                NnT[i] = r < row ? -NnT[i] : 0.f;
                AkqT[i] = r < row ? AkqT[i] : 0.f;
                Abr[i] = row <= r ? Abr[i] : 0.f;
                Akr[i] = row <= r ? Akr[i] : 0.f; }
            f32x16 P = Nn, PT = NnT; Tm = Nn; TmT = NnT;
#pragma unroll
            for (int i = 0; i < 16; ++i) { const int row = (i & 3) + 8 * (i >> 2) + 4 * h; if (row == r) { Tm[i] += 1.0f; TmT[i] += 1.0f; } }
#pragma unroll
            for (int it = 0; it < 4; ++it) {
                const bf16x8 p0 = CS_PACK(P, 0), p1 = CS_PACK(P, 1), t0 = CS_PACK(PT, 0), t1 = CS_PACK(PT, 1);
                f32x16 P2 = MF32(t0, p0, zero); P2 = MF32(t1, p1, P2);
                if (it < 3) { f32x16 P2T = MF32(p0, t0, zero); P2T = MF32(p1, t1, P2T); PT = P2T; }
                P = P2;
                const bf16x8 n0 = CS_PACK(P, 0), n1 = CS_PACK(P, 1), m0 = CS_PACK(TmT, 0), m1 = CS_PACK(TmT, 1);
                f32x16 Tn = MF32(m0, n0, Tm); Tn = MF32(m1, n1, Tn);
                if (it < 3) { f32x16 TnT = MF32(n0, m0, TmT); TnT = MF32(n1, m1, TnT); TmT = TnT; }
                Tm = Tn;
            }
        }
        const size_t rec = (size_t)seq * CS_NCH + chunk;
        unsigned char* gMs = ws + WS_CMS + rec * 8192; unsigned char* gNs = ws + WS_CNS + rec * 8192; unsigned char* gGy = ws + WS_CGY + rec * 4096; unsigned char* gYl = ws + WS_CYL + rec * 4096;
        const bf16x8 tm0 = CS_PACK(Tm, 0), tm1 = CS_PACK(Tm, 1);
        f32x16 ATt = MF32(tm0, CS_PACK(AkqT, 0), zero); ATt = MF32(tm1, CS_PACK(AkqT, 1), ATt);
        const bf16x8 at0 = CS_PACK(ATt, 0), at1 = CS_PACK(ATt, 1), ab0 = CS_PACK(Abr, 0), ab1 = CS_PACK(Abr, 1);
        bf16x8 qa[2][2];
#pragma unroll
        for (int kt = 0; kt < 2; ++kt) { f32x16 Q_ = MF32(tm0, CS_XFRAG(CS_XQ, kt, 0), zero); Q_ = MF32(tm1, CS_XFRAG(CS_XQ, kt, 1), Q_); qa[kt][0] = CS_PACK(Q_, 0); qa[kt][1] = CS_PACK(Q_, 1); }
#pragma unroll
        for (int kt = 0; kt < 2; ++kt) { f32x16 Gm = MF32(qa[kt][0], ab0, zero); Gm = MF32(qa[kt][1], ab1, Gm);
#pragma unroll
            for (int g = 0; g < 4; ++g) { const int k0 = 32 * kt + 8 * g + 4 * h; const u32x2 rv = *(const LAS u32x2*)(wb + CS_TR + r * CS_TP + k0 * 2);
                u32x2 o; o.x = pkbf(bflo(rv.x) - Gm[4 * g], bfhi(rv.x) - Gm[4 * g + 1]); o.y = pkbf(bflo(rv.y) - Gm[4 * g + 2], bfhi(rv.y) - Gm[4 * g + 3]);
                const int pos = 32 * kt + 8 * ((2 * g + h) & 3) + 4 * (g >> 1);
                *(u32x2*)(gGy + r * 128 + cs_swz(r, pos)) = o; } }
        { f32x16 Wm = MF32(at0, ab0, zero); Wm = MF32(at1, ab1, Wm);
#pragma unroll
          for (int i = 0; i < 16; ++i) Wm[i] = Akr[i] - Wm[i];
          const bf16x8 w0 = CS_PACK(Wm, 0), w1 = CS_PACK(Wm, 1);
#pragma unroll
          for (int vt = 0; vt < 2; ++vt) { f32x16 Yl = MF32(w0, CS_XFRAG(CS_XV, vt, 0), zero); Yl = MF32(w1, CS_XFRAG(CS_XV, vt, 1), Yl);
#pragma unroll
              for (int g = 0; g < 4; ++g) { u32x2 o; o.x = pkbf(Yl[4 * g], Yl[4 * g + 1]); o.y = pkbf(Yl[4 * g + 2], Yl[4 * g + 3]);
                  *(u32x2*)(gYl + (32 * vt + r) * 64 + (8 * g + 4 * h) * 2) = o; } } }
#pragma unroll
        for (int k2t = 0; k2t < 2; ++k2t) { const float el = *(const LAS float*)(wb + CS_ELC + 4 * (32 * k2t + r)); const bf16x8 b0 = CS_XFRAG(CS_XB, k2t, 0), b1 = CS_XFRAG(CS_XB, k2t, 1);
#pragma unroll
            for (int k1t = 0; k1t < 2; ++k1t) { f32x16 Mm = MF32(qa[k1t][0], b0, zero); Mm = MF32(qa[k1t][1], b1, Mm);
#pragma unroll
                for (int g = 0; g < 4; ++g) { float o4[4];
#pragma unroll
                    for (int j = 0; j < 4; ++j) { const int k1 = 32 * k1t + 8 * g + 4 * h + j; o4[j] = ((k1 == 32 * k2t + r ? 1.0f : 0.0f) - Mm[4 * g + j]) * el; }
                    u32x2 o; o.x = pkbf(o4[0], o4[1]); o.y = pkbf(o4[2], o4[3]);
                    const int k2 = 32 * k2t + r, pos = 32 * k1t + 8 * ((2 * g + h) & 3) + 4 * (g >> 1);
                    *(u32x2*)(gMs + k2 * 128 + cs_swz(k2, pos)) = o; } } }
#pragma unroll
        for (int kt = 0; kt < 2; ++kt) { f32x16 Zm = MF32(at0, CS_XFRAG(CS_XB, kt, 0), zero); Zm = MF32(at1, CS_XFRAG(CS_XB, kt, 1), Zm);
#pragma unroll
            for (int g = 0; g < 4; ++g) { const u32x2 kv = *(const LAS u32x2*)(wb + CS_XK + cs_rho(32 * kt + r) * CS_XP + (8 * g + 4 * h) * 2);
                Zm[4 * g] = bflo(kv.x) - Zm[4 * g]; Zm[4 * g + 1] = bfhi(kv.x) - Zm[4 * g + 1]; Zm[4 * g + 2] = bflo(kv.y) - Zm[4 * g + 2]; Zm[4 * g + 3] = bfhi(kv.y) - Zm[4 * g + 3]; }
            const bf16x8 z0 = CS_PACK(Zm, 0), z1 = CS_PACK(Zm, 1);
#pragma unroll
            for (int vt = 0; vt < 2; ++vt) { f32x16 Nm = MF32(z0, CS_XFRAG(CS_XV, vt, 0), zero); Nm = MF32(z1, CS_XFRAG(CS_XV, vt, 1), Nm);
#pragma unroll
                for (int g = 0; g < 4; ++g) { const int k0 = 32 * kt + 8 * g + 4 * h; const f32x4 e4 = *(const LAS f32x4*)(wb + CS_ELC + 4 * k0);
                    u32x2 o; o.x = pkbf(Nm[4 * g] * e4[0], Nm[4 * g + 1] * e4[1]); o.y = pkbf(Nm[4 * g + 2] * e4[2], Nm[4 * g + 3] * e4[3]);
                    const int v = 32 * vt + r;
                    *(u32x2*)(gNs + v * 128 + cs_swz(v, k0)) = o; } } }
    }
#undef CS_TFRAG
#undef CS_XFRAG
}

constexpr int CQ_SLOT = 24576, CQ_R = 5, CQ_D = 4;
static_assert(CQ_R * CQ_SLOT <= LDS_MISC, "scan_seq LDS");
__device__ __forceinline__ void scan_seq(KArgs a, int seq, LAS unsigned char* lds, int wave, int lane) {
    unsigned char* ws = a->ws;
    const int dir = seq >> 5, bb = (seq >> 4) & 1, hd = seq & 15;
    if (wave >= 4) {
        const int lw = wave - 4;
        const unsigned char* pbase[6]; unsigned pstride[6];
#pragma unroll
        for (int i = 0; i < 6; ++i) { const int p = lw * 6 + i; const int arr = p < 8 ? 0 : (p < 16 ? 1 : (p < 20 ? 2 : 3)); const int po = p - (arr == 0 ? 0 : (arr == 1 ? 8 : (arr == 2 ? 16 : 20)));
            const size_t wsoff = arr == 0 ? WS_CMS : (arr == 1 ? WS_CNS : (arr == 2 ? WS_CGY : WS_CYL)); pstride[i] = arr < 2 ? 8192u : 4096u;
            pbase[i] = ws + wsoff + (size_t)seq * CS_NCH * pstride[i] + po * 1024 + lane * 16; }
#define CQ_ISSUE(cc) do { const int c_ = (cc) < CS_NCH ? (cc) : CS_NCH - 1; LAS unsigned char* sl_ = lds + ((cc) % CQ_R) * CQ_SLOT + lw * 6144; \
        _Pragma("unroll") for (int i_ = 0; i_ < 6; ++i_) __builtin_amdgcn_global_load_lds((const unsigned*)(pbase[i_] + (size_t)c_ * pstride[i_]), (LAS unsigned*)(sl_ + i_ * 1024), 16, 0, 0); } while (0)
        CQ_ISSUE(0); CQ_ISSUE(1); CQ_ISSUE(2); CQ_ISSUE(3);
        asm volatile("s_waitcnt vmcnt(18)" ::: "memory"); __builtin_amdgcn_s_barrier();
#pragma nounroll
        for (int c = 0; c < CS_NCH; ++c) { CQ_ISSUE(c + CQ_D); asm volatile("s_waitcnt vmcnt(18)" ::: "memory"); __builtin_amdgcn_s_barrier(); }
        asm volatile("s_waitcnt vmcnt(0)" ::: "memory");
#undef CQ_ISSUE
    } else {
        const int c16 = lane & 15, q = lane >> 4, v = 16 * wave + c16;
        bf16_t* Y = (bf16_t*)(ws + (dir ? WS_YB : WS_YF));
        f32x4 st[4];
#pragma unroll
        for (int I = 0; I < 4; ++I) st[I] = (f32x4){0.f, 0.f, 0.f, 0.f};
        __builtin_amdgcn_s_barrier();
#pragma nounroll
        for (int c = 0; c < CS_NCH; ++c) {
            const LAS unsigned char* sb = lds + (c % CQ_R) * CQ_SLOT;
            bf16x8 bfr[2];
#pragma unroll
            for (int s = 0; s < 2; ++s) bfr[s] = __builtin_bit_cast(bf16x8, (u32x4){pkbf(st[2 * s][0], st[2 * s][1]), pkbf(st[2 * s][2], st[2 * s][3]), pkbf(st[2 * s + 1][0], st[2 * s + 1][1]), pkbf(st[2 * s + 1][2], st[2 * s + 1][3])});
#pragma unroll
            for (int J = 0; J < 2; ++J) { const u32x2 yi = *(const LAS u32x2*)(sb + 20480 + v * 64 + (2 * J + (q >> 1)) * 16 + (q & 1) * 8);
                f32x4 acc = (f32x4){bflo(yi.x), bfhi(yi.x), bflo(yi.y), bfhi(yi.y)};
#pragma unroll
                for (int s = 0; s < 2; ++s) { const int row = 16 * J + c16; const bf16x8 af = *(const LAS bf16x8*)(sb + 16384 + row * 128 + (((4 * s + q) ^ (row & 7)) << 4));
                    acc = __builtin_amdgcn_mfma_f32_16x16x32_bf16(af, bfr[s], acc, 0, 0, 0); }
#pragma unroll
                for (int j = 0; j < 4; ++j) { const int tk = c * CS_C + 16 * J + 4 * q + j; const int tok = dir ? (SEQ - 1 - tk) : tk;
                    Y[(size_t)(bb * SEQ + tok) * RW + hd * 64 + v] = (bf16_t)(pkbf(acc[j], 0.f) & 0xffffu); } }
#pragma unroll
            for (int I = 0; I < 4; ++I) { const u32x2 ni = *(const LAS u32x2*)(sb + 8192 + v * 128 + (((2 * I + (q >> 1)) ^ (v & 7)) << 4) + (q & 1) * 8);
                f32x4 acc = (f32x4){bflo(ni.x), bfhi(ni.x), bflo(ni.y), bfhi(ni.y)};
#pragma unroll
                for (int s = 0; s < 2; ++s) { const int row = 16 * I + c16; const bf16x8 af = *(const LAS bf16x8*)(sb + row * 128 + (((4 * s + q) ^ (row & 7)) << 4));
                    acc = __builtin_amdgcn_mfma_f32_16x16x32_bf16(af, bfr[s], acc, 0, 0, 0); }
                st[I] = acc; }
            __builtin_amdgcn_s_barrier();
        }
    }
}

__device__ __forceinline__ void phase_post(KArgs a, int l, int gw, int NGW, int lane) {
    unsigned char* ws = a->ws;
    const bf16_t* YF = (const bf16_t*)(ws + WS_YF); const bf16_t* YB = (const bf16_t*)(ws + WS_YB);
    const float* A0 = (const float*)(ws + WS_A2); const float* A1 = A0 + (size_t)M * RW;
    const bf16_t* Rb = (const bf16_t*)(ws + WS_R); const bf16_t* Kb = (const bf16_t*)(ws + WS_K); const bf16_t* Vb = (const bf16_t*)(ws + WS_V); const bf16_t* Gb = (const bf16_t*)(ws + WS_G);
    bf16_t* YS = (bf16_t*)(ws + WS_YS);
    const float* k_a = a->in[I_KA] + (size_t)l * RW; const float* r_k = a->in[I_RK] + (size_t)l * RW; const float* gng = a->in[I_GNG] + (size_t)l * RW; const float* gnb = a->in[I_GNB] + (size_t)l * RW;
    for (int m = gw; m < M; m += NGW) {
#pragma unroll
        for (int j = 0; j < 2; ++j) {
            const int c = 8 * (lane + 64 * j); const size_t o = (size_t)m * RW + c;
            float y[8], rr[8], kk[8], vv[8], gg[8], a0[8], a1[8];
            { float yf[8], yb2[8]; unpack8(*(const u32x4*)(YF + o), yf); unpack8(*(const u32x4*)(YB + o), yb2);
#pragma unroll
              for (int e = 0; e < 8; ++e) y[e] = yf[e] + yb2[e]; }
            { const f32x4 p0 = *(const f32x4*)(A0 + o), p1 = *(const f32x4*)(A0 + o + 4), q0 = *(const f32x4*)(A1 + o), q1 = *(const f32x4*)(A1 + o + 4);
#pragma unroll
              for (int e = 0; e < 4; ++e) { a0[e] = p0[e]; a0[4 + e] = p1[e]; a1[e] = q0[e]; a1[4 + e] = q1[e]; } }
            unpack8(*(const u32x4*)(Rb + o), rr); unpack8(*(const u32x4*)(Kb + o), kk); unpack8(*(const u32x4*)(Vb + o), vv); unpack8(*(const u32x4*)(Gb + o), gg);
            float s = 0.f;
#pragma unroll
            for (int e = 0; e < 8; ++e) s += y[e];
            const float mean = sum8(s) * (1.f / 64.f); float q = 0.f;
#pragma unroll
            for (int e = 0; e < 8; ++e) { y[e] -= mean; q += y[e] * y[e]; }
            const float rstd = rsqrtf(sum8(q) * (1.f / 64.f) + GN_EPS);
            float bs = 0.f;
#pragma unroll
            for (int e = 0; e < 8; ++e) { const float kb = kk[e] * (1.0f + (0.5f * (a0[e] + a1[e]) - 1.0f) * k_a[c + e]); bs += rr[e] * kb * r_k[c + e]; }
            bs = sum8(bs);
            float ov[8];
#pragma unroll
            for (int e = 0; e < 8; ++e) ov[e] = (y[e] * rstd * gng[c + e] + gnb[c + e] + bs * vv[e]) * gg[e];
            *(u32x4*)(YS + (size_t)m * 3072 + c) = pack8(ov);
        }
    }
}

__global__ void __launch_bounds__(512, 2) mk_fwd(Args args) {
    extern __shared__ __attribute__((aligned(16))) unsigned char lds_raw[];
    LAS unsigned char* lds = (LAS unsigned char*)lds_raw;
    volatile LAS unsigned* MISC = (volatile LAS unsigned*)(lds + LDS_MISC);
    for (int u = threadIdx.x; u < 64; u += 512) MISC[u] = 0u;
    __syncthreads();
    const int lo = args.ph_lo, hi = args.ph_hi;
    XcdBarrier bar = xcd_barrier_post((unsigned*)(args.ws + WS_CTL) + CW_BAR, MISC + 8);
#define PH_LOCALS() int tid = threadIdx.x; asm volatile("" : "+v"(tid)); int bid = blockIdx.x; asm volatile("" : "+s"(bid)); int G = gridDim.x; asm volatile("" : "+s"(G)); \
    const int lane = tid & 63, wave = __builtin_amdgcn_readfirstlane(tid >> 6), gw = bid * 8 + wave, NGW = G * 8; \
    unsigned char* ws = kargs()->ws; (void)lane; (void)gw; (void)ws; (void)NGW
#define IN(k) (lo <= (k) && (k) < hi)
#define SEAM(k) do { if ((k) + 1 < hi) xcd_barrier(bar); } while (0)
    using namespace pg8;
#define XB ((bf16_t*)(ws + WS_XB))
#define X ((float*)(ws + WS_X))
#define H ((bf16_t*)(ws + WS_H))
#define P ((bf16_t*)(ws + WS_P))

    for (int l = 0; l < DEPTH; ++l) {
        const int pb = l * NPH;
        if (PH_EN(0) && IN(pb + 0)) { PH_LOCALS(); for (int rep = 0; rep < (DUP_PHASE == 0 ? 2 : 1); ++rep) phase_cvt(kargs(), l, gw, NGW, lane); SEAM(pb + 0); }
        if (PH_EN(1) && IN(pb + 1)) { PH_LOCALS();
            for (int rep = 0; rep < (DUP_PHASE == 1 ? 2 : 1); ++rep)
            { Gemm g{XB, (const bf16_t*)(ws + WS_WGU1), M, 2 * FF, DM, DM, DM}; StaticOrder S; S.init(M, 2 * FF, G, bid); EpiSwiglu E{H, FF};
              gemm_phase<EpiSwiglu, StaticOrder, true, true>(lds, g, S, E); }
            { Gemm g{(const bf16_t*)(ws + WS_MEMN), (const bf16_t*)(ws + WS_WKV), BATCH * NMEM, 1024, DM, DM, DM}; StaticOrder S; S.init(BATCH * NMEM, 1024, G, bid); EpiBf16 E{(bf16_t*)(ws + WS_KMEM), 1024};
              gemm_phase<EpiBf16, StaticOrder, true, true>(lds, g, S, E); }
            { Gemm g{(const bf16_t*)(ws + WS_WKV) + (size_t)1024 * DM, (const bf16_t*)(ws + WS_MEMN), 1024, BATCH * NMEM, DM, DM, DM}; StaticOrder S; S.init(1024, BATCH * NMEM, G, bid); EpiBf16 E{(bf16_t*)(ws + WS_VT), BATCH * NMEM};
              gemm_phase<EpiBf16, StaticOrder, true, true>(lds, g, S, E); }
            SEAM(pb + 1);
        }
        if (PH_EN(2) && IN(pb + 2)) { PH_LOCALS();
            Gemm g{H, (const bf16_t*)(ws + WS_WD1), M, DM, FF, FF, FF}; StaticOrder S; S.init(M, DM, G, bid); EpiRes E{l == 0 ? kargs()->in[I_X] : X, X, DM, ALPHA, 0.5f};
            gemm_phase<EpiRes, StaticOrder, false, true>(lds, g, S, E);
            SEAM(pb + 2);
        }
        if (PH_EN(3) && IN(pb + 3)) { PH_LOCALS(); phase_ln(X, X, XB, kargs()->in[I_LN1G] + (size_t)l * DM, kargs()->in[I_LN1B] + (size_t)l * DM, gw, NGW, lane); SEAM(pb + 3); }
        if (PH_EN(4) && IN(pb + 4)) { PH_LOCALS();
            Gemm g{XB, (const bf16_t*)(ws + WS_WIN), M, DINP, DM, DM, DM}; StaticOrder S; S.init(M, DINP, G, bid); EpiBf16 E{P, DINP};
            gemm_phase<EpiBf16, StaticOrder, true, true>(lds, g, S, E);
            SEAM(pb + 4);
        }
        if (PH_EN(5) && IN(pb + 5)) { PH_LOCALS(); phase_elt(kargs(), l, gw, NGW, lane); SEAM(pb + 5); }
        if (PH_EN(6) && IN(pb + 6)) { PH_LOCALS();
            { Gemm g{(const bf16_t*)(ws + WS_ACAT), (const bf16_t*)(ws + WS_WLR), M, 2048, LRK, LRK, LRK}; StaticOrder S; S.init(M, 2048, G, bid);
              EpiLR<0> E{(float*)(ws + WS_W2), nullptr, kargs()->in[I_W0] + (size_t)l * 2 * RW}; gemm_phase<EpiLR<0>, StaticOrder, false, true>(lds, g, S, E); }
            { Gemm g{(const bf16_t*)(ws + WS_ACAT), (const bf16_t*)(ws + WS_WLR) + (size_t)2048 * LRK, M, 2048, LRK, LRK, LRK}; StaticOrder S; S.init(M, 2048, G, bid);
              EpiLR<1> E{(float*)(ws + WS_A2), nullptr, kargs()->in[I_A0] + (size_t)l * 2 * RW}; gemm_phase<EpiLR<1>, StaticOrder, false, true>(lds, g, S, E); }
            { Gemm g{(const bf16_t*)(ws + WS_ACAT), (const bf16_t*)(ws + WS_WLR) + (size_t)4096 * LRK, M, 1024, LRK, LRK, LRK}; StaticOrder S; S.init(M, 1024, G, bid);
              EpiLR<2> E{nullptr, (bf16_t*)(ws + WS_G), nullptr}; gemm_phase<EpiLR<2>, StaticOrder, false, true>(lds, g, S, E); }
            for (int u = bid; u < 256; u += G) xattn_unit(kargs(), u, lds, tid, wave, lane);
            SEAM(pb + 6);
        }
        if (PH_EN(7) && IN(pb + 7)) { PH_LOCALS();
#if SCAN_SEQ
            for (int u = bid; u < 256; u += G) phase_scan(kargs(), l, u, lds, tid, wave, lane);
#else
            scan_pre(kargs(), l, bid, G, lds, wave, lane);
#endif
            SEAM(pb + 7); }
        if (PH_EN(8) && IN(pb + 8)) { PH_LOCALS();
#if !SCAN_SEQ
            const int nseq_wg = G < 64 ? G : 64;
            if (bid < nseq_wg) for (int sq = bid; sq < 64; sq += nseq_wg) scan_seq(kargs(), sq, lds, wave, lane);
#endif
            SEAM(pb + 8); }
        if (PH_EN(9) && IN(pb + 9)) { PH_LOCALS(); phase_post(kargs(), l, gw, NGW, lane); phase_cvt2(kargs(), l, gw, NGW, lane); SEAM(pb + 9); }
        if (PH_EN(10) && IN(pb + 10)) { PH_LOCALS();
            const bf16_t* YS = (const bf16_t*)(ws + WS_YS); const bf16_t* WBR = (const bf16_t*)(ws + WS_WBR); const float* gb = kargs()->in[I_GATEB] + (size_t)l * 3 * DM;
            float* MIXF = (float*)(ws + WS_MIXF); bf16_t* MIXB = (bf16_t*)(ws + WS_MIXB);
            { Gemm g{YS, WBR, M, DM, RW, 3072, RW}; StaticOrder S; S.init(M, DM, G, bid); EpiGate<0> E{P, gb, MIXF, MIXB}; gemm_phase<EpiGate<0>, StaticOrder, false, true>(lds, g, S, E); }
            { Gemm g{YS + 1024, WBR + (size_t)DM * RW, M, DM, RW, 3072, RW}; StaticOrder S; S.init(M, DM, G, bid); EpiGate<1> E{P, gb, MIXF, MIXB}; gemm_phase<EpiGate<1>, StaticOrder, false, true>(lds, g, S, E); }
            { Gemm g{YS + 2048, WBR + (size_t)2 * DM * RW, M, DM, RW, 3072, RW}; StaticOrder S; S.init(M, DM, G, bid); EpiGate<2> E{P, gb, MIXF, MIXB}; gemm_phase<EpiGate<2>, StaticOrder, false, true>(lds, g, S, E); }
            SEAM(pb + 10);
        }
        if (PH_EN(11) && IN(pb + 11)) { PH_LOCALS();
            Gemm g{(const bf16_t*)(ws + WS_MIXB), (const bf16_t*)(ws + WS_WOUT), M, DM, DM, DM, DM}; StaticOrder S; S.init(M, DM, G, bid); EpiRes E{X, X, DM, ALPHA, 1.0f};
            gemm_phase<EpiRes, StaticOrder, false, true>(lds, g, S, E);
            SEAM(pb + 11);
        }
        if (PH_EN(12) && IN(pb + 12)) { PH_LOCALS(); phase_ln(X, X, XB, kargs()->in[I_LN2G] + (size_t)l * DM, kargs()->in[I_LN2B] + (size_t)l * DM, gw, NGW, lane); SEAM(pb + 12); }
        if (PH_EN(13) && IN(pb + 13)) { PH_LOCALS();
            Gemm g{XB, (const bf16_t*)(ws + WS_WGU2), M, 2 * FF, DM, DM, DM}; StaticOrder S; S.init(M, 2 * FF, G, bid); EpiSwiglu E{H, FF};
            gemm_phase<EpiSwiglu, StaticOrder, true, true>(lds, g, S, E);
            SEAM(pb + 13);
        }
        if (PH_EN(14) && IN(pb + 14)) { PH_LOCALS();
            Gemm g{H, (const bf16_t*)(ws + WS_WD2), M, DM, FF, FF, FF}; StaticOrder S; S.init(M, DM, G, bid); EpiRes E{X, X, DM, ALPHA, 0.5f};
            gemm_phase<EpiRes, StaticOrder, false, true>(lds, g, S, E);
            SEAM(pb + 14);
        }
        if (PH_EN(15) && IN(pb + 15)) { PH_LOCALS(); phase_ln(X, l == DEPTH - 1 ? kargs()->out : X, l == DEPTH - 1 ? (bf16_t*)nullptr : XB, kargs()->in[I_LN3G] + (size_t)l * DM, kargs()->in[I_LN3B] + (size_t)l * DM, gw, NGW, lane); SEAM(pb + 15); }
    }
#undef IN
#undef SEAM
#undef XB
#undef X
#undef H
#undef P
#undef PH_LOCALS
}

extern "C" void kernel_launch(void* const* d_in, const int* in_sizes, int n_in, void* d_out, int out_size, void* d_ws, size_t ws_size, hipStream_t stream) {
    static int grid = 0;
    if (grid == 0) {
        if (n_in != N_IN || out_size != M * DM || ws_size < WS_END) { fprintf(stderr, "kernel_launch: unexpected problem (n_in %d, out %d, ws %zu < %zu)\n", n_in, out_size, ws_size, (size_t)WS_END); grid = -1; return; }
        int dev = 0, cus = 0, per_cu = 0;
        if (hipGetDevice(&dev) != hipSuccess || hipDeviceGetAttribute(&cus, hipDeviceAttributeMultiprocessorCount, dev) != hipSuccess) { grid = -1; return; }
        if (hipFuncSetAttribute((const void*)mk_fwd, hipFuncAttributeMaxDynamicSharedMemorySize, LDS_BYTES) != hipSuccess) { fprintf(stderr, "kernel_launch: hipFuncSetAttribute failed\n"); grid = -1; return; }
        if (hipOccupancyMaxActiveBlocksPerMultiprocessor(&per_cu, (const void*)mk_fwd, 512, LDS_BYTES) != hipSuccess || per_cu < 1) fprintf(stderr, "kernel_launch: occupancy query says %d\n", per_cu);
        (void)hipGetLastError();
        grid = cus;
    }
    if (grid < 0) return;
    (void)hipMemsetAsync((char*)d_ws + WS_CTL, 0, CTL_BYTES, stream);
    Args a{};
    for (int i = 0; i < N_IN; ++i) a.in[i] = (const float*)d_in[i];
    a.out = (float*)d_out; a.ws = (unsigned char*)d_ws;
#if MK_ONE_LAUNCH
    a.ph_lo = 0; a.ph_hi = DEPTH * NPH;
    hipLaunchKernelGGL(mk_fwd, dim3(grid), dim3(512), LDS_BYTES, stream, a);
#else
    for (int p = 0; p < DEPTH * NPH; ++p) { a.ph_lo = p; a.ph_hi = p + 1; hipLaunchKernelGGL(mk_fwd, dim3(grid), dim3(512), LDS_BYTES, stream, a); }
#endif
}
```

```cpp
#include <hip/hip_runtime.h>
#include <cstdio>

#ifndef PHMASK
#define PHMASK 0xffff
#endif
#define PH_EN(k) (((PHMASK) >> (k)) & 1)
#ifndef SCAN_SEQ
#define SCAN_SEQ 0
#endif
#ifndef DUP_PHASE
#define DUP_PHASE -1
#endif
#ifndef MK_ONE_LAUNCH
#define MK_ONE_LAUNCH 1
#endif

#define LAS __attribute__((address_space(3)))
#define GAS __attribute__((address_space(1)))
typedef unsigned short bf16_t;
typedef short bf16x8 __attribute__((ext_vector_type(8)));
typedef float f32x4 __attribute__((ext_vector_type(4)));
typedef float f32x2 __attribute__((ext_vector_type(2)));
typedef unsigned u32x4 __attribute__((ext_vector_type(4)));
typedef unsigned u32x2 __attribute__((ext_vector_type(2)));

constexpr int DM = 2048, BATCH = 2, SEQ = 4096, M = BATCH * SEQ, DEPTH = 2, NMEM = 256, FF = 5504;
constexpr int RW = 1024, DIN = 13696, DINP = 13824;
constexpr int PC_R = 0, PC_K = 1024, PC_V = 2048, PC_LR = 3072, PC_CB = 3456, PC_CC = 4480, PC_CH = 5504, PC_Q = 6528, PC_G = 7552;
constexpr int LRK = 384, LRN = 5120;
constexpr float ALPHA = 1.41421356237309515f;
constexpr float LN_EPS = 1e-5f, GN_EPS = 64e-5f, DECAY_SCALE = 0.606531f;
constexpr int NPH = 16;

enum { I_X = 0, I_MEM, I_F1G, I_F1U, I_F1D, I_LN1G, I_LN1B, I_WIN, I_MU, I_W0, I_WUP, I_A0, I_AUP, I_GUP, I_KK, I_KA, I_RK, I_GNG, I_GNB, I_CONVW,
       I_MLNG, I_MLNB, I_WKV, I_WBR, I_GATEB, I_WOUT, I_LN2G, I_LN2B, I_F2G, I_F2U, I_F2D, I_LN3G, I_LN3B, N_IN };

constexpr size_t MiB = 1u << 20;
constexpr size_t WS_CTL = 0, CTL_BYTES = 1 * MiB;
constexpr size_t WS_WGU1 = 1 * MiB;
constexpr size_t WS_WD1 = WS_WGU1 + 43 * MiB;
constexpr size_t WS_WGU2 = WS_WD1 + 22 * MiB;
constexpr size_t WS_WD2 = WS_WGU2 + 43 * MiB;
constexpr size_t WS_WIN = WS_WD2 + 22 * MiB;
constexpr size_t WS_WKV = WS_WIN + 54 * MiB;
constexpr size_t WS_WBR = WS_WKV + 8 * MiB;
constexpr size_t WS_WOUT = WS_WBR + 12 * MiB;
constexpr size_t WS_WLR = WS_WOUT + 8 * MiB;
constexpr size_t WS_X = WS_WLR + 4 * MiB;
constexpr size_t WS_XB = WS_X + 64 * MiB;
constexpr size_t WS_H = WS_XB + 32 * MiB;
constexpr size_t WS_P = WS_H + 86 * MiB;
constexpr size_t WS_W2 = WS_P + 216 * MiB;
constexpr size_t WS_A2 = WS_W2 + 64 * MiB;
constexpr size_t WS_R = WS_A2 + 64 * MiB;
constexpr size_t WS_K = WS_R + 16 * MiB;
constexpr size_t WS_V = WS_K + 16 * MiB;
constexpr size_t WS_KK = WS_V + 16 * MiB;
constexpr size_t WS_G = WS_KK + 16 * MiB;
constexpr size_t WS_ACAT = WS_G + 16 * MiB;
constexpr size_t WS_YS = WS_ACAT + 6 * MiB;
constexpr size_t WS_MEMN = WS_YS + 48 * MiB;
constexpr size_t WS_KMEM = WS_MEMN + 2 * MiB;
constexpr size_t WS_VT = WS_KMEM + 1 * MiB;
constexpr size_t WS_END = WS_VT + 1 * MiB;
constexpr size_t WS_YF = WS_H, WS_YB = WS_H + 16 * MiB, WS_MIXF = WS_H, WS_MIXB = WS_XB;
constexpr size_t WS_CMS = WS_WGU1;
constexpr size_t WS_CNS = WS_WGU2;
constexpr size_t WS_CGY = WS_XB;
constexpr size_t WS_CYL = WS_H + 32 * MiB;
constexpr int CW_BAR = 4096;

constexpr int LDS_MISC = 150 * 1024;
constexpr int LDS_BYTES = 163840;

__device__ __forceinline__ unsigned cvt_pk_bf16(float lo, float hi) { unsigned r; asm volatile("v_cvt_pk_bf16_f32 %0, %1, %2" : "=v"(r) : "v"(lo), "v"(hi)); return r; }
__device__ __forceinline__ float bflo(unsigned w) { return __uint_as_float(w << 16); }
__device__ __forceinline__ float bfhi(unsigned w) { return __uint_as_float(w & 0xffff0000u); }
__device__ __forceinline__ void unpack8(const u32x4 w, float (&f)[8]) { f[0] = bflo(w.x); f[1] = bfhi(w.x); f[2] = bflo(w.y); f[3] = bfhi(w.y); f[4] = bflo(w.z); f[5] = bfhi(w.z); f[6] = bflo(w.w); f[7] = bfhi(w.w); }
__device__ __forceinline__ u32x4 pack8(const float (&f)[8]) { u32x4 w; w.x = cvt_pk_bf16(f[0], f[1]); w.y = cvt_pk_bf16(f[2], f[3]); w.z = cvt_pk_bf16(f[4], f[5]); w.w = cvt_pk_bf16(f[6], f[7]); return w; }
__device__ __forceinline__ float sigmoidf_(float x) { return __builtin_amdgcn_rcpf(1.0f + __expf(-x)); }
__device__ __forceinline__ float wave_sum(float v) {
#pragma unroll
    for (int o = 1; o < 64; o <<= 1) v += __shfl_xor(v, o);
    return v;
}
__device__ __forceinline__ float sum8(float v) { v += __shfl_xor(v, 1); v += __shfl_xor(v, 2); v += __shfl_xor(v, 4); return v; }

namespace pg8 {
constexpr int BM = 256, BK = 64, HALF = 128, HTB = HALF * BK * 2, STAGE_BYTES = 8 * HTB, NXCD = 8, WGM = 8;
__host__ __device__ __forceinline__ int lds_byte(int r, int c) { const int st = (r >> 4) * 2 + (c >> 5), rr = r & 15, cc = c & 31, ob = rr * 64 + cc * 2; return st * 1024 + (ob ^ (((ob >> 9) & 1) << 5)); }
__host__ __device__ __forceinline__ void stage_rc(int b, int& R, int& C) { const int st = b / 1024, sb = b % 1024, swz = sb ^ (((sb >> 9) & 1) << 5); R = (st >> 1) * 16 + swz / 64; C = (st & 1) * 32 + (swz % 64) / 2; }
__host__ __device__ __forceinline__ int perm32(int rho) { const int n = rho >> 4, i = rho & 15; return 8 * (i >> 2) + 4 * n + (i & 3); }
struct Unit { int pm, pn; };
struct Gemm { const bf16_t* A; const bf16_t* Bt; int M, N, K, lda, ldb; };
struct StaticOrder {
    int nM, nN, nwg, G, c;
    __host__ __device__ void init(int M_, int N_, int G_, int c_) { nM = M_ / BM; nN = N_ / BM; nwg = nM * nN; G = G_; c = c_; }
    __host__ __device__ bool next(int i, Unit& u) const {
        const long L = (long)i * G + c; if (L >= nwg) return false;
        int wgid = (int)L; { const int q = nwg / NXCD, r = nwg % NXCD, xcd = wgid % NXCD, off = wgid / NXCD; wgid = (xcd < r ? xcd * (q + 1) : r * (q + 1) + (xcd - r) * q) + off; }
        const int nig = WGM * nN, gid = wgid / nig, fm = gid * WGM, gsz = (nM - fm) < WGM ? (nM - fm) : WGM;
        u.pm = fm + ((wgid % nig) % gsz); u.pn = (wgid % nig) / gsz; return true;
    }
    __device__ __forceinline__ void a_ready(const Unit&) const {}
    __device__ __forceinline__ void done(const Unit&) const {}
};
template <class Epi, class Sched, bool ALIGN_EPI = false, bool SP2 = false>
__device__ __forceinline__ void gemm_phase(LAS unsigned char* lds, const Gemm g, const Sched& S, const Epi& E) {
    int tid_ = threadIdx.x; asm volatile("" : "+v"(tid_));
    const int tid = tid_, wid = __builtin_amdgcn_readfirstlane(tid >> 6), lane = tid & 63, wr = wid >> 2, wc = wid & 3, fr = lane & 15, fq = lane >> 4;
    const int K = g.K, nt = K / BK;
    unsigned voffA[2], voffB[2];
#pragma unroll
    for (int i = 0; i < 2; ++i) { int R, C; stage_rc(tid * 16 + i * 8192, R, C); const int Rb = Epi::PERM ? ((R & ~31) + perm32(R & 31)) : R;
        voffA[i] = (unsigned)(R * g.lda + C) * 2u; voffB[i] = (unsigned)(Rb * g.ldb + C) * 2u; }
    const size_t kstep = (size_t)(BK * 2);
    const size_t hsA = (size_t)HALF * g.lda * 2, hsB = (size_t)HALF * g.ldb * 2;
    const size_t tsA = 2 * hsA, tsB = 2 * hsB;
    const unsigned ldsw = (unsigned)wid * 1024u;
    const int aoff = lds_byte(wr * 64 + fr, fq * 8), boff = lds_byte(wc * 32 + fr, fq * 8);
#define PG8_SA(b, h) (((b) * 2 + (h)) * HTB)
#define PG8_SB(b, h) ((4 + (b) * 2 + (h)) * HTB)
#define PG8_STAGE(bufoff, gbase, voff) do { _Pragma("unroll") for (int _i = 0; _i < 2; ++_i) \
        __builtin_amdgcn_global_load_lds((const unsigned*)((const char*)(gbase) + (voff)[_i]), (LAS unsigned*)(lds + (bufoff) + ldsw + _i * 8192), 16, 0, 0); } while (0)
#define PG8_LDA(dst, b, h) do { _Pragma("unroll") for (int m = 0; m < 4; ++m) _Pragma("unroll") for (int k = 0; k < 2; ++k) dst[m][k] = *(const LAS bf16x8*)(lds + PG8_SA(b, h) + aoff + m * 2048 + k * 1024); } while (0)
#define PG8_LDB(dst, b, h) do { _Pragma("unroll") for (int n = 0; n < 2; ++n) _Pragma("unroll") for (int k = 0; k < 2; ++k) dst[n][k] = *(const LAS bf16x8*)(lds + PG8_SB(b, h) + boff + n * 2048 + k * 1024); } while (0)
#define PG8_MMA(ai, bj, At, Bt) do { __builtin_amdgcn_s_setprio(1); _Pragma("unroll") for (int m = 0; m < 4; ++m) _Pragma("unroll") for (int n = 0; n < 2; ++n) _Pragma("unroll") for (int k = 0; k < 2; ++k) \
        acc[ai][bj][m][n] = __builtin_amdgcn_mfma_f32_16x16x32_bf16(Bt[n][k], At[m][k], acc[ai][bj][m][n], 0, 0, 0); __builtin_amdgcn_s_setprio(0); } while (0)
#define PG8_WAIT_V(n) asm volatile("s_waitcnt vmcnt(" #n ")" ::: "memory")
#define PG8_WAIT_L(n) asm volatile("s_waitcnt lgkmcnt(" #n ")" ::: "memory")
#define PG8_BAR __builtin_amdgcn_s_barrier()
#define PG8_SCHED __builtin_amdgcn_sched_barrier(0)
    Unit cur, nxt; int ui = 0;
    if (!S.next(0, cur)) return;
    f32x4 acc[2][2][4][2];
#pragma unroll
    for (int a = 0; a < 2; ++a)
#pragma unroll
        for (int b = 0; b < 2; ++b)
#pragma unroll
            for (int m = 0; m < 4; ++m)
#pragma unroll
                for (int n = 0; n < 2; ++n) acc[a][b][m][n] = (f32x4){0.f, 0.f, 0.f, 0.f};
    bf16x8 At[4][2], B0[2][2], B1[2][2];
    const char* cA = (const char*)g.A + (size_t)cur.pm * tsA; const char* cB = (const char*)g.Bt + (size_t)cur.pn * tsB;
    S.a_ready(cur);
    if constexpr (SP2) {
        PG8_STAGE(PG8_SB(0, 0), cB, voffB); PG8_STAGE(PG8_SB(0, 1), cB + hsB, voffB); PG8_STAGE(PG8_SA(0, 0), cA, voffA); PG8_STAGE(PG8_SA(0, 1), cA + hsA, voffA);
        if (wr == 1) PG8_BAR;
        PG8_WAIT_V(2); PG8_BAR;
        PG8_STAGE(PG8_SB(1, 0), cB + kstep, voffB); PG8_STAGE(PG8_SA(1, 0), cA + kstep, voffA); PG8_STAGE(PG8_SB(1, 1), cB + hsB + kstep, voffB);
        PG8_WAIT_V(6); PG8_BAR;
    } else {
        PG8_STAGE(PG8_SB(0, 0), cB, voffB); PG8_STAGE(PG8_SA(0, 0), cA, voffA); PG8_STAGE(PG8_SB(0, 1), cB + hsB, voffB); PG8_STAGE(PG8_SA(0, 1), cA + hsA, voffA);
        if (wr == 1) PG8_BAR;
        PG8_WAIT_V(4); PG8_BAR;
        PG8_STAGE(PG8_SB(1, 0), cB + kstep, voffB); PG8_STAGE(PG8_SA(1, 0), cA + kstep, voffA); PG8_STAGE(PG8_SB(1, 1), cB + hsB + kstep, voffB);
        PG8_WAIT_V(6); PG8_BAR;
    }
    for (;;) {
        const bool has_next = S.next(ui + 1, nxt);
        const char* nA = has_next ? (const char*)g.A + (size_t)nxt.pm * tsA : cA; const char* nB = has_next ? (const char*)g.Bt + (size_t)nxt.pn * tsB : cB;
#pragma nounroll
        for (int t = 0; t < nt; t += 2) {
            const bool last = (t == nt - 2);
            const char* a1 = cA + (size_t)(t + 1) * kstep;
            const char* a2 = last ? nA : cA + (size_t)(t + 2) * kstep; const char* b2 = last ? nB : cB + (size_t)(t + 2) * kstep;
            const char* a3 = a2 + kstep; const char* b3 = b2 + kstep;
            if (last && has_next) S.a_ready(nxt);
            if constexpr (SP2) {
            PG8_LDB(B0, 0, 0); PG8_LDB(B1, 0, 1); PG8_SCHED; PG8_LDA(At, 0, 0); PG8_STAGE(PG8_SA(1, 1), a1 + hsA, voffA);
            PG8_WAIT_V(8); PG8_WAIT_L(0); PG8_BAR; PG8_MMA(0, 0, At, B0); PG8_MMA(0, 1, At, B1); PG8_BAR; PG8_SCHED;
            PG8_LDA(At, 0, 1); PG8_STAGE(PG8_SB(0, 0), b2, voffB); PG8_STAGE(PG8_SB(0, 1), b2 + hsB, voffB); PG8_STAGE(PG8_SA(0, 0), a2, voffA);
            PG8_WAIT_V(8); PG8_WAIT_L(0); PG8_BAR; PG8_MMA(1, 0, At, B0); PG8_MMA(1, 1, At, B1); PG8_BAR; PG8_SCHED;
            PG8_LDB(B0, 1, 0); PG8_LDB(B1, 1, 1); PG8_SCHED; PG8_LDA(At, 1, 0); PG8_STAGE(PG8_SA(0, 1), a2 + hsA, voffA);
            PG8_WAIT_V(8); PG8_WAIT_L(0); PG8_BAR; PG8_MMA(0, 0, At, B0); PG8_MMA(0, 1, At, B1); PG8_BAR; PG8_SCHED;
            PG8_LDA(At, 1, 1); PG8_STAGE(PG8_SB(1, 0), b3, voffB); PG8_STAGE(PG8_SB(1, 1), b3 + hsB, voffB); PG8_STAGE(PG8_SA(1, 0), a3, voffA);
            PG8_WAIT_V(8); PG8_WAIT_L(0); PG8_BAR; PG8_MMA(1, 0, At, B0); PG8_MMA(1, 1, At, B1); PG8_BAR; PG8_SCHED;
            } else {
            PG8_LDB(B0, 0, 0); PG8_SCHED; PG8_LDA(At, 0, 0); PG8_STAGE(PG8_SA(1, 1), a1 + hsA, voffA);
            PG8_WAIT_L(8); PG8_BAR; PG8_WAIT_L(0); PG8_MMA(0, 0, At, B0); PG8_BAR; PG8_SCHED;
            PG8_LDB(B1, 0, 1); PG8_STAGE(PG8_SB(0, 0), b2, voffB);
            PG8_BAR; PG8_WAIT_L(0); PG8_MMA(0, 1, At, B1); PG8_BAR;
            PG8_LDA(At, 0, 1); PG8_STAGE(PG8_SA(0, 0), a2, voffA);
            PG8_BAR; PG8_WAIT_L(0); PG8_MMA(1, 0, At, B0); PG8_BAR; PG8_SCHED;
            PG8_STAGE(PG8_SB(0, 1), b2 + hsB, voffB);
            PG8_WAIT_V(6); PG8_BAR; PG8_MMA(1, 1, At, B1); PG8_BAR;
            PG8_LDB(B0, 1, 0); PG8_SCHED; PG8_LDA(At, 1, 0); PG8_STAGE(PG8_SA(0, 1), a2 + hsA, voffA);
            PG8_WAIT_L(8); PG8_BAR; PG8_WAIT_L(0); PG8_MMA(0, 0, At, B0); PG8_BAR; PG8_SCHED;
            PG8_LDB(B1, 1, 1); PG8_STAGE(PG8_SB(1, 0), b3, voffB);
            PG8_BAR; PG8_WAIT_L(0); PG8_MMA(0, 1, At, B1); PG8_BAR;
            PG8_LDA(At, 1, 1); PG8_STAGE(PG8_SA(1, 0), a3, voffA);
            PG8_BAR; PG8_WAIT_L(0); PG8_MMA(1, 0, At, B0); PG8_BAR; PG8_SCHED;
            PG8_STAGE(PG8_SB(1, 1), b3 + hsB, voffB);
            PG8_WAIT_V(6); PG8_BAR; PG8_MMA(1, 1, At, B1); PG8_BAR;
            }
        }
        if constexpr (ALIGN_EPI) { if (wr == 0) PG8_BAR; }
        E(acc, cur, wr, wc, fr, fq); S.done(cur);
        if (!has_next) break;
#pragma unroll
        for (int a = 0; a < 2; ++a)
#pragma unroll
            for (int b = 0; b < 2; ++b)
#pragma unroll
                for (int m = 0; m < 4; ++m)
#pragma unroll
                    for (int n = 0; n < 2; ++n) acc[a][b][m][n] = (f32x4){0.f, 0.f, 0.f, 0.f};
        cur = nxt; cA = nA; cB = nB; ++ui;
        if constexpr (ALIGN_EPI) { if (wr == 1) PG8_BAR; }
    }
    PG8_WAIT_V(0);
    if constexpr (!ALIGN_EPI) { if (wr == 0) PG8_BAR; }
    PG8_BAR;
#undef PG8_SA
#undef PG8_SB
#undef PG8_STAGE
#undef PG8_LDA
#undef PG8_LDB
#undef PG8_MMA
#undef PG8_WAIT_V
#undef PG8_WAIT_L
#undef PG8_BAR
#undef PG8_SCHED
}

struct EpiBf16 {
    static constexpr bool PERM = true;
    bf16_t* O; int ldc;
    __device__ __forceinline__ void operator()(const f32x4 (&acc)[2][2][4][2], const Unit& u, int wr, int wc, int fr, int fq) const {
        const int row0 = u.pm * BM + wr * 64 + fr, col0 = u.pn * BM + wc * 32 + 8 * fq;
#pragma unroll
        for (int ai = 0; ai < 2; ++ai)
#pragma unroll
            for (int m = 0; m < 4; ++m) { bf16_t* rowp = O + (size_t)(row0 + ai * HALF + m * 16) * ldc + col0;
#pragma unroll
                for (int bj = 0; bj < 2; ++bj) { const f32x4 v0 = acc[ai][bj][m][0], v1 = acc[ai][bj][m][1];
                    u32x4 w; w.x = cvt_pk_bf16(v0[0], v0[1]); w.y = cvt_pk_bf16(v0[2], v0[3]); w.z = cvt_pk_bf16(v1[0], v1[1]); w.w = cvt_pk_bf16(v1[2], v1[3]);
                    *(u32x4*)(rowp + bj * HALF) = w; } }
    }
};
struct EpiSwiglu {
    static constexpr bool PERM = true;
    bf16_t* H; int ldh;
    __device__ __forceinline__ void operator()(const f32x4 (&acc)[2][2][4][2], const Unit& u, int wr, int wc, int fr, int fq) const {
        const int row0 = u.pm * BM + wr * 64 + fr, col0 = u.pn * HALF + wc * 32 + 8 * fq;
#pragma unroll
        for (int ai = 0; ai < 2; ++ai)
#pragma unroll
            for (int m = 0; m < 4; ++m) { bf16_t* rowp = H + (size_t)(row0 + ai * HALF + m * 16) * ldh + col0;
                float h[8];
#pragma unroll
                for (int n = 0; n < 2; ++n)
#pragma unroll
                    for (int j = 0; j < 4; ++j) { const float gt = acc[ai][0][m][n][j], up = acc[ai][1][m][n][j]; h[n * 4 + j] = gt * __builtin_amdgcn_rcpf(1.0f + __expf(-gt)) * up; }
                *(u32x4*)rowp = pack8(h); }
    }
};
struct EpiRes {
    static constexpr bool PERM = false;
    const float* base; float* out; int ldc; float alpha, beta;
    __device__ __forceinline__ void operator()(const f32x4 (&acc)[2][2][4][2], const Unit& u, int wr, int wc, int fr, int fq) const {
        const int row0 = u.pm * BM + wr * 64 + fr, col0 = u.pn * BM + wc * 32 + 4 * fq;
#pragma unroll
        for (int ai = 0; ai < 2; ++ai)
#pragma unroll
            for (int m = 0; m < 4; ++m) { const size_t off = (size_t)(row0 + ai * HALF + m * 16) * ldc + col0;
#pragma unroll
                for (int bj = 0; bj < 2; ++bj)
#pragma unroll
                    for (int n = 0; n < 2; ++n) { const f32x4 b = *(const f32x4*)(base + off + bj * HALF + n * 16); *(f32x4*)(out + off + bj * HALF + n * 16) = b * alpha + acc[ai][bj][m][n] * beta; } }
    }
};
template <int KIND> struct EpiLR {
    static constexpr bool PERM = false;
    float* O32; bf16_t* G; const float* bias;
    __device__ __forceinline__ void operator()(const f32x4 (&acc)[2][2][4][2], const Unit& u, int wr, int wc, int fr, int fq) const {
        const int row0 = u.pm * BM + wr * 64 + fr, col0 = u.pn * BM + wc * 32 + 4 * fq;
#pragma unroll
        for (int bj = 0; bj < 2; ++bj)
#pragma unroll
            for (int n = 0; n < 2; ++n) { const int col = col0 + bj * HALF + n * 16;
                if (KIND < 2) { const f32x4 bb = *(const f32x4*)(bias + col); float* dst = O32 + (size_t)(col >> 10) * M * RW + (col & 1023);
#pragma unroll
                    for (int ai = 0; ai < 2; ++ai)
#pragma unroll
                        for (int m = 0; m < 4; ++m) { f32x4 o;
#pragma unroll
                            for (int j = 0; j < 4; ++j) { const float sg = sigmoidf_(acc[ai][bj][m][n][j] + bb[j]); o[j] = KIND == 0 ? -DECAY_SCALE * sg : sg; }
                            *(f32x4*)(dst + (size_t)(row0 + ai * HALF + m * 16) * RW) = o; }
                } else { bf16_t* dst = G + col;
#pragma unroll
                    for (int ai = 0; ai < 2; ++ai)
#pragma unroll
                        for (int m = 0; m < 4; ++m) { const f32x4 v = acc[ai][bj][m][n]; u32x2 w; w.x = cvt_pk_bf16(v[0], v[1]); w.y = cvt_pk_bf16(v[2], v[3]);
                            *(u32x2*)(dst + (size_t)(row0 + ai * HALF + m * 16) * RW) = w; }
                } }
    }
};
template <int BR> struct EpiGate {
    static constexpr bool PERM = false;
    const bf16_t* P; const float* gb; float* MIXF; bf16_t* MIXB;
    __device__ __forceinline__ void operator()(const f32x4 (&acc)[2][2][4][2], const Unit& u, int wr, int wc, int fr, int fq) const {
        const int row0 = u.pm * BM + wr * 64 + fr, col0 = u.pn * BM + wc * 32 + 4 * fq;
#pragma unroll
        for (int bj = 0; bj < 2; ++bj)
#pragma unroll
            for (int n = 0; n < 2; ++n) { const int col = col0 + bj * HALF + n * 16; const f32x4 bb = *(const f32x4*)(gb + BR * DM + col);
#pragma unroll
                for (int ai = 0; ai < 2; ++ai)
#pragma unroll
                    for (int m = 0; m < 4; ++m) { const int row = row0 + ai * HALF + m * 16;
                        const u32x2 gl = *(const u32x2*)(P + (size_t)row * DINP + PC_G + BR * DM + col);
                        f32x4 v;
                        v[0] = sigmoidf_(bflo(gl.x) + bb[0]) * acc[ai][bj][m][n][0]; v[1] = sigmoidf_(bfhi(gl.x) + bb[1]) * acc[ai][bj][m][n][1];
                        v[2] = sigmoidf_(bflo(gl.y) + bb[2]) * acc[ai][bj][m][n][2]; v[3] = sigmoidf_(bfhi(gl.y) + bb[3]) * acc[ai][bj][m][n][3];
                        float* mp = MIXF + (size_t)row * DM + col;
                        if (BR == 0) *(f32x4*)mp = v;
                        else if (BR == 1) *(f32x4*)mp = *(const f32x4*)mp + v;
                        else { const f32x4 t = *(const f32x4*)mp + v; u32x2 w; w.x = cvt_pk_bf16(t[0], t[1]); w.y = cvt_pk_bf16(t[2], t[3]); *(u32x2*)(MIXB + (size_t)row * DM + col) = w; } } }
    }
};
}

#define XB_TMO      128
#define XB_XCNT(j)  (256  + 64 * (j))
#define XB_XSUB(j)  (1280 + 64 * (j))
#define XB_XGEN(j)  (2304 + 64 * (j))
#define XB_TOP      3328
#define XB_TOPGEN   3392
#define XCD_BAR_WORDS 3456
#define XB_SPIN_CAP (1u << 18)
__device__ __forceinline__ unsigned xb_ld(unsigned* p)              { return __hip_atomic_load(p, __ATOMIC_RELAXED, __HIP_MEMORY_SCOPE_AGENT); }
__device__ __forceinline__ unsigned xb_add(unsigned* p, unsigned v) { return __hip_atomic_fetch_add(p, v, __ATOMIC_RELAXED, __HIP_MEMORY_SCOPE_AGENT); }
__device__ __forceinline__ unsigned xb_xcc_id() { return (unsigned)__builtin_amdgcn_s_getreg((3 << 11) | 20) & 0xFu; }
#define XB_SPIN(cond, bar) do { unsigned _sp = 0; while (cond) { __builtin_amdgcn_s_sleep(1); \
    if ((++_sp & 255u) == 0u) { if (xb_ld(&(bar)[XB_TMO])) break; if (_sp > XB_SPIN_CAP) { atomicAdd(&(bar)[XB_TMO], 1u); break; } } } } while (0)
struct XcdBarrier { unsigned* bar; unsigned x; volatile LAS unsigned* st; };
__device__ __forceinline__ XcdBarrier xcd_barrier_post(unsigned* bar, volatile LAS unsigned* st) {
    XcdBarrier b; b.bar = bar; b.x = xb_xcc_id(); b.st = st;
    if (threadIdx.x == 0) (void)xb_add(&bar[XB_XCNT(b.x)], 1u);
    return b;
}
__device__ __forceinline__ void xcd_barrier_complete(unsigned* bar, unsigned x, unsigned& nloc, unsigned& nx) {
    const unsigned G = gridDim.x * gridDim.y * gridDim.z;
    unsigned sum, cnt, mine, sp = 0u;
    for (;;) {
        sum = 0u; cnt = 0u; mine = 0u;
#pragma unroll
        for (unsigned j = 0; j < 16; ++j) { const unsigned c = xb_ld(&bar[XB_XCNT(j)]); sum += c; cnt += (c > 0u) ? 1u : 0u; mine = (j == x) ? c : mine; }
        if (sum == G) break;
        __builtin_amdgcn_s_sleep(1);
        if ((++sp & 255u) == 0u) { if (xb_ld(&bar[XB_TMO])) break; if (sp > XB_SPIN_CAP) { atomicAdd(&bar[XB_TMO], 1u); break; } }
    }
    nloc = mine > 0u ? mine : 1u; nx = cnt > 0u ? cnt : 1u;
}
__device__ __forceinline__ void xcd_barrier(const XcdBarrier& b) {
    asm volatile("s_waitcnt vmcnt(0)" ::: "memory");
    __syncthreads();
    if (threadIdx.x == 0) {
        unsigned* bar = b.bar;
        __builtin_amdgcn_s_waitcnt(0);
        unsigned nloc = b.st[0], nx = b.st[1];
        if (nloc == 0u) { xcd_barrier_complete(bar, b.x, nloc, nx); b.st[0] = nloc; b.st[1] = nx; }
        const unsigned old = xb_add(&bar[XB_XSUB(b.x)], 1u);
        const unsigned gen = old / nloc;
        if (old + 1u == (gen + 1u) * nloc) {
            __builtin_amdgcn_fence(__ATOMIC_RELEASE, "agent");
            asm volatile("s_waitcnt vmcnt(0)" ::: "memory");
            const unsigned og = xb_add(&bar[XB_TOP], 1u);
            const unsigned tg = og / nx;
            if (og + 1u == (tg + 1u) * nx) xb_add(&bar[XB_TOPGEN], 1u);
            else XB_SPIN(xb_ld(&bar[XB_TOPGEN]) == tg, bar);
            __builtin_amdgcn_fence(__ATOMIC_ACQUIRE, "agent");
            xb_add(&bar[XB_XGEN(b.x)], 1u);
            asm volatile("s_waitcnt vmcnt(0)" ::: "memory");
        } else {
            XB_SPIN(xb_ld(&bar[XB_XGEN(b.x)]) == gen, bar);
            __builtin_amdgcn_fence(__ATOMIC_ACQUIRE, "agent");
            asm volatile("s_waitcnt vmcnt(0)" ::: "memory");
        }
    }
    __syncthreads();
}

struct Args { const float* in[N_IN]; float* out; unsigned char* ws; int ph_lo, ph_hi; };
typedef const __attribute__((address_space(4))) Args* KArgs;
__device__ __forceinline__ KArgs kargs() { KArgs p = (KArgs)__builtin_amdgcn_kernarg_segment_ptr(); asm volatile("" : "+s"(p)); return p; }

template <int MODE>
__device__ __forceinline__ void cvt_tile(const float* W, int K, int N, bf16_t* WT, int item, int lane) {
    const int nblk = N / 32, kb = item / nblk, nb = item - kb * nblk, k0 = kb * 64, n0 = nb * 32;
    const int n4 = lane & 7, kg = lane >> 3;
    const float* src = W + (size_t)(k0 + kg * 8) * N + n0 + n4 * 4;
    f32x4 v[8];
#pragma unroll
    for (int kk = 0; kk < 8; ++kk) v[kk] = *(const f32x4*)(src + (size_t)kk * N);
    int drow = n0 + n4 * 4;
    if (MODE == 1) drow = (drow >> 7) * 256 + (drow & 127);
    if (MODE == 2) drow = (drow >> 7) * 256 + 128 + (drow & 127);
    bf16_t* dst = WT + (size_t)drow * K + k0 + kg * 8;
#pragma unroll
    for (int j = 0; j < 4; ++j) { u32x4 w; w.x = cvt_pk_bf16(v[0][j], v[1][j]); w.y = cvt_pk_bf16(v[2][j], v[3][j]); w.z = cvt_pk_bf16(v[4][j], v[5][j]); w.w = cvt_pk_bf16(v[6][j], v[7][j]);
        *(u32x4*)(dst + (size_t)j * K) = w; }
}

__device__ __forceinline__ void phase_cvt(KArgs a, int l, int gw, int NGW, int lane) {
    unsigned char* ws = a->ws;
    const float* f1g = a->in[I_F1G] + (size_t)l * DM * FF; const float* f1u = a->in[I_F1U] + (size_t)l * DM * FF; const float* f1d = a->in[I_F1D] + (size_t)l * FF * DM;
    const float* win = a->in[I_WIN] + (size_t)l * DM * DIN; const float* wkv = a->in[I_WKV] + (size_t)l * DM * DM; const float* wbr = a->in[I_WBR] + (size_t)l * 3 * RW * DM;
    const float* wout = a->in[I_WOUT] + (size_t)l * DM * DM;
    constexpr int T_GU = (DM / 64) * (FF / 32), T_D = (FF / 64) * (DM / 32), T_IN = (DM / 64) * (DIN / 32), T_SQ = (DM / 64) * (DM / 32), T_BR = (RW / 64) * (DM / 32);
    constexpr int NIT = 2 * T_GU + T_D + T_IN + 2 * T_SQ + 3 * T_BR;
    for (int it = gw; it < NIT; it += NGW) {
        int r = it;
        if (r < T_GU) { cvt_tile<1>(f1g, DM, FF, (bf16_t*)(ws + WS_WGU1), r, lane); continue; } r -= T_GU;
        if (r < T_GU) { cvt_tile<2>(f1u, DM, FF, (bf16_t*)(ws + WS_WGU1), r, lane); continue; } r -= T_GU;
        if (r < T_D) { cvt_tile<0>(f1d, FF, DM, (bf16_t*)(ws + WS_WD1), r, lane); continue; } r -= T_D;
        if (r < T_IN) { cvt_tile<0>(win, DM, DIN, (bf16_t*)(ws + WS_WIN), r, lane); continue; } r -= T_IN;
        if (r < T_SQ) { cvt_tile<0>(wkv, DM, DM, (bf16_t*)(ws + WS_WKV), r, lane); continue; } r -= T_SQ;
        if (r < T_BR) { cvt_tile<0>(wbr, RW, DM, (bf16_t*)(ws + WS_WBR), r, lane); continue; } r -= T_BR;
        if (r < T_BR) { cvt_tile<0>(wbr + (size_t)RW * DM, RW, DM, (bf16_t*)(ws + WS_WBR) + (size_t)DM * RW, r, lane); continue; } r -= T_BR;
        if (r < T_BR) { cvt_tile<0>(wbr + (size_t)2 * RW * DM, RW, DM, (bf16_t*)(ws + WS_WBR) + (size_t)2 * DM * RW, r, lane); continue; } r -= T_BR;
        cvt_tile<0>(wout, DM, DM, (bf16_t*)(ws + WS_WOUT), r, lane);
    }
    { u32x4* z = (u32x4*)((bf16_t*)(ws + WS_WIN) + (size_t)DIN * DM); const int nz = (DINP - DIN) * DM / 8;
      for (int i = gw * 64 + lane; i < nz; i += NGW * 64) z[i] = (u32x4){0u, 0u, 0u, 0u}; }
    { const float* wup = a->in[I_WUP] + (size_t)l * 2 * 64 * RW; const float* aup = a->in[I_AUP] + (size_t)l * 2 * 64 * RW; const float* gup = a->in[I_GUP] + (size_t)l * 128 * RW;
      bf16_t* wlr = (bf16_t*)(ws + WS_WLR);
      for (int i = gw * 64 + lane; i < LRN * (LRK / 8); i += NGW * 64) { const int n = i / (LRK / 8), kc = (i - n * (LRK / 8)) * 8; const int blk = n >> 10, nn = n & 1023;
          const int kb0 = blk < 4 ? 64 * blk : 256, kb1 = blk < 4 ? kb0 + 64 : 384;
          const float* src = blk < 2 ? wup + (size_t)blk * 64 * RW : (blk < 4 ? aup + (size_t)(blk - 2) * 64 * RW : gup);
          float f[8];
#pragma unroll
          for (int e = 0; e < 8; ++e) { const int k = kc + e; f[e] = (k >= kb0 && k < kb1) ? src[(size_t)(k - kb0) * RW + nn] : 0.f; }
          *(u32x4*)(wlr + (size_t)n * LRK + kc) = pack8(f); } }
    if (l == 0) { const f32x4* xs = (const f32x4*)a->in[I_X]; u32x2* xb = (u32x2*)(ws + WS_XB);
        for (size_t i = (size_t)gw * 64 + lane; i < (size_t)M * DM / 4; i += (size_t)NGW * 64) { const f32x4 v = xs[i]; u32x2 w; w.x = cvt_pk_bf16(v[0], v[1]); w.y = cvt_pk_bf16(v[2], v[3]); xb[i] = w; } }
    { const float* mg = a->in[I_MLNG] + (size_t)l * DM; const float* mb = a->in[I_MLNB] + (size_t)l * DM; bf16_t* memn = (bf16_t*)(ws + WS_MEMN);
      for (int m = gw; m < BATCH * NMEM; m += NGW) {
          const f32x4* xr = (const f32x4*)(a->in[I_MEM] + (size_t)m * DM) + lane; f32x4 v[8]; float s = 0.f;
#pragma unroll
          for (int j = 0; j < 8; ++j) { v[j] = xr[64 * j]; s += (v[j][0] + v[j][1]) + (v[j][2] + v[j][3]); }
          const float mean = wave_sum(s) * (1.f / DM); float s2 = 0.f;
#pragma unroll
          for (int j = 0; j < 8; ++j) { v[j] = v[j] - mean; s2 += (v[j][0] * v[j][0] + v[j][1] * v[j][1]) + (v[j][2] * v[j][2] + v[j][3] * v[j][3]); }
          const float rstd = rsqrtf(wave_sum(s2) * (1.f / DM) + LN_EPS);
#pragma unroll
          for (int j = 0; j < 8; ++j) { const f32x4 gg = *((const f32x4*)mg + lane + 64 * j), bb = *((const f32x4*)mb + lane + 64 * j); const f32x4 y = v[j] * rstd * gg + bb;
              u32x2 w; w.x = cvt_pk_bf16(y[0], y[1]); w.y = cvt_pk_bf16(y[2], y[3]); *((u32x2*)(memn + (size_t)m * DM) + lane + 64 * j) = w; } } }
}

__device__ __forceinline__ void phase_cvt2(KArgs a, int l, int gw, int NGW, int lane) {
    unsigned char* ws = a->ws;
    const float* f2g = a->in[I_F2G] + (size_t)l * DM * FF; const float* f2u = a->in[I_F2U] + (size_t)l * DM * FF; const float* f2d = a->in[I_F2D] + (size_t)l * FF * DM;
    constexpr int T_GU = (DM / 64) * (FF / 32), T_D = (FF / 64) * (DM / 32);
    constexpr int NIT = 2 * T_GU + T_D;
    for (int it = gw; it < NIT; it += NGW) {
        int r = it;
        if (r < T_GU) { cvt_tile<1>(f2g, DM, FF, (bf16_t*)(ws + WS_WGU2), r, lane); continue; } r -= T_GU;
        if (r < T_GU) { cvt_tile<2>(f2u, DM, FF, (bf16_t*)(ws + WS_WGU2), r, lane); continue; } r -= T_GU;
        cvt_tile<0>(f2d, FF, DM, (bf16_t*)(ws + WS_WD2), r, lane);
    }
}

__device__ __forceinline__ void phase_ln(const float* src, float* dst, bf16_t* dstb, const float* g, const float* b, int gw, int NGW, int lane) {
    for (int m = gw; m < M; m += NGW) {
        const f32x4* xr = (const f32x4*)(src + (size_t)m * DM) + lane; f32x4 v[8]; float s = 0.f;
#pragma unroll
        for (int j = 0; j < 8; ++j) { v[j] = xr[64 * j]; s += (v[j][0] + v[j][1]) + (v[j][2] + v[j][3]); }
        const float mean = wave_sum(s) * (1.f / DM); float s2 = 0.f;
#pragma unroll
        for (int j = 0; j < 8; ++j) { v[j] = v[j] - mean; s2 += (v[j][0] * v[j][0] + v[j][1] * v[j][1]) + (v[j][2] * v[j][2] + v[j][3] * v[j][3]); }
        const float rstd = rsqrtf(wave_sum(s2) * (1.f / DM) + LN_EPS);
#pragma unroll
        for (int j = 0; j < 8; ++j) { const f32x4 gg = *((const f32x4*)g + lane + 64 * j), bb = *((const f32x4*)b + lane + 64 * j); const f32x4 y = v[j] * rstd * gg + bb;
            *((f32x4*)(dst + (size_t)m * DM) + lane + 64 * j) = y;
            if (dstb) { u32x2 w; w.x = cvt_pk_bf16(y[0], y[1]); w.y = cvt_pk_bf16(y[2], y[3]); *((u32x2*)(dstb + (size_t)m * DM) + lane + 64 * j) = w; } }
    }
}

__device__ __forceinline__ void phase_elt(KArgs a, int l, int gw, int NGW, int lane) {
    unsigned char* ws = a->ws;
    const bf16_t* P = (const bf16_t*)(ws + WS_P);
    bf16_t* Rb = (bf16_t*)(ws + WS_R); bf16_t* Kb = (bf16_t*)(ws + WS_K); bf16_t* Vb = (bf16_t*)(ws + WS_V); bf16_t* KKb = (bf16_t*)(ws + WS_KK);
    bf16_t* AC = (bf16_t*)(ws + WS_ACAT); bf16_t* YS = (bf16_t*)(ws + WS_YS);
    const float* mu = a->in[I_MU] + (size_t)l * 3456; const float* k_k = a->in[I_KK] + (size_t)l * RW; const float* cw = a->in[I_CONVW] + (size_t)l * 3 * RW;
    for (int m = gw; m < M; m += NGW) {
        const int t = m & (SEQ - 1); const bool hp = t > 0, hn = t < SEQ - 1;
        const bf16_t* pc = P + (size_t)m * DINP;
#pragma unroll
        for (int j = 0; j < 7; ++j) {
            const int c0 = 8 * (lane + 64 * j);
            if (j == 6 && lane >= 48) continue;
            const u32x4 zc = (u32x4){0u, 0u, 0u, 0u};
            const u32x4 wc_ = *(const u32x4*)(pc + c0); const u32x4 wp = hp ? *(const u32x4*)(pc - DINP + c0) : zc; const u32x4 wn = hn ? *(const u32x4*)(pc + DINP + c0) : zc;
            float cu[8], pv[8], nx[8], s[8]; unpack8(wc_, cu); unpack8(wp, pv); unpack8(wn, nx);
            const f32x4 m0 = *(const f32x4*)(mu + c0), m1 = *(const f32x4*)(mu + c0 + 4);
#pragma unroll
            for (int e = 0; e < 8; ++e) { const float mm = e < 4 ? m0[e] : m1[e - 4]; s[e] = cu[e] + mm * (0.5f * (pv[e] + nx[e]) - cu[e]); }
            if (j < 2) { *(u32x4*)(Rb + (size_t)m * RW + c0) = pack8(s); }
            else if (j < 4) { const int c = c0 - 1024; *(u32x4*)(Kb + (size_t)m * RW + c) = pack8(s);
                const f32x4 k0 = *(const f32x4*)(k_k + c), k1 = *(const f32x4*)(k_k + c + 4); float kx[8]; float ss = 0.f;
#pragma unroll
                for (int e = 0; e < 8; ++e) { kx[e] = s[e] * (e < 4 ? k0[e] : k1[e - 4]); ss += kx[e] * kx[e]; }
                ss = sum8(ss); const float inv = rsqrtf(ss + 1e-12f);
#pragma unroll
                for (int e = 0; e < 8; ++e) kx[e] *= inv;
                *(u32x4*)(KKb + (size_t)m * RW + c) = pack8(kx); }
            else if (j < 6) { *(u32x4*)(Vb + (size_t)m * RW + (c0 - 2048)) = pack8(s); }
            else { const int cc = c0 - 3072; float f[8];
#pragma unroll
                for (int e = 0; e < 8; ++e) f[e] = cc < 128 ? tanhf(s[e]) : (cc < 256 ? s[e] : sigmoidf_(s[e]));
                *(u32x4*)(AC + (size_t)m * LRK + cc) = pack8(f); }
        }
#pragma unroll
        for (int j = 0; j < 2; ++j) {
            const int c = 8 * (lane + 64 * j);
            const u32x4 zc = (u32x4){0u, 0u, 0u, 0u};
            float gbv[8], gc[8], hh[8], up[8], uc[8], un[8];
            unpack8(*(const u32x4*)(pc + PC_CB + c), gbv);
            unpack8(*(const u32x4*)(pc + PC_CC + c), gc); unpack8(*(const u32x4*)(pc + PC_CH + c), hh);
#pragma unroll
            for (int e = 0; e < 8; ++e) uc[e] = gc[e] * hh[e];
            unpack8(hp ? *(const u32x4*)(pc - DINP + PC_CC + c) : zc, gc); unpack8(hp ? *(const u32x4*)(pc - DINP + PC_CH + c) : zc, hh);
#pragma unroll
            for (int e = 0; e < 8; ++e) up[e] = gc[e] * hh[e];
            unpack8(hn ? *(const u32x4*)(pc + DINP + PC_CC + c) : zc, gc); unpack8(hn ? *(const u32x4*)(pc + DINP + PC_CH + c) : zc, hh);
#pragma unroll
            for (int e = 0; e < 8; ++e) un[e] = gc[e] * hh[e];
            float o[8];
#pragma unroll
            for (int e = 0; e < 8; ++e) o[e] = gbv[e] * (cw[c + e] * up[e] + cw[RW + c + e] * uc[e] + cw[2 * RW + c + e] * un[e]);
            *(u32x4*)(YS + (size_t)m * 3072 + 1024 + c) = pack8(o);
        }
    }
}

constexpr int XA_PITCH = 528;
__device__ __forceinline__ void xattn_unit(KArgs a, int unit, LAS unsigned char* lds, int tid, int wave, int lane) {
    unsigned char* ws = a->ws;
    const bf16_t* P = (const bf16_t*)(ws + WS_P); const bf16_t* KM = (const bf16_t*)(ws + WS_KMEM); const bf16_t* VT = (const bf16_t*)(ws + WS_VT); bf16_t* YS = (bf16_t*)(ws + WS_YS);
    const int bb = unit >> 7, h = (unit >> 5) & 3, qt = unit & 31, fr = lane & 15, fq = lane >> 4;
    const int mrow = bb * SEQ + qt * 128 + wave * 16 + fr;
    bf16x8 qf[8];
#pragma unroll
    for (int ks = 0; ks < 8; ++ks) qf[ks] = *(const bf16x8*)(P + (size_t)mrow * DINP + PC_Q + h * 256 + 32 * ks + 8 * fq);
#pragma unroll 4
    for (int it = 0; it < 16; ++it) { const int idx = tid + 512 * it, key = idx >> 5, ch = idx & 31;
        const u32x4 v = *(const u32x4*)(KM + (size_t)(bb * NMEM + key) * 1024 + h * 256 + ch * 8);
        *(LAS u32x4*)(lds + key * XA_PITCH + ch * 16) = v; }
    __syncthreads();
    f32x4 sacc[16];
#pragma unroll
    for (int kb = 0; kb < 16; ++kb) { f32x4 acc = (f32x4){0.f, 0.f, 0.f, 0.f};
#pragma unroll
        for (int ks = 0; ks < 8; ++ks) { const bf16x8 kf = *(const LAS bf16x8*)(lds + (kb * 16 + fr) * XA_PITCH + (32 * ks + 8 * fq) * 2);
            acc = __builtin_amdgcn_mfma_f32_16x16x32_bf16(kf, qf[ks], acc, 0, 0, 0); }
        sacc[kb] = acc; }
    float mx = -3.0e38f;
#pragma unroll
    for (int kb = 0; kb < 16; ++kb)
#pragma unroll
        for (int i = 0; i < 4; ++i) mx = fmaxf(mx, sacc[kb][i]);
    mx = fmaxf(mx, __shfl_xor(mx, 16)); mx = fmaxf(mx, __shfl_xor(mx, 32));
    float sum = 0.f;
#pragma unroll
    for (int kb = 0; kb < 16; ++kb)
#pragma unroll
        for (int i = 0; i < 4; ++i) { const float p = __expf((sacc[kb][i] - mx) * 0.0625f); sacc[kb][i] = p; sum += p; }
    sum += __shfl_xor(sum, 16); sum += __shfl_xor(sum, 32);
    const float rs = 1.0f / sum;
    bf16x8 pf[8];
#pragma unroll
    for (int s2 = 0; s2 < 8; ++s2) { u32x4 w; w.x = cvt_pk_bf16(sacc[2 * s2][0], sacc[2 * s2][1]); w.y = cvt_pk_bf16(sacc[2 * s2][2], sacc[2 * s2][3]);
        w.z = cvt_pk_bf16(sacc[2 * s2 + 1][0], sacc[2 * s2 + 1][1]); w.w = cvt_pk_bf16(sacc[2 * s2 + 1][2], sacc[2 * s2 + 1][3]); pf[s2] = __builtin_bit_cast(bf16x8, w); }
    __syncthreads();
#pragma unroll 4
    for (int it = 0; it < 16; ++it) { const int idx = tid + 512 * it, d = idx >> 5, ch = idx & 31;
        const u32x4 v = *(const u32x4*)(VT + (size_t)(h * 256 + d) * 512 + bb * NMEM + ch * 8);
        *(LAS u32x4*)(lds + d * XA_PITCH + ch * 16) = v; }
    __syncthreads();
#pragma unroll
    for (int db = 0; db < 16; ++db) { f32x4 acc = (f32x4){0.f, 0.f, 0.f, 0.f};
#pragma unroll
        for (int s2 = 0; s2 < 8; ++s2) { const LAS unsigned char* rp = lds + (db * 16 + fr) * XA_PITCH;
            const u32x2 lo = *(const LAS u32x2*)(rp + (32 * s2 + 4 * fq) * 2), hi = *(const LAS u32x2*)(rp + (32 * s2 + 16 + 4 * fq) * 2);
            u32x4 w; w.x = lo.x; w.y = lo.y; w.z = hi.x; w.w = hi.y;
            acc = __builtin_amdgcn_mfma_f32_16x16x32_bf16(__builtin_bit_cast(bf16x8, w), pf[s2], acc, 0, 0, 0); }
        u32x2 o; o.x = cvt_pk_bf16(acc[0] * rs, acc[1] * rs); o.y = cvt_pk_bf16(acc[2] * rs, acc[3] * rs);
        *(u32x2*)(YS + (size_t)mrow * 3072 + 2048 + h * 256 + db * 16 + 4 * fq) = o; }
    __syncthreads();
}

constexpr int SC_TC = 32;
constexpr int SC_BUF = SC_TC * 5 * 64 * 4;
constexpr int SC_VOFF = SC_BUF, SC_YOFF = SC_BUF + SC_TC * 16 * 4, SC_STRIDE = SC_YOFF + SC_TC * 16 * 4;
__device__ __forceinline__ void phase_scan(KArgs a, int l, int wgid, LAS unsigned char* lds, int tid, int wave, int lane) {
    unsigned char* ws = a->ws;
    const int seq = wgid >> 2, rq = wgid & 3, dir = seq >> 5, bb = (seq >> 4) & 1, h = seq & 15;
    const float* W2 = (const float*)(ws + WS_W2) + (size_t)dir * M * RW; const float* A2 = (const float*)(ws + WS_A2) + (size_t)dir * M * RW;
    const bf16_t* KKb = (const bf16_t*)(ws + WS_KK); const bf16_t* Kb = (const bf16_t*)(ws + WS_K); const bf16_t* Rb = (const bf16_t*)(ws + WS_R); const bf16_t* Vb = (const bf16_t*)(ws + WS_V);
    bf16_t* Y = (bf16_t*)(ws + (dir ? WS_YB : WS_YF));
    const float* k_a = a->in[I_KA] + (size_t)l * RW;
    const int ss = tid >> 4, kq = tid & 15;
    const f32x4 ka4 = *(const f32x4*)(k_a + h * 64 + 4 * kq);
    f32x4 gw_, ga_; u32x2 gkk, gk, gr; unsigned short gv;
#define SC_LOAD(ci) do { const int tk = (ci) * SC_TC + ss; const int tok = dir ? (SEQ - 1 - tk) : tk; const size_t mo = (size_t)(bb * SEQ + tok) * RW + h * 64; \
        gw_ = *(const f32x4*)(W2 + mo + 4 * kq); ga_ = *(const f32x4*)(A2 + mo + 4 * kq); gkk = *(const u32x2*)(KKb + mo + 4 * kq); gk = *(const u32x2*)(Kb + mo + 4 * kq); gr = *(const u32x2*)(Rb + mo + 4 * kq); \
        gv = Vb[mo + rq * 16 + kq]; } while (0)
#define SC_STORE(buf) do { LAS unsigned char* bp = lds + (buf) * SC_STRIDE; LAS float* vp = (LAS float*)(bp + (ss * 5) * 256 + kq * 16); \
        f32x4 kk4 = (f32x4){bflo(gkk.x), bfhi(gkk.x), bflo(gkk.y), bfhi(gkk.y)}; f32x4 k4 = (f32x4){bflo(gk.x), bfhi(gk.x), bflo(gk.y), bfhi(gk.y)}; f32x4 r4 = (f32x4){bflo(gr.x), bfhi(gr.x), bflo(gr.y), bfhi(gr.y)}; \
        *(LAS f32x4*)(vp) = (f32x4){__expf(gw_[0]), __expf(gw_[1]), __expf(gw_[2]), __expf(gw_[3])}; *(LAS f32x4*)(vp + 64) = kk4; *(LAS f32x4*)(vp + 128) = kk4 * ga_; *(LAS f32x4*)(vp + 192) = k4 * (1.0f + (ga_ - 1.0f) * ka4); *(LAS f32x4*)(vp + 256) = r4; \
        ((LAS float*)(bp + SC_VOFF))[ss * 16 + kq] = __uint_as_float((unsigned)gv << 16); } while (0)
    const int rg = lane >> 4, kc = lane & 15, myrow = 4 * wave + rg;
    f32x4 S = (f32x4){0.f, 0.f, 0.f, 0.f};
#define SC_ROWSUM(x) do { x += __builtin_bit_cast(float, __builtin_amdgcn_update_dpp(0, __builtin_bit_cast(int, x), 0x128, 0xf, 0xf, false)); \
        x += __builtin_bit_cast(float, __builtin_amdgcn_update_dpp(0, __builtin_bit_cast(int, x), 0x124, 0xf, 0xf, false)); \
        x += __builtin_bit_cast(float, __builtin_amdgcn_update_dpp(0, __builtin_bit_cast(int, x), 0x122, 0xf, 0xf, false)); \
        x += __builtin_bit_cast(float, __builtin_amdgcn_update_dpp(0, __builtin_bit_cast(int, x), 0x121, 0xf, 0xf, false)); } while (0)
    SC_LOAD(0); SC_STORE(0);
    __syncthreads();
    constexpr int NCH = SEQ / SC_TC;
    for (int ci = 0; ci < NCH; ++ci) {
        const int buf = ci & 1;
        if (ci + 1 < NCH) SC_LOAD(ci + 1);
        if (wave < 4) {
            const LAS unsigned char* bp = lds + buf * SC_STRIDE;
            const LAS float* vb = (const LAS float*)(bp + SC_VOFF) + myrow; LAS float* yb = (LAS float*)(lds + buf * SC_STRIDE + SC_YOFF) + kc * 16 + myrow;
            const LAS float* vp0 = (const LAS float*)bp + 4 * kc;
            f32x4 w4 = *(const LAS f32x4*)(vp0), kk4 = *(const LAS f32x4*)(vp0 + 64), b4 = *(const LAS f32x4*)(vp0 + 128), kd4 = *(const LAS f32x4*)(vp0 + 192), r4 = *(const LAS f32x4*)(vp0 + 256);
            float vv = vb[0], ykeep = 0.f;
#pragma unroll
            for (int s = 0; s < SC_TC; ++s) {
                const LAS float* vpn = vp0 + ((s + 1) & (SC_TC - 1)) * 320;
                const f32x4 nw4 = *(const LAS f32x4*)(vpn), nkk4 = *(const LAS f32x4*)(vpn + 64), nb4 = *(const LAS f32x4*)(vpn + 128), nkd4 = *(const LAS f32x4*)(vpn + 192), nr4 = *(const LAS f32x4*)(vpn + 256);
                const float nvv = vb[((s + 1) & (SC_TC - 1)) * 16];
                f32x2 p = (f32x2){S[0], S[1]} * (f32x2){kk4[0], kk4[1]}; p = (f32x2){S[2], S[3]} * (f32x2){kk4[2], kk4[3]} + p;
                float d = p.x + p.y;
                SC_ROWSUM(d);
                S = S * w4 + (kd4 * vv - b4 * d);
                f32x2 q = (f32x2){S[0], S[1]} * (f32x2){r4[0], r4[1]}; q = (f32x2){S[2], S[3]} * (f32x2){r4[2], r4[3]} + q;
                float y = q.x + q.y;
                SC_ROWSUM(y);
                ykeep = (kc == (s & 15)) ? y : ykeep;
                if ((s & 15) == 15) yb[(s >> 4) * 256] = ykeep;
                w4 = nw4; kk4 = nkk4; b4 = nb4; kd4 = nkd4; r4 = nr4; vv = nvv;
            }
        }
        if (ci + 1 < NCH) SC_STORE(buf ^ 1);
        __syncthreads();
        { const int tk = ci * SC_TC + ss; const int tok = dir ? (SEQ - 1 - tk) : tk;
          Y[(size_t)(bb * SEQ + tok) * RW + h * 64 + rq * 16 + kq] = (bf16_t)(cvt_pk_bf16(((const LAS float*)(lds + buf * SC_STRIDE + SC_YOFF))[ss * 16 + kq], 0.f) & 0xffffu); }
    }
    __syncthreads();
#undef SC_LOAD
#undef SC_STORE
}

typedef float f32x16 __attribute__((ext_vector_type(16)));
typedef __bf16 bf16x2_t __attribute__((ext_vector_type(2)));
__device__ __forceinline__ unsigned pkbf(float a, float b) { const f32x2 v = {a, b}; return __builtin_bit_cast(unsigned, __builtin_convertvector(v, bf16x2_t)); }
#define CS_PACK(x, s) __builtin_bit_cast(bf16x8, (u32x4){pkbf((x)[8 * (s)], (x)[8 * (s) + 1]), pkbf((x)[8 * (s) + 2], (x)[8 * (s) + 3]), pkbf((x)[8 * (s) + 4], (x)[8 * (s) + 5]), pkbf((x)[8 * (s) + 6], (x)[8 * (s) + 7])})
#define MF32(a, b, c) __builtin_amdgcn_mfma_f32_32x32x16_bf16((a), (b), (c), 0, 0, 0)
constexpr int CS_C = 32, CS_NCH = SEQ / CS_C;
constexpr int CS_TP = 144, CS_XP = 72;
constexpr int CS_TQ = 0, CS_TR = 4608, CS_TB = 9216, CS_TK = 13824, CS_XQ = 18432, CS_XB = 23040, CS_XK = 27648, CS_XV = 32256, CS_ELC = 36864, CS_WAVE = 37376;
static_assert(4 * CS_WAVE <= LDS_MISC, "scan_pre LDS");
__device__ __forceinline__ int cs_rho(int k) { return (k >> 1) + 32 * (k & 1); }
__device__ __forceinline__ int cs_swz(int row, int pos) { return ((((pos >> 3) ^ (row & 7)) << 4) + ((pos >> 2) & 1) * 8); }
__device__ __forceinline__ void scan_pre(KArgs a, int l, int bid, int G, LAS unsigned char* lds, int wave, int lane) {
    if (wave >= 4) return;
    unsigned char* ws = a->ws;
    LAS unsigned char* wb = lds + wave * CS_WAVE;
    const int r = lane & 31, h = lane >> 5;
    const bf16_t* KKb = (const bf16_t*)(ws + WS_KK); const bf16_t* Kb = (const bf16_t*)(ws + WS_K); const bf16_t* Rb = (const bf16_t*)(ws + WS_R); const bf16_t* Vb = (const bf16_t*)(ws + WS_V);
    const float* k_a = a->in[I_KA] + (size_t)l * RW;
    f32x16 zero;
#pragma unroll
    for (int i = 0; i < 16; ++i) zero[i] = 0.f;
    for (int item = bid * 4 + wave; item < 64 * CS_NCH; item += G * 4) {
        const int seq = item >> 7, chunk = item & (CS_NCH - 1), dir = seq >> 5, bb = (seq >> 4) & 1, hd = seq & 15;
        const float* LW = (const float*)(ws + WS_W2) + (size_t)dir * M * RW; const float* A2 = (const float*)(ws + WS_A2) + (size_t)dir * M * RW;
        {
            const int half = h, kp = r, c0 = chunk * CS_C;
            const f32x2 ka2 = *(const f32x2*)(k_a + hd * 64 + 2 * kp);
            f32x2 lw[16], avv[16]; unsigned kkwv[16], kwv[16], rwv[16], vwv[16]; f32x2 tot = (f32x2){0.f, 0.f};
            const int tstep = dir ? -RW : RW;
            const int idx0 = (bb * SEQ + (dir ? SEQ - 1 - c0 : c0)) * RW + hd * 64 + (16 * half) * tstep + 2 * kp;
#pragma unroll
            for (int i = 0; i < 16; ++i) { const int mo = idx0 + i * tstep;
                lw[i] = *(const f32x2*)(LW + mo); avv[i] = *(const f32x2*)(A2 + mo); kkwv[i] = *(const unsigned*)(KKb + mo); kwv[i] = *(const unsigned*)(Kb + mo); rwv[i] = *(const unsigned*)(Rb + mo); vwv[i] = *(const unsigned*)(Vb + mo); }
            asm volatile("" ::: "memory");
#pragma unroll
            for (int i = 0; i < 16; ++i) tot += lw[i];
            f32x2 run; run.x = __shfl(tot.x, kp); run.y = __shfl(tot.y, kp);
            if (half == 0) run = (f32x2){0.f, 0.f};
            unsigned pq0 = 0, pq1 = 0, pb0 = 0, pb1 = 0, pk0 = 0, pk1 = 0, pv = 0;
            float oq0 = 0, oq1 = 0, ob0 = 0, ob1 = 0, ok0 = 0, ok1 = 0;
#pragma unroll
            for (int i = 0; i < 16; ++i) {
                const int tl = 16 * half + i;
                const f32x2 av = avv[i]; const unsigned kkw = kkwv[i], kw = kwv[i], rw = rwv[i], vw = vwv[i];
                const f32x2 Lm = run; run += lw[i];
                const f32x2 eL = (f32x2){__expf(run.x), __expf(run.y)}, eLm = (f32x2){__expf(Lm.x), __expf(Lm.y)}, ei = (f32x2){__expf(-run.x), __expf(-run.y)};
                const f32x2 kk2 = (f32x2){bflo(kkw), bfhi(kkw)}, k2 = (f32x2){bflo(kw), bfhi(kw)}, r2 = (f32x2){bflo(rw), bfhi(rw)};
                const f32x2 q = kk2 * eLm, rt = r2 * eL, bt = kk2 * av * ei, kt = k2 * (1.0f + (av - 1.0f) * ka2) * ei;
                *(LAS unsigned*)(wb + CS_TQ + tl * CS_TP + 4 * kp) = pkbf(q.x, q.y); *(LAS unsigned*)(wb + CS_TR + tl * CS_TP + 4 * kp) = pkbf(rt.x, rt.y);
                *(LAS unsigned*)(wb + CS_TB + tl * CS_TP + 4 * kp) = pkbf(bt.x, bt.y); *(LAS unsigned*)(wb + CS_TK + tl * CS_TP + 4 * kp) = pkbf(kt.x, kt.y);
                if ((i & 1) == 0) { oq0 = q.x; oq1 = q.y; ob0 = bt.x; ob1 = bt.y; ok0 = kt.x; ok1 = kt.y; pv = vw; }
                else {
                    pq0 = pkbf(oq0, q.x); pq1 = pkbf(oq1, q.y); pb0 = pkbf(ob0, bt.x); pb1 = pkbf(ob1, bt.y); pk0 = pkbf(ok0, kt.x); pk1 = pkbf(ok1, kt.y);
                    const int co = 2 * (tl - 1);
                    *(LAS unsigned*)(wb + CS_XQ + kp * CS_XP + co) = pq0; *(LAS unsigned*)(wb + CS_XQ + (32 + kp) * CS_XP + co) = pq1;
                    *(LAS unsigned*)(wb + CS_XB + kp * CS_XP + co) = pb0; *(LAS unsigned*)(wb + CS_XB + (32 + kp) * CS_XP + co) = pb1;
                    *(LAS unsigned*)(wb + CS_XK + kp * CS_XP + co) = pk0; *(LAS unsigned*)(wb + CS_XK + (32 + kp) * CS_XP + co) = pk1;
                    *(LAS unsigned*)(wb + CS_XV + kp * CS_XP + co) = (pv & 0xffffu) | (vw << 16); *(LAS unsigned*)(wb + CS_XV + (32 + kp) * CS_XP + co) = (pv >> 16) | (vw & 0xffff0000u);
                }
                if (i == 15 && half == 1) *(LAS f32x2*)(wb + CS_ELC + 8 * kp) = eL;
            }
        }
#define CS_TFRAG(off, ks) (*(const LAS bf16x8*)(wb + (off) + r * CS_TP + (16 * (ks) + 8 * h) * 2))
#define CS_XFRAG(off, tile, s) __builtin_bit_cast(bf16x8, (u32x4){ (*(const LAS u32x2*)(wb + (off) + cs_rho(32 * (tile) + r) * CS_XP + (16 * (s) + 4 * h) * 2)).x, (*(const LAS u32x2*)(wb + (off) + cs_rho(32 * (tile) + r) * CS_XP + (16 * (s) + 4 * h) * 2)).y, \
                                                             (*(const LAS u32x2*)(wb + (off) + cs_rho(32 * (tile) + r) * CS_XP + (16 * (s) + 8 + 4 * h) * 2)).x, (*(const LAS u32x2*)(wb + (off) + cs_rho(32 * (tile) + r) * CS_XP + (16 * (s) + 8 + 4 * h) * 2)).y })
        f32x16 Tm, TmT, AkqT, Abr, Akr;
        {
            bf16x8 fq[4], fr[4], fb[4], fk[4];
#pragma unroll
            for (int ks = 0; ks < 4; ++ks) { fq[ks] = CS_TFRAG(CS_TQ, ks); fr[ks] = CS_TFRAG(CS_TR, ks); fb[ks] = CS_TFRAG(CS_TB, ks); fk[ks] = CS_TFRAG(CS_TK, ks); }
            f32x16 Nn = zero, NnT = zero; AkqT = zero; Abr = zero; Akr = zero;
#pragma unroll
            for (int ks = 0; ks < 4; ++ks) { Nn = MF32(fb[ks], fq[ks], Nn); NnT = MF32(fq[ks], fb[ks], NnT); AkqT = MF32(fq[ks], fk[ks], AkqT); Abr = MF32(fb[ks], fr[ks], Abr); Akr = MF32(fk[ks], fr[ks], Akr); }
#pragma unroll
            for (int i = 0; i < 16; ++i) { const int row = (i & 3) + 8 * (i >> 2) + 4 * h;
                Nn[i] = row < r ? -Nn[i] : 0.f;
                NnT[i] = r < row ? -NnT[i] : 0.f;
                AkqT[i] = r < row ? AkqT[i] : 0.f;
                Abr[i] = row <= r ? Abr[i] : 0.f;
                Akr[i] = row <= r ? Akr[i] : 0.f; }
            f32x16 P = Nn, PT = NnT; Tm = Nn; TmT = NnT;
#pragma unroll
            for (int i = 0; i < 16; ++i) { const int row = (i & 3) + 8 * (i >> 2) + 4 * h; if (row == r) { Tm[i] += 1.0f; TmT[i] += 1.0f; } }
#pragma unroll
            for (int it = 0; it < 4; ++it) {
                const bf16x8 p0 = CS_PACK(P, 0), p1 = CS_PACK(P, 1), t0 = CS_PACK(PT, 0), t1 = CS_PACK(PT, 1);
                f32x16 P2 = MF32(t0, p0, zero); P2 = MF32(t1, p1, P2);
                if (it < 3) { f32x16 P2T = MF32(p0, t0, zero); P2T = MF32(p1, t1, P2T); PT = P2T; }
                P = P2;
                const bf16x8 n0 = CS_PACK(P, 0), n1 = CS_PACK(P, 1), m0 = CS_PACK(TmT, 0), m1 = CS_PACK(TmT, 1);
                f32x16 Tn = MF32(m0, n0, Tm); Tn = MF32(m1, n1, Tn);
                if (it < 3) { f32x16 TnT = MF32(n0, m0, TmT); TnT = MF32(n1, m1, TnT); TmT = TnT; }
                Tm = Tn;
            }
        }
        const size_t rec = (size_t)seq * CS_NCH + chunk;
        unsigned char* gMs = ws + WS_CMS + rec * 8192; unsigned char* gNs = ws + WS_CNS + rec * 8192; unsigned char* gGy = ws + WS_CGY + rec * 4096; unsigned char* gYl = ws + WS_CYL + rec * 4096;
        const bf16x8 tm0 = CS_PACK(Tm, 0), tm1 = CS_PACK(Tm, 1);
        f32x16 ATt = MF32(tm0, CS_PACK(AkqT, 0), zero); ATt = MF32(tm1, CS_PACK(AkqT, 1), ATt);
        const bf16x8 at0 = CS_PACK(ATt, 0), at1 = CS_PACK(ATt, 1), ab0 = CS_PACK(Abr, 0), ab1 = CS_PACK(Abr, 1);
        bf16x8 qa[2][2];
#pragma unroll
        for (int kt = 0; kt < 2; ++kt) { f32x16 Q_ = MF32(tm0, CS_XFRAG(CS_XQ, kt, 0), zero); Q_ = MF32(tm1, CS_XFRAG(CS_XQ, kt, 1), Q_); qa[kt][0] = CS_PACK(Q_, 0); qa[kt][1] = CS_PACK(Q_, 1); }
#pragma unroll
        for (int kt = 0; kt < 2; ++kt) { f32x16 Gm = MF32(qa[kt][0], ab0, zero); Gm = MF32(qa[kt][1], ab1, Gm);
#pragma unroll
            for (int g = 0; g < 4; ++g) { const int k0 = 32 * kt + 8 * g + 4 * h; const u32x2 rv = *(const LAS u32x2*)(wb + CS_TR + r * CS_TP + k0 * 2);
                u32x2 o; o.x = pkbf(bflo(rv.x) - Gm[4 * g], bfhi(rv.x) - Gm[4 * g + 1]); o.y = pkbf(bflo(rv.y) - Gm[4 * g + 2], bfhi(rv.y) - Gm[4 * g + 3]);
                const int pos = 32 * kt + 8 * ((2 * g + h) & 3) + 4 * (g >> 1);
                *(u32x2*)(gGy + r * 128 + cs_swz(r, pos)) = o; } }
        { f32x16 Wm = MF32(at0, ab0, zero); Wm = MF32(at1, ab1, Wm);
#pragma unroll
          for (int i = 0; i < 16; ++i) Wm[i] = Akr[i] - Wm[i];
          const bf16x8 w0 = CS_PACK(Wm, 0), w1 = CS_PACK(Wm, 1);
#pragma unroll
          for (int vt = 0; vt < 2; ++vt) { f32x16 Yl = MF32(CS_XFRAG(CS_XV, vt, 0), w0, zero); Yl = MF32(CS_XFRAG(CS_XV, vt, 1), w1, Yl);
#pragma unroll
              for (int g = 0; g < 4; ++g) { u32x2 o; o.x = pkbf(Yl[4 * g], Yl[4 * g + 1]); o.y = pkbf(Yl[4 * g + 2], Yl[4 * g + 3]);
                  *(u32x2*)(gYl + r * 128 + cs_swz(r, 32 * vt + 8 * g + 4 * h)) = o; } } }
#pragma unroll
        for (int k2t = 0; k2t < 2; ++k2t) { const float el = *(const LAS float*)(wb + CS_ELC + 4 * (32 * k2t + r)); const bf16x8 b0 = CS_XFRAG(CS_XB, k2t, 0), b1 = CS_XFRAG(CS_XB, k2t, 1);
#pragma unroll
            for (int k1t = 0; k1t < 2; ++k1t) { f32x16 Mm = MF32(qa[k1t][0], b0, zero); Mm = MF32(qa[k1t][1], b1, Mm);
#pragma unroll
                for (int g = 0; g < 4; ++g) { float o4[4];
#pragma unroll
                    for (int j = 0; j < 4; ++j) { const int k1 = 32 * k1t + 8 * g + 4 * h + j; o4[j] = ((k1 == 32 * k2t + r ? 1.0f : 0.0f) - Mm[4 * g + j]) * el; }
                    u32x2 o; o.x = pkbf(o4[0], o4[1]); o.y = pkbf(o4[2], o4[3]);
                    const int k2 = 32 * k2t + r, pos = 32 * k1t + 8 * ((2 * g + h) & 3) + 4 * (g >> 1);
                    *(u32x2*)(gMs + k2 * 128 + cs_swz(k2, pos)) = o; } } }
#pragma unroll
        for (int kt = 0; kt < 2; ++kt) { f32x16 Zm = MF32(at0, CS_XFRAG(CS_XB, kt, 0), zero); Zm = MF32(at1, CS_XFRAG(CS_XB, kt, 1), Zm);
#pragma unroll
            for (int g = 0; g < 4; ++g) { const u32x2 kv = *(const LAS u32x2*)(wb + CS_XK + cs_rho(32 * kt + r) * CS_XP + (8 * g + 4 * h) * 2);
                Zm[4 * g] = bflo(kv.x) - Zm[4 * g]; Zm[4 * g + 1] = bfhi(kv.x) - Zm[4 * g + 1]; Zm[4 * g + 2] = bflo(kv.y) - Zm[4 * g + 2]; Zm[4 * g + 3] = bfhi(kv.y) - Zm[4 * g + 3]; }
            const bf16x8 z0 = CS_PACK(Zm, 0), z1 = CS_PACK(Zm, 1);
#pragma unroll
            for (int vt = 0; vt < 2; ++vt) { f32x16 Nm = MF32(z0, CS_XFRAG(CS_XV, vt, 0), zero); Nm = MF32(z1, CS_XFRAG(CS_XV, vt, 1), Nm);
#pragma unroll
                for (int g = 0; g < 4; ++g) { const int k0 = 32 * kt + 8 * g + 4 * h; const f32x4 e4 = *(const LAS f32x4*)(wb + CS_ELC + 4 * k0);
                    u32x2 o; o.x = pkbf(Nm[4 * g] * e4[0], Nm[4 * g + 1] * e4[1]); o.y = pkbf(Nm[4 * g + 2] * e4[2], Nm[4 * g + 3] * e4[3]);
                    const int v = 32 * vt + r;
                    *(u32x2*)(gNs + v * 128 + cs_swz(v, k0)) = o; } } }
    }
#undef CS_TFRAG
#undef CS_XFRAG
}

constexpr int CQ_SLOT = 24576, CQ_R = 5, CQ_D = 4;
static_assert(CQ_R * CQ_SLOT <= LDS_MISC, "scan_seq LDS");
__device__ __forceinline__ void scan_seq(KArgs a, int seq, LAS unsigned char* lds, int wave, int lane) {
    unsigned char* ws = a->ws;
    const int dir = seq >> 5, bb = (seq >> 4) & 1, hd = seq & 15;
    if (wave >= 4) {
        const int lw = wave - 4;
        const unsigned char* pbase[6]; unsigned pstride[6];
#pragma unroll
        for (int i = 0; i < 6; ++i) { const int p = lw * 6 + i; const int arr = p < 8 ? 0 : (p < 16 ? 1 : (p < 20 ? 2 : 3)); const int po = p - (arr == 0 ? 0 : (arr == 1 ? 8 : (arr == 2 ? 16 : 20)));
            const size_t wsoff = arr == 0 ? WS_CMS : (arr == 1 ? WS_CNS : (arr == 2 ? WS_CGY : WS_CYL)); pstride[i] = arr < 2 ? 8192u : 4096u;
            pbase[i] = ws + wsoff + (size_t)seq * CS_NCH * pstride[i] + po * 1024 + lane * 16; }
#define CQ_ISSUE(cc) do { const int c_ = (cc) < CS_NCH ? (cc) : CS_NCH - 1; LAS unsigned char* sl_ = lds + ((cc) % CQ_R) * CQ_SLOT + lw * 6144; \
        _Pragma("unroll") for (int i_ = 0; i_ < 6; ++i_) __builtin_amdgcn_global_load_lds((const unsigned*)(pbase[i_] + (size_t)c_ * pstride[i_]), (LAS unsigned*)(sl_ + i_ * 1024), 16, 0, 0); } while (0)
        CQ_ISSUE(0); CQ_ISSUE(1); CQ_ISSUE(2); CQ_ISSUE(3);
        asm volatile("s_waitcnt vmcnt(12)" ::: "memory"); __builtin_amdgcn_s_barrier();
#pragma nounroll
        for (int c = 0; c < CS_NCH; ++c) { CQ_ISSUE(c + CQ_D); asm volatile("s_waitcnt vmcnt(12)" ::: "memory"); __builtin_amdgcn_s_barrier(); }
        asm volatile("s_waitcnt vmcnt(0)" ::: "memory");
#undef CQ_ISSUE
    } else {
        const int c16 = lane & 15, q = lane >> 4, v = 16 * wave + c16;
        bf16_t* Y = (bf16_t*)(ws + (dir ? WS_YB : WS_YF)) + (size_t)bb * SEQ * RW + hd * 64 + 16 * wave + 4 * q;
        f32x4 st[4];
#pragma unroll
        for (int I = 0; I < 4; ++I) st[I] = (f32x4){0.f, 0.f, 0.f, 0.f};
        bf16x8 fm[4][2], fg[2][2]; u32x2 fn[4], fy[2];
#define CQ_FRAGS(cc) do { const LAS unsigned char* sb_ = lds + ((cc) % CQ_R) * CQ_SLOT; \
        _Pragma("unroll") for (int I_ = 0; I_ < 4; ++I_) { const int row_ = 16 * I_ + c16; \
            _Pragma("unroll") for (int s_ = 0; s_ < 2; ++s_) fm[I_][s_] = *(const LAS bf16x8*)(sb_ + row_ * 128 + (((4 * s_ + q) ^ (row_ & 7)) << 4)); \
            fn[I_] = *(const LAS u32x2*)(sb_ + 8192 + v * 128 + (((2 * I_ + (q >> 1)) ^ (v & 7)) << 4) + (q & 1) * 8); } \
        _Pragma("unroll") for (int J_ = 0; J_ < 2; ++J_) { const int t_ = 16 * J_ + c16; \
            _Pragma("unroll") for (int s_ = 0; s_ < 2; ++s_) fg[J_][s_] = *(const LAS bf16x8*)(sb_ + 16384 + t_ * 128 + (((4 * s_ + q) ^ (t_ & 7)) << 4)); \
            fy[J_] = *(const LAS u32x2*)(sb_ + 20480 + t_ * 128 + cs_swz(t_, 16 * wave + 4 * q)); } } while (0)
        __builtin_amdgcn_s_barrier();
        CQ_FRAGS(0);
#pragma nounroll
        for (int c = 0; c < CS_NCH; ++c) {
            bf16x8 bfr[2];
#pragma unroll
            for (int s = 0; s < 2; ++s) bfr[s] = __builtin_bit_cast(bf16x8, (u32x4){pkbf(st[2 * s][0], st[2 * s][1]), pkbf(st[2 * s][2], st[2 * s][3]), pkbf(st[2 * s + 1][0], st[2 * s + 1][1]), pkbf(st[2 * s + 1][2], st[2 * s + 1][3])});
            f32x4 ya[2];
#pragma unroll
            for (int J = 0; J < 2; ++J) { ya[J] = (f32x4){bflo(fy[J].x), bfhi(fy[J].x), bflo(fy[J].y), bfhi(fy[J].y)};
#pragma unroll
                for (int s = 0; s < 2; ++s) ya[J] = __builtin_amdgcn_mfma_f32_16x16x32_bf16(bfr[s], fg[J][s], ya[J], 0, 0, 0); }
#pragma unroll
            for (int I = 0; I < 4; ++I) { f32x4 acc = (f32x4){bflo(fn[I].x), bfhi(fn[I].x), bflo(fn[I].y), bfhi(fn[I].y)};
#pragma unroll
                for (int s = 0; s < 2; ++s) acc = __builtin_amdgcn_mfma_f32_16x16x32_bf16(fm[I][s], bfr[s], acc, 0, 0, 0);
                st[I] = acc; }
            CQ_FRAGS(c + 1 < CS_NCH ? c + 1 : c);
#pragma unroll
            for (int J = 0; J < 2; ++J) { const int tk = c * CS_C + 16 * J + c16; const int tok = dir ? (SEQ - 1 - tk) : tk;
                u32x2 o; o.x = pkbf(ya[J][0], ya[J][1]); o.y = pkbf(ya[J][2], ya[J][3]);
                *(u32x2*)(Y + (size_t)tok * RW) = o; }
            __builtin_amdgcn_s_barrier();
        }
#undef CQ_FRAGS
    }
}

__device__ __forceinline__ void phase_post(KArgs a, int l, int gw, int NGW, int lane) {
    unsigned char* ws = a->ws;
    const bf16_t* YF = (const bf16_t*)(ws + WS_YF); const bf16_t* YB = (const bf16_t*)(ws + WS_YB);
    const float* A0 = (const float*)(ws + WS_A2); const float* A1 = A0 + (size_t)M * RW;
    const bf16_t* Rb = (const bf16_t*)(ws + WS_R); const bf16_t* Kb = (const bf16_t*)(ws + WS_K); const bf16_t* Vb = (const bf16_t*)(ws + WS_V); const bf16_t* Gb = (const bf16_t*)(ws + WS_G);
    bf16_t* YS = (bf16_t*)(ws + WS_YS);
    const float* k_a = a->in[I_KA] + (size_t)l * RW; const float* r_k = a->in[I_RK] + (size_t)l * RW; const float* gng = a->in[I_GNG] + (size_t)l * RW; const float* gnb = a->in[I_GNB] + (size_t)l * RW;
    for (int m = gw; m < M; m += NGW) {
#pragma unroll
        for (int j = 0; j < 2; ++j) {
            const int c = 8 * (lane + 64 * j); const size_t o = (size_t)m * RW + c;
            float y[8], rr[8], kk[8], vv[8], gg[8], a0[8], a1[8];
            { float yf[8], yb2[8]; unpack8(*(const u32x4*)(YF + o), yf); unpack8(*(const u32x4*)(YB + o), yb2);
#pragma unroll
              for (int e = 0; e < 8; ++e) y[e] = yf[e] + yb2[e]; }
            { const f32x4 p0 = *(const f32x4*)(A0 + o), p1 = *(const f32x4*)(A0 + o + 4), q0 = *(const f32x4*)(A1 + o), q1 = *(const f32x4*)(A1 + o + 4);
#pragma unroll
              for (int e = 0; e < 4; ++e) { a0[e] = p0[e]; a0[4 + e] = p1[e]; a1[e] = q0[e]; a1[4 + e] = q1[e]; } }
            unpack8(*(const u32x4*)(Rb + o), rr); unpack8(*(const u32x4*)(Kb + o), kk); unpack8(*(const u32x4*)(Vb + o), vv); unpack8(*(const u32x4*)(Gb + o), gg);
            float s = 0.f;
#pragma unroll
            for (int e = 0; e < 8; ++e) s += y[e];
            const float mean = sum8(s) * (1.f / 64.f); float q = 0.f;
#pragma unroll
            for (int e = 0; e < 8; ++e) { y[e] -= mean; q += y[e] * y[e]; }
            const float rstd = rsqrtf(sum8(q) * (1.f / 64.f) + GN_EPS);
            float bs = 0.f;
#pragma unroll
            for (int e = 0; e < 8; ++e) { const float kb = kk[e] * (1.0f + (0.5f * (a0[e] + a1[e]) - 1.0f) * k_a[c + e]); bs += rr[e] * kb * r_k[c + e]; }
            bs = sum8(bs);
            float ov[8];
#pragma unroll
            for (int e = 0; e < 8; ++e) ov[e] = (y[e] * rstd * gng[c + e] + gnb[c + e] + bs * vv[e]) * gg[e];
            *(u32x4*)(YS + (size_t)m * 3072 + c) = pack8(ov);
        }
    }
}

__global__ void __launch_bounds__(512, 2) mk_fwd(Args args) {
    extern __shared__ __attribute__((aligned(16))) unsigned char lds_raw[];
    LAS unsigned char* lds = (LAS unsigned char*)lds_raw;
    volatile LAS unsigned* MISC = (volatile LAS unsigned*)(lds + LDS_MISC);
    for (int u = threadIdx.x; u < 64; u += 512) MISC[u] = 0u;
    __syncthreads();
    const int lo = args.ph_lo, hi = args.ph_hi;
    XcdBarrier bar = xcd_barrier_post((unsigned*)(args.ws + WS_CTL) + CW_BAR, MISC + 8);
#define PH_LOCALS() int tid = threadIdx.x; asm volatile("" : "+v"(tid)); int bid = blockIdx.x; asm volatile("" : "+s"(bid)); int G = gridDim.x; asm volatile("" : "+s"(G)); \
    const int lane = tid & 63, wave = __builtin_amdgcn_readfirstlane(tid >> 6), gw = bid * 8 + wave, NGW = G * 8; \
    unsigned char* ws = kargs()->ws; (void)lane; (void)gw; (void)ws; (void)NGW
#define IN(k) (lo <= (k) && (k) < hi)
#define SEAM(k) do { if ((k) + 1 < hi) xcd_barrier(bar); } while (0)
    using namespace pg8;
#define XB ((bf16_t*)(ws + WS_XB))
#define X ((float*)(ws + WS_X))
#define H ((bf16_t*)(ws + WS_H))
#define P ((bf16_t*)(ws + WS_P))

    for (int l = 0; l < DEPTH; ++l) {
        const int pb = l * NPH;
        if (PH_EN(0) && IN(pb + 0)) { PH_LOCALS(); for (int rep = 0; rep < (DUP_PHASE == 0 ? 2 : 1); ++rep) phase_cvt(kargs(), l, gw, NGW, lane); SEAM(pb + 0); }
        if (PH_EN(1) && IN(pb + 1)) { PH_LOCALS();
            for (int rep = 0; rep < (DUP_PHASE == 1 ? 2 : 1); ++rep)
            { Gemm g{XB, (const bf16_t*)(ws + WS_WGU1), M, 2 * FF, DM, DM, DM}; StaticOrder S; S.init(M, 2 * FF, G, bid); EpiSwiglu E{H, FF};
              gemm_phase<EpiSwiglu, StaticOrder, true, true>(lds, g, S, E); }
            if (G == 256) {
                if (bid >= 96 && bid < 104) { Gemm g{(const bf16_t*)(ws + WS_MEMN), (const bf16_t*)(ws + WS_WKV), BATCH * NMEM, 1024, DM, DM, DM}; StaticOrder S; S.init(BATCH * NMEM, 1024, 8, bid - 96); EpiBf16 E{(bf16_t*)(ws + WS_KMEM), 1024};
                  gemm_phase<EpiBf16, StaticOrder, true, true>(lds, g, S, E); }
                else if (bid >= 104 && bid < 112) { Gemm g{(const bf16_t*)(ws + WS_WKV) + (size_t)1024 * DM, (const bf16_t*)(ws + WS_MEMN), 1024, BATCH * NMEM, DM, DM, DM}; StaticOrder S; S.init(1024, BATCH * NMEM, 8, bid - 104); EpiBf16 E{(bf16_t*)(ws + WS_VT), BATCH * NMEM};
                  gemm_phase<EpiBf16, StaticOrder, true, true>(lds, g, S, E); }
            } else {
                { Gemm g{(const bf16_t*)(ws + WS_MEMN), (const bf16_t*)(ws + WS_WKV), BATCH * NMEM, 1024, DM, DM, DM}; StaticOrder S; S.init(BATCH * NMEM, 1024, G, bid); EpiBf16 E{(bf16_t*)(ws + WS_KMEM), 1024};
                  gemm_phase<EpiBf16, StaticOrder, true, true>(lds, g, S, E); }
                { Gemm g{(const bf16_t*)(ws + WS_WKV) + (size_t)1024 * DM, (const bf16_t*)(ws + WS_MEMN), 1024, BATCH * NMEM, DM, DM, DM}; StaticOrder S; S.init(1024, BATCH * NMEM, G, bid); EpiBf16 E{(bf16_t*)(ws + WS_VT), BATCH * NMEM};
                  gemm_phase<EpiBf16, StaticOrder, true, true>(lds, g, S, E); }
            }
            SEAM(pb + 1);
        }
        if (PH_EN(2) && IN(pb + 2)) { PH_LOCALS();
            Gemm g{H, (const bf16_t*)(ws + WS_WD1), M, DM, FF, FF, FF}; StaticOrder S; S.init(M, DM, G, bid); EpiRes E{l == 0 ? kargs()->in[I_X] : X, X, DM, ALPHA, 0.5f};
            gemm_phase<EpiRes, StaticOrder, false, true>(lds, g, S, E);
            SEAM(pb + 2);
        }
        if (PH_EN(3) && IN(pb + 3)) { PH_LOCALS(); phase_ln(X, X, XB, kargs()->in[I_LN1G] + (size_t)l * DM, kargs()->in[I_LN1B] + (size_t)l * DM, gw, NGW, lane); SEAM(pb + 3); }
        if (PH_EN(4) && IN(pb + 4)) { PH_LOCALS();
            Gemm g{XB, (const bf16_t*)(ws + WS_WIN), M, DINP, DM, DM, DM}; StaticOrder S; S.init(M, DINP, G, bid); EpiBf16 E{P, DINP};
            gemm_phase<EpiBf16, StaticOrder, true, true>(lds, g, S, E);
            SEAM(pb + 4);
        }
        if (PH_EN(5) && IN(pb + 5)) { PH_LOCALS(); phase_elt(kargs(), l, gw, NGW, lane); SEAM(pb + 5); }
#if DUP_PHASE == 59
        if (PH_EN(5) && IN(pb + 5)) { PH_LOCALS(); phase_elt(kargs(), l, gw, NGW, lane); xcd_barrier(bar); }
        if (PH_EN(5) && IN(pb + 5)) { PH_LOCALS(); for (int u = bid; u < 256; u += G) xattn_unit(kargs(), u, lds, tid, wave, lane); xcd_barrier(bar); }
#endif
        if (PH_EN(6) && IN(pb + 6)) { PH_LOCALS();
            { Gemm g{(const bf16_t*)(ws + WS_ACAT), (const bf16_t*)(ws + WS_WLR), M, 2048, LRK, LRK, LRK}; StaticOrder S; S.init(M, 2048, G, bid);
              EpiLR<0> E{(float*)(ws + WS_W2), nullptr, kargs()->in[I_W0] + (size_t)l * 2 * RW}; gemm_phase<EpiLR<0>, StaticOrder, false, true>(lds, g, S, E); }
            { Gemm g{(const bf16_t*)(ws + WS_ACAT), (const bf16_t*)(ws + WS_WLR) + (size_t)2048 * LRK, M, 2048, LRK, LRK, LRK}; StaticOrder S; S.init(M, 2048, G, bid);
              EpiLR<1> E{(float*)(ws + WS_A2), nullptr, kargs()->in[I_A0] + (size_t)l * 2 * RW}; gemm_phase<EpiLR<1>, StaticOrder, false, true>(lds, g, S, E); }
            { Gemm g{(const bf16_t*)(ws + WS_ACAT), (const bf16_t*)(ws + WS_WLR) + (size_t)4096 * LRK, M, 1024, LRK, LRK, LRK}; StaticOrder S; S.init(M, 1024, G, bid);
              EpiLR<2> E{nullptr, (bf16_t*)(ws + WS_G), nullptr}; gemm_phase<EpiLR<2>, StaticOrder, false, true>(lds, g, S, E); }
            for (int u = bid; u < 256; u += G) xattn_unit(kargs(), u, lds, tid, wave, lane);
            SEAM(pb + 6);
        }
        if (PH_EN(7) && IN(pb + 7)) { PH_LOCALS();
#if SCAN_SEQ
            for (int u = bid; u < 256; u += G) phase_scan(kargs(), l, u, lds, tid, wave, lane);
#else
            scan_pre(kargs(), l, bid, G, lds, wave, lane);
#endif
            SEAM(pb + 7); }
#if DUP_PHASE == 7
        if (PH_EN(7) && IN(pb + 7)) { PH_LOCALS(); scan_pre(kargs(), l, bid, G, lds, wave, lane); xcd_barrier(bar); }
#endif
        if (PH_EN(8) && IN(pb + 8)) { PH_LOCALS();
#if !SCAN_SEQ
            const int nseq_wg = G < 64 ? G : 64;
            for (int rep = 0; rep < (DUP_PHASE == 8 ? 2 : 1); ++rep) if (bid < nseq_wg) for (int sq = bid; sq < 64; sq += nseq_wg) scan_seq(kargs(), sq, lds, wave, lane);
#endif
            SEAM(pb + 8); }
        if (PH_EN(9) && IN(pb + 9)) { PH_LOCALS(); phase_post(kargs(), l, gw, NGW, lane); phase_cvt2(kargs(), l, gw, NGW, lane); SEAM(pb + 9); }
#if DUP_PHASE == 59
        if (PH_EN(9) && IN(pb + 9)) { PH_LOCALS(); phase_post(kargs(), l, gw, NGW, lane); phase_cvt2(kargs(), l, gw, NGW, lane); xcd_barrier(bar); }
#endif
        if (PH_EN(10) && IN(pb + 10)) { PH_LOCALS();
            const bf16_t* YS = (const bf16_t*)(ws + WS_YS); const bf16_t* WBR = (const bf16_t*)(ws + WS_WBR); const float* gb = kargs()->in[I_GATEB] + (size_t)l * 3 * DM;
            float* MIXF = (float*)(ws + WS_MIXF); bf16_t* MIXB = (bf16_t*)(ws + WS_MIXB);
            { Gemm g{YS, WBR, M, DM, RW, 3072, RW}; StaticOrder S; S.init(M, DM, G, bid); EpiGate<0> E{P, gb, MIXF, MIXB}; gemm_phase<EpiGate<0>, StaticOrder, false, true>(lds, g, S, E); }
            { Gemm g{YS + 1024, WBR + (size_t)DM * RW, M, DM, RW, 3072, RW}; StaticOrder S; S.init(M, DM, G, bid); EpiGate<1> E{P, gb, MIXF, MIXB}; gemm_phase<EpiGate<1>, StaticOrder, false, true>(lds, g, S, E); }
            { Gemm g{YS + 2048, WBR + (size_t)2 * DM * RW, M, DM, RW, 3072, RW}; StaticOrder S; S.init(M, DM, G, bid); EpiGate<2> E{P, gb, MIXF, MIXB}; gemm_phase<EpiGate<2>, StaticOrder, false, true>(lds, g, S, E); }
            SEAM(pb + 10);
        }
        if (PH_EN(11) && IN(pb + 11)) { PH_LOCALS();
            Gemm g{(const bf16_t*)(ws + WS_MIXB), (const bf16_t*)(ws + WS_WOUT), M, DM, DM, DM, DM}; StaticOrder S; S.init(M, DM, G, bid); EpiRes E{X, X, DM, ALPHA, 1.0f};
            gemm_phase<EpiRes, StaticOrder, false, true>(lds, g, S, E);
            SEAM(pb + 11);
        }
        if (PH_EN(12) && IN(pb + 12)) { PH_LOCALS(); phase_ln(X, X, XB, kargs()->in[I_LN2G] + (size_t)l * DM, kargs()->in[I_LN2B] + (size_t)l * DM, gw, NGW, lane); SEAM(pb + 12); }
        if (PH_EN(13) && IN(pb + 13)) { PH_LOCALS();
            Gemm g{XB, (const bf16_t*)(ws + WS_WGU2), M, 2 * FF, DM, DM, DM}; StaticOrder S; S.init(M, 2 * FF, G, bid); EpiSwiglu E{H, FF};
            gemm_phase<EpiSwiglu, StaticOrder, true, true>(lds, g, S, E);
            SEAM(pb + 13);
        }
        if (PH_EN(14) && IN(pb + 14)) { PH_LOCALS();
            Gemm g{H, (const bf16_t*)(ws + WS_WD2), M, DM, FF, FF, FF}; StaticOrder S; S.init(M, DM, G, bid); EpiRes E{X, X, DM, ALPHA, 0.5f};
            gemm_phase<EpiRes, StaticOrder, false, true>(lds, g, S, E);
            SEAM(pb + 14);
        }
        if (PH_EN(15) && IN(pb + 15)) { PH_LOCALS(); phase_ln(X, l == DEPTH - 1 ? kargs()->out : X, l == DEPTH - 1 ? (bf16_t*)nullptr : XB, kargs()->in[I_LN3G] + (size_t)l * DM, kargs()->in[I_LN3B] + (size_t)l * DM, gw, NGW, lane); SEAM(pb + 15); }
    }
#undef IN
#undef SEAM
#undef XB
#undef X
#undef H
#undef P
#undef PH_LOCALS
}

extern "C" void kernel_launch(void* const* d_in, const int* in_sizes, int n_in, void* d_out, int out_size, void* d_ws, size_t ws_size, hipStream_t stream) {
    static int grid = 0;
    if (grid == 0) {
        if (n_in != N_IN || out_size != M * DM || ws_size < WS_END) { fprintf(stderr, "kernel_launch: unexpected problem (n_in %d, out %d, ws %zu < %zu)\n", n_in, out_size, ws_size, (size_t)WS_END); grid = -1; return; }
        int dev = 0, cus = 0, per_cu = 0;
        if (hipGetDevice(&dev) != hipSuccess || hipDeviceGetAttribute(&cus, hipDeviceAttributeMultiprocessorCount, dev) != hipSuccess) { grid = -1; return; }
        if (hipFuncSetAttribute((const void*)mk_fwd, hipFuncAttributeMaxDynamicSharedMemorySize, LDS_BYTES) != hipSuccess) { fprintf(stderr, "kernel_launch: hipFuncSetAttribute failed\n"); grid = -1; return; }
        if (hipOccupancyMaxActiveBlocksPerMultiprocessor(&per_cu, (const void*)mk_fwd, 512, LDS_BYTES) != hipSuccess || per_cu < 1) fprintf(stderr, "kernel_launch: occupancy query says %d\n", per_cu);
        (void)hipGetLastError();
        grid = cus;
    }
    if (grid < 0) return;
    (void)hipMemsetAsync((char*)d_ws + WS_CTL, 0, CTL_BYTES, stream);
    Args a{};
    for (int i = 0; i < N_IN; ++i) a.in[i] = (const float*)d_in[i];
    a.out = (float*)d_out; a.ws = (unsigned char*)d_ws;
#if MK_ONE_LAUNCH
    a.ph_lo = 0; a.ph_hi = DEPTH * NPH;
    hipLaunchKernelGGL(mk_fwd, dim3(grid), dim3(512), LDS_BYTES, stream, a);
#else
    for (int p = 0; p < DEPTH * NPH; ++p) { a.ph_lo = p; a.ph_hi = p + 1; hipLaunchKernelGGL(mk_fwd, dim3(grid), dim3(512), LDS_BYTES, stream, a); }
#endif
}
```
